# Optimizing an MI355X kernel written in HIP

```python
import math
import jax, jax.numpy as jnp
from jax import lax
import numpy as np

D_MODEL = 1024
BATCH = 16
SEQ = 4096
DEPTH = 1

GLA_HEADS = 4
GLA_K = D_MODEL // 2
GLA_V = D_MODEL
GLA_DK = GLA_K // GLA_HEADS
GLA_DV = GLA_V // GLA_HEADS
GLA_RANK = 16
GLA_GATE_NORM = 16.0
GLA_CHUNK = 64
DIFF_HEADS = 4
DIFF_HD = 128
DIFF_QK = DIFF_HEADS * 2 * DIFF_HD
DIFF_V = DIFF_HEADS * 2 * DIFF_HD
Q_BLOCK = 128
ROPE_THETA = 10000.0
FFN_HIDDEN = -(-8 * D_MODEL // (3 * 256)) * 256
NORM_EPS = 1e-6
SUBLN_EPS = 1e-5
IN_SIZES = (GLA_K, GLA_K, GLA_V, GLA_V, 2 * GLA_RANK, DIFF_QK, DIFF_QK, DIFF_V, D_MODEL, D_MODEL)
IN_WIDTH = sum(IN_SIZES)

kernel_name = "hybrid_gla_diffattn_encoder_block"


def rms_norm(x, w, eps=NORM_EPS):
    xf = x.astype(jnp.float32)
    y = xf * lax.rsqrt(jnp.mean(xf * xf, axis=-1, keepdims=True) + eps)
    return (y * w.astype(jnp.float32)).astype(x.dtype)


def rope(x, pos):
    d = x.shape[-1]
    inv_freq = 1.0 / (ROPE_THETA ** (jnp.arange(0, d, 2, dtype=jnp.float32) / d))
    freqs = pos.astype(jnp.float32)[:, None] * inv_freq[None, :]
    emb = jnp.concatenate([freqs, freqs], axis=-1)
    cos = jnp.cos(emb)[None, :, None, None, :]
    sin = jnp.sin(emb)[None, :, None, None, :]
    xf = x.astype(jnp.float32)
    x1, x2 = xf[..., : d // 2], xf[..., d // 2:]
    rot = jnp.concatenate([-x2, x1], axis=-1)
    return (xf * cos + rot * sin).astype(x.dtype)


def gla_chunked(q, k, v, g):
    B, S, H, dk = q.shape
    dv = v.shape[-1]
    C = GLA_CHUNK
    N = S // C

    def chunks(t):
        return t.reshape(B, N, C, H, t.shape[-1]).transpose(1, 0, 3, 2, 4)

    qc, kc, vc, gc = chunks(q), chunks(k), chunks(v), chunks(g)
    b = jnp.cumsum(gc, axis=3)
    b_last = b[:, :, :, -1:, :]
    q_t = qc * jnp.exp(b)
    k_t = kc * jnp.exp(-b)
    k_s = kc * jnp.exp(b_last - b)
    mask = jnp.tril(jnp.ones((C, C), dtype=bool))
    attn = jnp.where(mask, jnp.einsum('nbhid,nbhjd->nbhij', q_t, k_t), 0.0)
    o_intra = jnp.einsum('nbhij,nbhjv->nbhiv', attn, vc)

    def step(state, xs):
        q_n, k_n, v_n, decay_n = xs
        o = jnp.einsum('bhid,bhdv->bhiv', q_n, state)
        state = state * decay_n[:, :, 0, :, None] + jnp.einsum('bhjd,bhjv->bhdv', k_n, v_n)
        return state, o

    state0 = jnp.zeros((B, H, dk, dv), dtype=q.dtype)
    _, o_inter = lax.scan(step, state0, (q_t, k_s, vc, jnp.exp(b_last)))
    o = o_intra + o_inter
    return o.transpose(1, 0, 3, 2, 4).reshape(B, S, H, dv)


def diff_attention(q, k, v, lam):
    B, S, H, _, d = q.shape
    nb = S // Q_BLOCK
    qb = q.reshape(B, nb, Q_BLOCK, H, 2, d).transpose(1, 0, 2, 3, 4, 5)

    def block(q_blk):
        s = jnp.einsum('bqhcd,bkhcd->bhcqk', q_blk, k).astype(jnp.float32)
        p = jax.nn.softmax(s, axis=-1)
        w = p[:, :, 0] - lam * p[:, :, 1]
        return jnp.einsum('bhqk,bkhv->bqhv', w.astype(v.dtype), v)

    o = lax.map(block, qb)
    return o.transpose(1, 0, 2, 3, 4).reshape(B, S, H, 2 * d)


def hybrid_mixer(u, w_in, w_gk2, b_gk, gla_norm_w, lq1, lk1, lq2, lk2, subln_w, w_out, lambda_init):
    B, S, _ = u.shape
    f32 = jnp.float32
    proj = u @ w_in
    idx = []
    acc = 0
    for sz in IN_SIZES[:-1]:
        acc += sz
        idx.append(acc)
    gq, gk, gv, gr, glr, dq, dk, dv, ga, gb = jnp.split(proj, idx, axis=-1)

    q = (gq.astype(f32) * (GLA_DK ** -0.5)).reshape(B, S, GLA_HEADS, GLA_DK)
    k = gk.astype(f32).reshape(B, S, GLA_HEADS, GLA_DK)
    v = gv.astype(f32).reshape(B, S, GLA_HEADS, GLA_DV)
    glr = glr.astype(f32).reshape(B, S, 2, GLA_RANK)
    logits = jnp.einsum('bsdr,drk->bsdk', glr, w_gk2.astype(f32)) + b_gk.astype(f32)
    log_a = jax.nn.log_sigmoid(logits) / GLA_GATE_NORM
    g_f = log_a[:, :, 0].reshape(B, S, GLA_HEADS, GLA_DK)
    g_b = log_a[:, :, 1].reshape(B, S, GLA_HEADS, GLA_DK)
    o_f = gla_chunked(q, k, v, g_f)
    o_b = jnp.flip(gla_chunked(jnp.flip(q, 1), jnp.flip(k, 1), jnp.flip(v, 1), jnp.flip(g_b, 1)), 1)
    o_a = rms_norm(o_f + o_b, gla_norm_w)
    y_a = o_a.reshape(B, S, GLA_V) * jax.nn.silu(gr.astype(f32))

    pos = jnp.arange(S)
    q2 = rope(dq.reshape(B, S, DIFF_HEADS, 2, DIFF_HD), pos) * jnp.asarray(DIFF_HD ** -0.5, dtype=dq.dtype)
    k2 = rope(dk.reshape(B, S, DIFF_HEADS, 2, DIFF_HD), pos)
    v2 = dv.reshape(B, S, DIFF_HEADS, 2 * DIFF_HD)
    lam = (jnp.exp(jnp.sum(lq1.astype(f32) * lk1.astype(f32)))
           - jnp.exp(jnp.sum(lq2.astype(f32) * lk2.astype(f32))) + lambda_init)
    o2 = diff_attention(q2, k2, v2, lam)
    y_b = (rms_norm(o2, subln_w, eps=SUBLN_EPS).astype(f32) * (1.0 - lambda_init)).reshape(B, S, DIFF_V)

    merged = jax.nn.sigmoid(ga.astype(f32)) * y_a + jax.nn.sigmoid(gb.astype(f32)) * y_b
    return merged.astype(u.dtype) @ w_out


def swiglu(x, w_ffn_in, w_ffn_out):
    a = x @ w_ffn_in
    gate, up = jnp.split(a, [FFN_HIDDEN], axis=-1)
    return (jax.nn.silu(gate) * up) @ w_ffn_out


def setup_inputs(seed: int = 0) -> dict:
    key = jax.random.key(seed)
    ks = jax.random.split(key, 16)
    f = jnp.float32
    nrm = lambda k, shp, s: jax.random.normal(k, shp, dtype=f) * s
    return {
        "x": jax.random.normal(ks[0], (BATCH, SEQ, D_MODEL), dtype=f),
        "norm_mix_w": 1.0 + nrm(ks[1], (DEPTH, D_MODEL), 0.02),
        "w_in": nrm(ks[2], (DEPTH, D_MODEL, IN_WIDTH), D_MODEL ** -0.5),
        "w_gk2": nrm(ks[3], (DEPTH, 2, GLA_RANK, GLA_K), GLA_RANK ** -0.5),
        "b_gk": nrm(ks[4], (DEPTH, 2, GLA_K), 0.1),
        "gla_norm_w": 1.0 + nrm(ks[5], (DEPTH, GLA_DV), 0.02),
        "lambda_q1": nrm(ks[6], (DEPTH, DIFF_HD), 0.1),
        "lambda_k1": nrm(ks[7], (DEPTH, DIFF_HD), 0.1),
        "lambda_q2": nrm(ks[8], (DEPTH, DIFF_HD), 0.1),
        "lambda_k2": nrm(ks[9], (DEPTH, DIFF_HD), 0.1),
        "diff_subln_w": 1.0 + nrm(ks[10], (DEPTH, 2 * DIFF_HD), 0.02),
        "w_out": nrm(ks[11], (DEPTH, D_MODEL, D_MODEL), D_MODEL ** -0.5),
        "norm_ffn_w": 1.0 + nrm(ks[12], (DEPTH, D_MODEL), 0.02),
        "w_ffn_in": nrm(ks[13], (DEPTH, D_MODEL, 2 * FFN_HIDDEN), D_MODEL ** -0.5),
        "w_ffn_out": nrm(ks[14], (DEPTH, FFN_HIDDEN, D_MODEL), FFN_HIDDEN ** -0.5),
        "norm_final_w": 1.0 + nrm(ks[15], (D_MODEL,), 0.02),
    }


def reference(x, norm_mix_w, w_in, w_gk2, b_gk, gla_norm_w, lambda_q1, lambda_k1, lambda_q2,
              lambda_k2, diff_subln_w, w_out, norm_ffn_w, w_ffn_in, w_ffn_out, norm_final_w):
    h = x
    for layer in range(DEPTH):
        lambda_init = 0.8 - 0.6 * math.exp(-0.3 * layer)
        u = rms_norm(h, norm_mix_w[layer])
        h = h + hybrid_mixer(u, w_in[layer], w_gk2[layer], b_gk[layer], gla_norm_w[layer],
                             lambda_q1[layer], lambda_k1[layer], lambda_q2[layer], lambda_k2[layer],
                             diff_subln_w[layer], w_out[layer], lambda_init)
        h = h + swiglu(rms_norm(h, norm_ffn_w[layer]), w_ffn_in[layer], w_ffn_out[layer])
    return rms_norm(h, norm_final_w)
```

```cpp
#include <hip/hip_runtime.h>
#include <hip/hip_bf16.h>
#include <hip/hip_cooperative_groups.h>
#include <cstdio>
#include <cstdint>
namespace cg = cooperative_groups;
#ifndef N_LAUNCH_MODE
#define N_LAUNCH_MODE 1
#endif
namespace pg8 {
#define PG8_LAS __attribute__((address_space(3)))
typedef unsigned short bf16_t;
typedef short bf16x8 __attribute__((ext_vector_type(8)));
typedef float f32x4 __attribute__((ext_vector_type(4)));
typedef unsigned u32x4 __attribute__((ext_vector_type(4)));
constexpr int BM = 256, BK = 64, HALF = 128, HTB = HALF * BK * 2  , STAGE_BYTES = 8 * HTB, NXCD = 8, WGM = 8;

__host__ __device__ __forceinline__ int lds_byte(int r, int c) { const int st = (r >> 4) * 2 + (c >> 5), rr = r & 15, cc = c & 31, ob = rr * 64 + cc * 2; return st * 1024 + (ob ^ (((ob >> 9) & 1) << 5)); }
__host__ __device__ __forceinline__ void stage_rc(int b, int& R, int& C) { const int st = b / 1024, sb = b % 1024, swz = sb ^ (((sb >> 9) & 1) << 5); R = (st >> 1) * 16 + swz / 64; C = (st & 1) * 32 + (swz % 64) / 2; }
__host__ __device__ __forceinline__ int perm32(int rho) { const int n = rho >> 4, i = rho & 15; return 8 * (i >> 2) + 4 * n + (i & 3); }

struct Unit { int pm, pn; };
struct Gemm { const bf16_t* A; const bf16_t* Bt; int M, N, K; };

struct StaticOrder {
    int nM, nN, nwg, G, c;
    __host__ __device__ void init(int M, int N, int G_, int c_) { nM = M / BM; nN = N / BM; nwg = nM * nN; G = G_; c = c_; }
    __host__ __device__ bool next(int i, Unit& u) const {
        const long L = (long)i * G + c; if (L >= nwg) return false;
        int wgid = (int)L; { const int q = nwg / NXCD, r = nwg % NXCD, xcd = wgid % NXCD, off = wgid / NXCD; wgid = (xcd < r ? xcd * (q + 1) : r * (q + 1) + (xcd - r) * q) + off; }
        const int nig = WGM * nN, gid = wgid / nig, fm = gid * WGM, gsz = (nM - fm) < WGM ? (nM - fm) : WGM;
        u.pm = fm + ((wgid % nig) % gsz); u.pn = (wgid % nig) / gsz; return true;
    }
    __device__ __forceinline__ void a_ready(const Unit&) const {}
    __device__ __forceinline__ void done(const Unit&) const {}
};

typedef float cvt_f32x2_t __attribute__((ext_vector_type(2))); typedef __bf16 cvt_bf16x2_t __attribute__((ext_vector_type(2)));
__device__ __forceinline__ unsigned cvt_pk_bf16(float lo, float hi) { cvt_f32x2_t v = {lo, hi}; cvt_bf16x2_t b = __builtin_convertvector(v, cvt_bf16x2_t); return __builtin_bit_cast(unsigned, b); }
typedef float f32x2 __attribute__((ext_vector_type(2)));
template <class Epi, class Sched, bool ALIGN_EPI = false, bool SP2 = false>
__device__ __forceinline__ void gemm_phase(PG8_LAS unsigned char* lds, const Gemm g, const Sched& S, const Epi& E) {
    int tid_ = threadIdx.x; asm volatile("" : "+v"(tid_)); const int tid = tid_, wid = __builtin_amdgcn_readfirstlane(tid >> 6), lane = tid & 63, wr = wid >> 2, wc = wid & 3, fr = lane & 15, fq = lane >> 4;
    const int K = g.K, nt = K / BK;
    unsigned voffA[2], voffB[2];
#pragma unroll
    for (int i = 0; i < 2; ++i) { int R, C; stage_rc(tid * 16 + i * 8192, R, C); const int Rb = Epi::PERM ? ((R & ~31) + perm32(R & 31)) : R;
        voffA[i] = (unsigned)(R * K + C) * 2u; voffB[i] = (unsigned)(Rb * K + C) * 2u; }
    const size_t kstep = (size_t)(BK * 2);
    const size_t hstep = (size_t)HALF * K * 2;
    const size_t tstep = 2 * hstep;
    const unsigned ldsw = (unsigned)wid * 1024u;
    const int aoff = lds_byte(wr * 64 + fr, fq * 8), boff = lds_byte(wc * 32 + fr, fq * 8);
#define PG8_SA(b, h) (((b) * 2 + (h)) * HTB)
#define PG8_SB(b, h) ((4 + (b) * 2 + (h)) * HTB)
#define PG8_STAGE(bufoff, gbase, voff) do { _Pragma("unroll") for (int _i = 0; _i < 2; ++_i) \
        __builtin_amdgcn_global_load_lds((const unsigned*)((const char*)(gbase) + (voff)[_i]), (PG8_LAS unsigned*)(lds + (bufoff) + ldsw + _i * 8192), 16, 0, 0); } while (0)
#define PG8_LDA(dst, b, h) do { _Pragma("unroll") for (int m = 0; m < 4; ++m) _Pragma("unroll") for (int k = 0; k < 2; ++k) dst[m][k] = *(const PG8_LAS bf16x8*)(lds + PG8_SA(b, h) + aoff + m * 2048 + k * 1024); } while (0)
#define PG8_LDB(dst, b, h) do { _Pragma("unroll") for (int n = 0; n < 2; ++n) _Pragma("unroll") for (int k = 0; k < 2; ++k) dst[n][k] = *(const PG8_LAS bf16x8*)(lds + PG8_SB(b, h) + boff + n * 2048 + k * 1024); } while (0)
#define PG8_MMA(ai, bj, At, Bt) do { __builtin_amdgcn_s_setprio(1); _Pragma("unroll") for (int m = 0; m < 4; ++m) _Pragma("unroll") for (int n = 0; n < 2; ++n) _Pragma("unroll") for (int k = 0; k < 2; ++k) \
        acc[ai][bj][m][n] = __builtin_amdgcn_mfma_f32_16x16x32_bf16(Bt[n][k], At[m][k], acc[ai][bj][m][n], 0, 0, 0); __builtin_amdgcn_s_setprio(0); } while (0)
#define PG8_WAIT_V(n) asm volatile("s_waitcnt vmcnt(" #n ")" ::: "memory")
#define PG8_WAIT_L(n) asm volatile("s_waitcnt lgkmcnt(" #n ")" ::: "memory")
#define PG8_BAR __builtin_amdgcn_s_barrier()
#define PG8_SCHED __builtin_amdgcn_sched_barrier(0)
    Unit cur, nxt; int ui = 0;
    if (!S.next(0, cur)) return;
    f32x4 acc[2][2][4][2];
#pragma unroll
    for (int a = 0; a < 2; ++a)
#pragma unroll
        for (int b = 0; b < 2; ++b)
#pragma unroll
            for (int m = 0; m < 4; ++m)
#pragma unroll
                for (int n = 0; n < 2; ++n) acc[a][b][m][n] = (f32x4){0.f, 0.f, 0.f, 0.f};
    bf16x8 At[4][2], B0[2][2], B1[2][2];
    const char* cA = (const char*)g.A + (size_t)cur.pm * tstep; const char* cB = (const char*)g.Bt + (size_t)cur.pn * tstep;
    S.a_ready(cur);
    if constexpr (SP2) {
        PG8_STAGE(PG8_SB(0, 0), cB, voffB); PG8_STAGE(PG8_SB(0, 1), cB + hstep, voffB); PG8_STAGE(PG8_SA(0, 0), cA, voffA); PG8_STAGE(PG8_SA(0, 1), cA + hstep, voffA);
        if (wr == 1) PG8_BAR;
        PG8_WAIT_V(2); PG8_BAR;
        PG8_STAGE(PG8_SB(1, 0), cB + kstep, voffB); PG8_STAGE(PG8_SA(1, 0), cA + kstep, voffA); PG8_STAGE(PG8_SB(1, 1), cB + hstep + kstep, voffB);
        PG8_WAIT_V(6); PG8_BAR;
    } else {
        PG8_STAGE(PG8_SB(0, 0), cB, voffB); PG8_STAGE(PG8_SA(0, 0), cA, voffA); PG8_STAGE(PG8_SB(0, 1), cB + hstep, voffB); PG8_STAGE(PG8_SA(0, 1), cA + hstep, voffA);
        if (wr == 1) PG8_BAR;
        PG8_WAIT_V(4); PG8_BAR;
        PG8_STAGE(PG8_SB(1, 0), cB + kstep, voffB); PG8_STAGE(PG8_SA(1, 0), cA + kstep, voffA); PG8_STAGE(PG8_SB(1, 1), cB + hstep + kstep, voffB);
        PG8_WAIT_V(6); PG8_BAR;
    }
    for (;;) {
        const bool has_next = S.next(ui + 1, nxt);
        const char* nA = has_next ? (const char*)g.A + (size_t)nxt.pm * tstep : cA; const char* nB = has_next ? (const char*)g.Bt + (size_t)nxt.pn * tstep : cB;
        for (int t = 0; t < nt; t += 2) {
            const bool last = (t == nt - 2);
            const char* a1 = cA + (size_t)(t + 1) * kstep;
            const char* a2 = last ? nA : cA + (size_t)(t + 2) * kstep; const char* b2 = last ? nB : cB + (size_t)(t + 2) * kstep;
            const char* a3 = a2 + kstep; const char* b3 = b2 + kstep;
            if (last && has_next) S.a_ready(nxt);
            if constexpr (SP2) {
            PG8_LDB(B0, 0, 0); PG8_LDB(B1, 0, 1); PG8_SCHED; PG8_LDA(At, 0, 0); PG8_STAGE(PG8_SA(1, 1), a1 + hstep, voffA);
            PG8_WAIT_V(8); PG8_WAIT_L(0); PG8_BAR; PG8_MMA(0, 0, At, B0); PG8_MMA(0, 1, At, B1); PG8_BAR; PG8_SCHED;
            PG8_LDA(At, 0, 1); PG8_STAGE(PG8_SB(0, 0), b2, voffB); PG8_STAGE(PG8_SB(0, 1), b2 + hstep, voffB); PG8_STAGE(PG8_SA(0, 0), a2, voffA);
            PG8_WAIT_V(8); PG8_WAIT_L(0); PG8_BAR; PG8_MMA(1, 0, At, B0); PG8_MMA(1, 1, At, B1); PG8_BAR; PG8_SCHED;
            PG8_LDB(B0, 1, 0); PG8_LDB(B1, 1, 1); PG8_SCHED; PG8_LDA(At, 1, 0); PG8_STAGE(PG8_SA(0, 1), a2 + hstep, voffA);
            PG8_WAIT_V(8); PG8_WAIT_L(0); PG8_BAR; PG8_MMA(0, 0, At, B0); PG8_MMA(0, 1, At, B1); PG8_BAR; PG8_SCHED;
            PG8_LDA(At, 1, 1); PG8_STAGE(PG8_SB(1, 0), b3, voffB); PG8_STAGE(PG8_SB(1, 1), b3 + hstep, voffB); PG8_STAGE(PG8_SA(1, 0), a3, voffA);
            PG8_WAIT_V(8); PG8_WAIT_L(0); PG8_BAR; PG8_MMA(1, 0, At, B0); PG8_MMA(1, 1, At, B1); PG8_BAR; PG8_SCHED;
            } else {
            PG8_LDB(B0, 0, 0); PG8_SCHED; PG8_LDA(At, 0, 0); PG8_STAGE(PG8_SA(1, 1), a1 + hstep, voffA);
            PG8_WAIT_L(8); PG8_BAR; PG8_WAIT_L(0); PG8_MMA(0, 0, At, B0); PG8_BAR; PG8_SCHED;
            PG8_LDB(B1, 0, 1); PG8_STAGE(PG8_SB(0, 0), b2, voffB);
            PG8_BAR; PG8_WAIT_L(0); PG8_MMA(0, 1, At, B1); PG8_BAR;
            PG8_LDA(At, 0, 1); PG8_STAGE(PG8_SA(0, 0), a2, voffA);
            PG8_BAR; PG8_WAIT_L(0); PG8_MMA(1, 0, At, B0); PG8_BAR; PG8_SCHED;
            PG8_STAGE(PG8_SB(0, 1), b2 + hstep, voffB);
            PG8_WAIT_V(6); PG8_BAR; PG8_MMA(1, 1, At, B1); PG8_BAR;
            PG8_LDB(B0, 1, 0); PG8_SCHED; PG8_LDA(At, 1, 0); PG8_STAGE(PG8_SA(0, 1), a2 + hstep, voffA);
            PG8_WAIT_L(8); PG8_BAR; PG8_WAIT_L(0); PG8_MMA(0, 0, At, B0); PG8_BAR; PG8_SCHED;
            PG8_LDB(B1, 1, 1); PG8_STAGE(PG8_SB(1, 0), b3, voffB);
            PG8_BAR; PG8_WAIT_L(0); PG8_MMA(0, 1, At, B1); PG8_BAR;
            PG8_LDA(At, 1, 1); PG8_STAGE(PG8_SA(1, 0), a3, voffA);
            PG8_BAR; PG8_WAIT_L(0); PG8_MMA(1, 0, At, B0); PG8_BAR; PG8_SCHED;
            PG8_STAGE(PG8_SB(1, 1), b3 + hstep, voffB);
            PG8_WAIT_V(6); PG8_BAR; PG8_MMA(1, 1, At, B1); PG8_BAR;
            }
        }
        if constexpr (ALIGN_EPI) { if (wr == 0) PG8_BAR; }
        if constexpr (!Epi::AFTER_DRAIN) { E(acc, cur, wr, wc, fr, fq); S.done(cur); }
        if (!has_next) break;
#pragma unroll
        for (int a = 0; a < 2; ++a)
#pragma unroll
            for (int b = 0; b < 2; ++b)
#pragma unroll
                for (int m = 0; m < 4; ++m)
#pragma unroll
                    for (int n = 0; n < 2; ++n) acc[a][b][m][n] = (f32x4){0.f, 0.f, 0.f, 0.f};
        cur = nxt; cA = nA; cB = nB; ++ui;
        if constexpr (ALIGN_EPI) { if (wr == 1) PG8_BAR; }
    }
    PG8_WAIT_V(0);
    if constexpr (!ALIGN_EPI) { if (wr == 0) PG8_BAR; }
    PG8_BAR;
    if constexpr (Epi::AFTER_DRAIN) { E.fused(acc, cur, wr, wc, fr, fq, lds, wid, lane); S.done(cur); }
#undef PG8_SA
#undef PG8_SB
#undef PG8_STAGE
#undef PG8_LDA
#undef PG8_LDB
#undef PG8_MMA
#undef PG8_WAIT_V
#undef PG8_WAIT_L
#undef PG8_BAR
#undef PG8_SCHED
}
}
namespace att {
using bf16 = __hip_bfloat16;
constexpr int   D = 128, NW = 8, QBLK = 32, KVBLK = 64;
constexpr float SCALE = 0.088388347648318440f;
constexpr float THR = 8.f;
constexpr int SDEPTH = 2;
constexpr int LDQ = 1024, LDK = 1024, LDO = 1024;
constexpr size_t SHM_V = KVBLK * D * 2, SHM_K = KVBLK * D * 2, SHM_ATTN = 2 * SHM_V + 2 * SHM_K + NW * 64 * 4;
__device__ __forceinline__ unsigned short f2bf_rne(float f) { unsigned u = __float_as_uint(f); return (unsigned short)((u + 0x7fffu + ((u >> 16) & 1u)) >> 16); }
using bf16x8 = __attribute__((ext_vector_type(8))) short;
using s16x4  = __attribute__((ext_vector_type(4))) short;
using f32x16 = __attribute__((ext_vector_type(16))) float;
using f32x8  = __attribute__((ext_vector_type(8))) float;
using u32x4  = __attribute__((ext_vector_type(4))) unsigned;
#define KSWZ(row, colB) ((row) * 256 + ((colB) ^ (((row) & 7) << 4)))
#define SBAR() __builtin_amdgcn_sched_barrier(0)
__device__ __forceinline__ int crow(int r, int hi) { return (r & 3) + 8 * (r >> 2) + 4 * hi; }
__device__ __forceinline__ unsigned cvtpk(float lo, float hi) {
  unsigned r; asm volatile("v_cvt_pk_bf16_f32 %0, %1, %2" : "=v"(r) : "v"(lo), "v"(hi)); return r;
}
template <typename TIn> struct Stage;
template <> struct Stage<bf16>  { using T = bf16x8;
  __device__ static __forceinline__ T ld8(const bf16* p) { return *reinterpret_cast<const bf16x8*>(p); }
  __device__ static __forceinline__ bf16x8 tobf(T x) { return x; } };
template <> struct Stage<float> { using T = f32x8;
  __device__ static __forceinline__ T ld8(const float* p) { return *reinterpret_cast<const f32x8*>(p); }
  __device__ static __forceinline__ bf16x8 tobf(T x) {
    u32x4 w = {cvtpk(x[0], x[1]), cvtpk(x[2], x[3]), cvtpk(x[4], x[5]), cvtpk(x[6], x[7])}; return *reinterpret_cast<bf16x8*>(&w); } };

__device__ __forceinline__ void partialSM(f32x16& p0, f32x16& p1, float& m_reg, float& mn, float& alpha) {
  constexpr float C = SCALE * 1.4426950408889634f;
  float pmax = p0[0]; _Pragma("unroll") for (int r = 1; r < 16; ++r) pmax = fmaxf(pmax, p0[r]); _Pragma("unroll") for (int r = 0; r < 16; ++r) pmax = fmaxf(pmax, p1[r]);
  { auto rr = __builtin_amdgcn_permlane32_swap(__float_as_uint(pmax), __float_as_uint(pmax), false, false);
    pmax = fmaxf(__uint_as_float(rr[0]), __uint_as_float(rr[1])); }
  if (__builtin_expect(__all(pmax - m_reg <= THR / SCALE), 1)) { mn = m_reg; alpha = 1.f; }
  else { mn = fmaxf(m_reg, pmax); alpha = __builtin_amdgcn_exp2f((m_reg - mn) * C); m_reg = mn; }
  float mnC = -mn * C;
  _Pragma("unroll") for (int r = 0; r < 16; ++r) p0[r] = fmaf(p0[r], C, mnC); _Pragma("unroll") for (int r = 0; r < 16; ++r) p1[r] = fmaf(p1[r], C, mnC);
  _Pragma("unroll") for (int r = 0; r < 16; ++r) p0[r] = __builtin_amdgcn_exp2f(p0[r]);
}
__device__ __forceinline__ void finishSM(f32x16& p0, f32x16& p1, float alpha, float& l_reg, bf16x8& pa0, bf16x8& pa1, bf16x8& pa2, bf16x8& pa3) {
  _Pragma("unroll") for (int r = 0; r < 16; ++r) p1[r] = __builtin_amdgcn_exp2f(p1[r]);
  float ps = 0; _Pragma("unroll") for (int r = 0; r < 16; ++r) ps += p0[r]; _Pragma("unroll") for (int r = 0; r < 16; ++r) ps += p1[r];
  { auto rr = __builtin_amdgcn_permlane32_swap(__float_as_uint(ps), __float_as_uint(ps), false, false);
    ps = __uint_as_float(rr[0]) + __uint_as_float(rr[1]); }
  l_reg = l_reg * alpha + ps;
#define PK4(P, BASE, OUT) do { unsigned a0 = cvtpk(P[BASE + 0], P[BASE + 1]), a1 = cvtpk(P[BASE + 2], P[BASE + 3]);   \
    unsigned b0 = cvtpk(P[BASE + 4], P[BASE + 5]), b1 = cvtpk(P[BASE + 6], P[BASE + 7]);                              \
    auto r0 = __builtin_amdgcn_permlane32_swap(a0, b0, false, false); auto r1 = __builtin_amdgcn_permlane32_swap(a1, b1, false, false); \
    u32x4 w = {r0[0], r1[0], r0[1], r1[1]}; OUT = *reinterpret_cast<bf16x8*>(&w); } while (0)
  PK4(p0, 0, pa0); PK4(p0, 8, pa1); PK4(p1, 0, pa2); PK4(p1, 8, pa3);
#undef PK4
}
__device__ __forceinline__ void qkt(f32x16& p0, f32x16& p1, const bf16* Ks, const bf16x8* qr, int r32, int hi) {
  p0 = f32x16{}; p1 = f32x16{};
  _Pragma("unroll") for (int d0 = 0; d0 < 8; ++d0) { int cb = (d0 * 16 + hi * 8) * 2;
    bf16x8 b0 = *reinterpret_cast<const bf16x8*>((const char*)Ks + KSWZ(r32, cb));
    bf16x8 b1 = *reinterpret_cast<const bf16x8*>((const char*)Ks + KSWZ(32 + r32, cb));
    p0 = __builtin_amdgcn_mfma_f32_32x32x16_bf16(b0, qr[d0], p0, 0, 0, 0);
    p1 = __builtin_amdgcn_mfma_f32_32x32x16_bf16(b1, qr[d0], p1, 0, 0, 0); }
}
__device__ __forceinline__ int v_st(int k, int c) { const int kk = (k & ~0xC) | ((k & 4) << 1) | ((k & 8) >> 1); return ((kk >> 3) * 4 + (c >> 5)) * 512 + ((kk & 7) * 32 + (c & 31)) * 2; }
__device__ __forceinline__ int v_rd_base(int lane) { return ((lane & 3) << 3) | (((lane >> 2) & 3) << 6) | (((lane >> 4) & 1) << 5) | (((lane >> 5) & 1) << 8); }
constexpr int v_rd_off(int d0, int ks, int half) { return d0 * 512 + ks * 4096 + half * 2048; }
template <int OFF> __device__ __forceinline__ s16x4 tr_read(int vb) {
  s16x4 r; asm volatile("ds_read_b64_tr_b16 %0, %1 offset:%2" : "=&v"(r) : "v"(vb), "i"(OFF) : "memory"); return r;
}
template <int D0> __device__ __forceinline__ void pv_one(f32x16& od, int vb, bf16x8 pa0, bf16x8 pa1, bf16x8 pa2, bf16x8 pa3) {
  const s16x4 l0 = tr_read<v_rd_off(D0, 0, 0)>(vb), h0 = tr_read<v_rd_off(D0, 0, 1)>(vb), l1 = tr_read<v_rd_off(D0, 1, 0)>(vb), h1 = tr_read<v_rd_off(D0, 1, 1)>(vb);
  const s16x4 l2 = tr_read<v_rd_off(D0, 2, 0)>(vb), h2 = tr_read<v_rd_off(D0, 2, 1)>(vb), l3 = tr_read<v_rd_off(D0, 3, 0)>(vb), h3 = tr_read<v_rd_off(D0, 3, 1)>(vb);
  asm volatile("s_waitcnt lgkmcnt(0)" ::: "memory"); SBAR();
#define PK(L, H) (bf16x8){L[0], L[1], L[2], L[3], H[0], H[1], H[2], H[3]}
  od = __builtin_amdgcn_mfma_f32_32x32x16_bf16(pa0, PK(l0, h0), od, 0, 0, 0);
  od = __builtin_amdgcn_mfma_f32_32x32x16_bf16(pa1, PK(l1, h1), od, 0, 0, 0);
  od = __builtin_amdgcn_mfma_f32_32x32x16_bf16(pa2, PK(l2, h2), od, 0, 0, 0);
  od = __builtin_amdgcn_mfma_f32_32x32x16_bf16(pa3, PK(l3, h3), od, 0, 0, 0);
#undef PK
}
__device__ __forceinline__ void pv_d0(f32x16* o, int vb, bf16x8 pa0, bf16x8 pa1, bf16x8 pa2, bf16x8 pa3) {
  pv_one<0>(o[0], vb, pa0, pa1, pa2, pa3); pv_one<1>(o[1], vb, pa0, pa1, pa2, pa3); pv_one<2>(o[2], vb, pa0, pa1, pa2, pa3); pv_one<3>(o[3], vb, pa0, pa1, pa2, pa3);
}
__device__ __forceinline__ void attn_dense_body(const bf16* __restrict__ Qb, const bf16* __restrict__ Kh, const bf16* __restrict__ Vh,
                                                float* O1b, unsigned short* O2b, const int pass, const float lam, int seq, char* lds) {
  using St = Stage<bf16>; using SQ = Stage<bf16>;
  int tid_ = threadIdx.x; asm volatile("" : "+v"(tid_));
  const int tid = tid_, wid = tid >> 6, lane = tid & 63, r32 = lane & 31, hi = lane >> 5;
  bf16* V_lds = (bf16*)lds; bf16* K_lds = (bf16*)(lds + 2 * SHM_V);
  float* ws = (float*)(lds + 2 * SHM_V + 2 * SHM_K) + wid * 64; float* li_l = ws; float* al_l = ws + 32;
  float m_reg = -1e30f, l_reg = 0; f32x16 o[4] = {}; bf16x8 qr[8];
  const bf16* Qw = Qb + (long)(wid * QBLK + r32) * LDQ + hi * 8;
  _Pragma("unroll") for (int d0 = 0; d0 < 8; ++d0) qr[d0] = SQ::tobf(SQ::ld8(Qw + d0 * 16));
  const int sr = tid >> 4, sc = (tid & 15) * 8, vst0 = v_st(sr, sc), vst1 = v_st(32 + sr, sc);
  const int vb0 = (int)(uintptr_t)V_lds + v_rd_base(lane);
  struct { typename St::T vs0, vs1, ks0, ks1; } sr_[SDEPTH];
#define SLOAD(i, k0) do { sr_[i].vs0 = St::ld8(&Vh[(long)((k0) + sr) * LDK + sc]); sr_[i].vs1 = St::ld8(&Vh[(long)((k0) + 32 + sr) * LDK + sc]); \
    sr_[i].ks0 = St::ld8(&Kh[(long)((k0) + sr) * LDK + sc]); sr_[i].ks1 = St::ld8(&Kh[(long)((k0) + 32 + sr) * LDK + sc]); } while (0)
#define SWRITE(b, i) do { *(bf16x8*)((char*)V_lds + (b) * SHM_V + vst0) = St::tobf(sr_[i].vs0);          \
    *(bf16x8*)((char*)V_lds + (b) * SHM_V + vst1) = St::tobf(sr_[i].vs1); int kc = sc * 2;               \
    *(bf16x8*)((char*)K_lds + (b) * SHM_K + KSWZ(sr, kc)) = St::tobf(sr_[i].ks0);                       \
    *(bf16x8*)((char*)K_lds + (b) * SHM_K + KSWZ(32 + sr, kc)) = St::tobf(sr_[i].ks1); } while (0)
#define SWAIT() do { if constexpr (SDEPTH == 2) asm volatile("s_waitcnt vmcnt(4)" ::: "memory"); else asm volatile("s_waitcnt vmcnt(0)" ::: "memory"); } while (0)
#define RESC(a) do { if (__any((a) < 1.f)) { if (hi == 0) al_l[r32] = (a); asm volatile("s_waitcnt lgkmcnt(0)" ::: "memory"); \
    _Pragma("unroll") for (int d = 0; d < 4; ++d) _Pragma("unroll") for (int r = 0; r < 16; ++r) o[d][r] *= al_l[crow(r, hi)]; } } while (0)
  f32x16 pA0, pA1, pB0, pB1; float mnA, mnB, alA, alB; bf16x8 pa0, pa1, pa2, pa3; const int NT = seq / KVBLK;
  constexpr int SE = 0, SO = SDEPTH - 1;
  SLOAD(SE, 0); asm volatile("s_waitcnt vmcnt(0)" ::: "memory"); SWRITE(0, SE); __syncthreads();
  qkt(pA0, pA1, K_lds, qr, r32, hi); partialSM(pA0, pA1, m_reg, mnA, alA);
  SLOAD(SO, KVBLK); if constexpr (SDEPTH == 2) { if (2 < NT) SLOAD(SE, 2 * KVBLK); }
  SWAIT(); SWRITE(1, SO); __syncthreads();
  for (int j = 1; j + 1 < NT; j += 2) {
    SBAR(); qkt(pB0, pB1, (bf16*)((char*)K_lds + SHM_K), qr, r32, hi);
    finishSM(pA0, pA1, alA, l_reg, pa0, pa1, pa2, pa3); SBAR();
    SLOAD(SO, (j + SDEPTH) * KVBLK); SBAR();
    pv_d0(o, vb0, pa0, pa1, pa2, pa3); partialSM(pB0, pB1, m_reg, mnB, alB);
    __syncthreads(); SWAIT(); SWRITE(0, SE);
    RESC(alB); __syncthreads();
    SBAR(); qkt(pA0, pA1, K_lds, qr, r32, hi);
    finishSM(pB0, pB1, alB, l_reg, pa0, pa1, pa2, pa3); SBAR();
    if (SDEPTH == 1 || j + 3 < NT) SLOAD(SE, (j + 1 + SDEPTH) * KVBLK); SBAR();
    pv_d0(o, vb0 + (int)SHM_V, pa0, pa1, pa2, pa3); partialSM(pA0, pA1, m_reg, mnA, alA);
    __syncthreads(); SWAIT(); SWRITE(1, SO);
    RESC(alA); __syncthreads();
  }
  SBAR(); qkt(pB0, pB1, (bf16*)((char*)K_lds + SHM_K), qr, r32, hi);
  finishSM(pA0, pA1, alA, l_reg, pa0, pa1, pa2, pa3); SBAR();
  pv_d0(o, vb0, pa0, pa1, pa2, pa3); partialSM(pB0, pB1, m_reg, mnB, alB);
  __syncthreads(); RESC(alB);
  finishSM(pB0, pB1, alB, l_reg, pa0, pa1, pa2, pa3); SBAR();
  pv_d0(o, vb0 + (int)SHM_V, pa0, pa1, pa2, pa3);
  if (hi == 0) li_l[r32] = l_reg; asm volatile("s_waitcnt lgkmcnt(0)" ::: "memory");
  float rli[16];
  _Pragma("unroll") for (int r = 0; r < 16; ++r) rli[r] = __builtin_amdgcn_rcpf(li_l[crow(r, hi)]);
  float* Ow = O1b + (long)(wid * QBLK) * LDO; unsigned short* Cw = O2b + (long)(wid * QBLK) * LDO;
  _Pragma("unroll") for (int r = 0; r < 16; ++r) { int orow = crow(r, hi);
    _Pragma("unroll") for (int d0 = 0; d0 < 4; ++d0) { const long idx = (long)orow * LDO + d0 * 32 + r32; const float val = o[d0][r] * rli[r];
      if (pass == 0) Ow[idx] = val; else Cw[idx] = f2bf_rne(Ow[idx] - lam * val); } }
#undef SLOAD
#undef SWRITE
#undef SWAIT
#undef RESC
}
}
namespace att2 {
using namespace att;
constexpr int KBUF = 16384, VBUF = 32768, L_K = 0, L_V = 3 * KBUF, L_WS = 3 * KBUF + 3 * VBUF;
__device__ __forceinline__ void glds16(const void* gsrc, unsigned lds_dst) { unsigned keep;
  asm volatile("s_mov_b32 %0, m0\n\ts_mov_b32 m0, %2\n\ts_nop 0\n\tglobal_load_lds_dwordx4 %1, off\n\ts_mov_b32 m0, %0" : "=&s"(keep) : "v"(gsrc), "s"(lds_dst) : "memory"); }
constexpr int v_rd_off8(int d0, int ks, int half) { return d0 * 512 + ks * 8192 + half * 4096; }
template <int D0> __device__ __forceinline__ void pv_one8(f32x16& od, int vb, bf16x8 pa0, bf16x8 pa1, bf16x8 pa2, bf16x8 pa3) {
  const s16x4 l0 = tr_read<v_rd_off8(D0, 0, 0)>(vb), h0 = tr_read<v_rd_off8(D0, 0, 1)>(vb), l1 = tr_read<v_rd_off8(D0, 1, 0)>(vb), h1 = tr_read<v_rd_off8(D0, 1, 1)>(vb);
  const s16x4 l2 = tr_read<v_rd_off8(D0, 2, 0)>(vb), h2 = tr_read<v_rd_off8(D0, 2, 1)>(vb), l3 = tr_read<v_rd_off8(D0, 3, 0)>(vb), h3 = tr_read<v_rd_off8(D0, 3, 1)>(vb);
  asm volatile("s_waitcnt lgkmcnt(0)" ::: "memory"); SBAR();
#define PK(L, H) (bf16x8){L[0], L[1], L[2], L[3], H[0], H[1], H[2], H[3]}
  od = __builtin_amdgcn_mfma_f32_32x32x16_bf16(pa0, PK(l0, h0), od, 0, 0, 0);
  od = __builtin_amdgcn_mfma_f32_32x32x16_bf16(pa1, PK(l1, h1), od, 0, 0, 0);
  od = __builtin_amdgcn_mfma_f32_32x32x16_bf16(pa2, PK(l2, h2), od, 0, 0, 0);
  od = __builtin_amdgcn_mfma_f32_32x32x16_bf16(pa3, PK(l3, h3), od, 0, 0, 0);
#undef PK
}
__device__ __forceinline__ void attn256_body(const bf16* __restrict__ Qb, const bf16* __restrict__ Kh, const bf16* __restrict__ Vh, float* O1b, unsigned short* O2b,
                                             const int pass, const float lam, int seq, char* lds) {
  int tid_ = threadIdx.x; asm volatile("" : "+v"(tid_));
  const int tid = tid_, lane = tid & 63, r32 = lane & 31, hi = lane >> 5; const int wid = __builtin_amdgcn_readfirstlane(tid >> 6);
  const unsigned lds0 = (unsigned)(uintptr_t)lds;
  float* ws = (float*)(lds + L_WS) + wid * 64; float* li_l = ws; float* al_l = ws + 32;
  float m_reg = -1e30f, l_reg = 0; f32x16 o[8] = {}; bf16x8 qr[8];
  const bf16* Qw = Qb + (long)(wid * QBLK + r32) * LDQ + hi * 8;
  _Pragma("unroll") for (int d0 = 0; d0 < 8; ++d0) qr[d0] = *reinterpret_cast<const bf16x8*>(Qw + d0 * 16);
  long ksrc[2], vsrc[4];
  _Pragma("unroll") for (int p = 0; p < 2; ++p) { const int q = wid * 2 + p, row = 4 * q + (lane >> 4), c = (lane & 15) ^ (row & 7); ksrc[p] = (long)row * LDK + c * 8; }
  _Pragma("unroll") for (int p = 0; p < 4; ++p) { const int q = wid * 4 + p, s = 2 * q + (lane >> 5), kgrp = s >> 3, cb = s & 7, rowin = (lane & 31) >> 2, chunk = lane & 3;
    const int kk = kgrp * 8 + rowin, key = (kk & ~0xC) | ((kk & 4) << 1) | ((kk & 8) >> 1); vsrc[p] = (long)key * LDK + cb * 32 + chunk * 8; }
#define DMA_TILE(t, kb, vo) do { const bf16* kt_ = Kh + (long)(t) * KVBLK * LDK; const bf16* vt_ = Vh + (long)(t) * KVBLK * LDK; \
    _Pragma("unroll") for (int p = 0; p < 2; ++p) glds16(kt_ + ksrc[p], (unsigned)__builtin_amdgcn_readfirstlane(lds0 + L_K + (kb) * KBUF + (wid * 2 + p) * 1024)); \
    _Pragma("unroll") for (int p = 0; p < 4; ++p) glds16(vt_ + vsrc[p], (unsigned)__builtin_amdgcn_readfirstlane(lds0 + L_V + (vo) + (wid * 4 + p) * 1024)); } while (0)
#define PV_RD(S, D0) do { S##l0 = tr_read<v_rd_off8(D0, 0, 0)>(vb); S##h0 = tr_read<v_rd_off8(D0, 0, 1)>(vb); S##l1 = tr_read<v_rd_off8(D0, 1, 0)>(vb); S##h1 = tr_read<v_rd_off8(D0, 1, 1)>(vb); \
    S##l2 = tr_read<v_rd_off8(D0, 2, 0)>(vb); S##h2 = tr_read<v_rd_off8(D0, 2, 1)>(vb); S##l3 = tr_read<v_rd_off8(D0, 3, 0)>(vb); S##h3 = tr_read<v_rd_off8(D0, 3, 1)>(vb); } while (0)
#define PV_PK(L, H) (bf16x8){L[0], L[1], L[2], L[3], H[0], H[1], H[2], H[3]}
#define PV_MM(S, D0) do { o[D0] = __builtin_amdgcn_mfma_f32_32x32x16_bf16(pa0, PV_PK(S##l0, S##h0), o[D0], 0, 0, 0); o[D0] = __builtin_amdgcn_mfma_f32_32x32x16_bf16(pa1, PV_PK(S##l1, S##h1), o[D0], 0, 0, 0); \
    o[D0] = __builtin_amdgcn_mfma_f32_32x32x16_bf16(pa2, PV_PK(S##l2, S##h2), o[D0], 0, 0, 0); o[D0] = __builtin_amdgcn_mfma_f32_32x32x16_bf16(pa3, PV_PK(S##l3, S##h3), o[D0], 0, 0, 0); } while (0)
#define PV_W8() do { asm volatile("s_waitcnt lgkmcnt(8)" ::: "memory"); SBAR(); } while (0)
#define PV_W0() do { asm volatile("s_waitcnt lgkmcnt(0)" ::: "memory"); SBAR(); } while (0)
#define PV8(vb_) do { const int vb = (vb_); s16x4 Al0, Ah0, Al1, Ah1, Al2, Ah2, Al3, Ah3, Bl0, Bh0, Bl1, Bh1, Bl2, Bh2, Bl3, Bh3; \
    PV_RD(A, 0); PV_RD(B, 1); PV_W8(); PV_MM(A, 0); SBAR(); PV_RD(A, 2); PV_W8(); PV_MM(B, 1); SBAR(); PV_RD(B, 3); PV_W8(); PV_MM(A, 2); SBAR(); PV_RD(A, 4); PV_W8(); PV_MM(B, 3); SBAR(); \
    PV_RD(B, 5); PV_W8(); PV_MM(A, 4); SBAR(); PV_RD(A, 6); PV_W8(); PV_MM(B, 5); SBAR(); PV_RD(B, 7); PV_W8(); PV_MM(A, 6); SBAR(); PV_W0(); PV_MM(B, 7); } while (0)
  const int vb0 = (int)lds0 + L_V + v_rd_base(lane);
  const int NT = seq / KVBLK;
  bf16x8 pa0, pa1, pa2, pa3;
  DMA_TILE(0, 0, 0); if (NT > 1) DMA_TILE(1, 1, VBUF);
  int scur = 0, snext2 = 2;
  for (int j = 0; j < NT; ++j) {
    if (j + 1 < NT) asm volatile("s_waitcnt vmcnt(6) lgkmcnt(0)\n\ts_barrier" ::: "memory");
    else            asm volatile("s_waitcnt vmcnt(0) lgkmcnt(0)\n\ts_barrier" ::: "memory");
    if (j + 2 < NT) DMA_TILE(j + 2, snext2, snext2 * VBUF);
    f32x16 p0, p1; float mn, alpha;
    qkt(p0, p1, (const bf16*)(lds + L_K + scur * KBUF), qr, r32, hi);
    partialSM(p0, p1, m_reg, mn, alpha);
    if (__any(alpha < 1.f)) { if (hi == 0) al_l[r32] = alpha; asm volatile("s_waitcnt lgkmcnt(0)" ::: "memory");
      _Pragma("unroll") for (int d = 0; d < 8; ++d) _Pragma("unroll") for (int r = 0; r < 16; ++r) o[d][r] *= al_l[crow(r, hi)]; }
    finishSM(p0, p1, alpha, l_reg, pa0, pa1, pa2, pa3); SBAR();
    PV8(vb0 + scur * VBUF);
    scur = (scur == 2) ? 0 : scur + 1; snext2 = (snext2 == 2) ? 0 : snext2 + 1;
  }
#undef PV8
#undef PV_RD
#undef PV_PK
#undef PV_MM
#undef PV_W8
#undef PV_W0
#undef DMA_TILE
  if (hi == 0) li_l[r32] = l_reg; asm volatile("s_waitcnt lgkmcnt(0)" ::: "memory");
  float rli[16];
  _Pragma("unroll") for (int r = 0; r < 16; ++r) rli[r] = __builtin_amdgcn_rcpf(li_l[crow(r, hi)]);
  float* Ow = O1b + (long)(wid * QBLK) * LDO; unsigned short* Cw = O2b + (long)(wid * QBLK) * LDO;
  _Pragma("unroll") for (int r = 0; r < 16; ++r) { const int orow = crow(r, hi);
    _Pragma("unroll") for (int d0 = 0; d0 < 8; ++d0) { const long idx = (long)orow * LDO + d0 * 32 + r32; const float val = o[d0][r] * rli[r];
      if (pass == 0) Ow[idx] = val; else Cw[idx] = f2bf_rne(Ow[idx] - lam * val); } }
  asm volatile("s_waitcnt lgkmcnt(0)\n\ts_barrier" ::: "memory");
}
}
typedef unsigned short bf16_t;
typedef float f32x4 __attribute__((ext_vector_type(4)));
typedef unsigned u32x4 __attribute__((ext_vector_type(4)));
typedef unsigned u32x2 __attribute__((ext_vector_type(2)));
constexpr int DM = 1024, SEQ = 4096, NBATCH = 16, NTOK = NBATCH * SEQ;
constexpr int NGRP = 2, GB = NBATCH / NGRP, TG = GB * SEQ;
constexpr int INW = 8224, NIN = 8448;
constexpr int FFH = 2816, NFI = 2 * FFH;
constexpr float EPS = 1e-6f, SUBLN_EPS = 1e-5f, LAMBDA_INIT = 0.2f;
constexpr size_t MiB = 1u << 20;
constexpr size_t WS_CTL = 0;
constexpr size_t WS_SS1 = 4096, WS_SS2 = 4096 + 262144;
constexpr size_t WS_BAR = 768 * 1024, WS_BAR_BYTES = 16384;
constexpr size_t WS_ROPE = 1 * MiB;
constexpr size_t WS_WIN = 4 * MiB;
constexpr size_t WS_WOUT = 21 * MiB;
constexpr size_t WS_WFI = 23 * MiB;
constexpr size_t WS_WFO = 34 * MiB;
constexpr size_t WS_MERGED = 40 * MiB;
constexpr size_t WS_U = 168 * MiB;
constexpr size_t WS_GQ = 296 * MiB, WS_GK = 328 * MiB, WS_GV = 360 * MiB, WS_GR = 424 * MiB, WS_DQ = 488 * MiB, WS_DK = 552 * MiB, WS_DV = 616 * MiB,
                 WS_GA = 680 * MiB, WS_GB = 744 * MiB, WS_GLR = 808 * MiB;
constexpr size_t WS_OF = 812 * MiB, WS_OB = 876 * MiB, WS_O2C = 940 * MiB, WS_DEC = 1004 * MiB, WS_END = 1006 * MiB;
constexpr size_t OUT_QT = 128 * MiB, OUT_KST = 192 * MiB;
constexpr size_t WS_H1B = 296 * MiB, WS_ACT = 424 * MiB;
static_assert(WS_ACT + (size_t)NTOK * FFH * 2 <= WS_GLR, "tail overlay");
constexpr int LDS_BYTES = 151552;
constexpr int NPHASE = 13;

__device__ __forceinline__ float bf2f(unsigned short b) { return __uint_as_float((unsigned)b << 16); }
__device__ __forceinline__ unsigned short f2bf(float f) { return (unsigned short)pg8::cvt_pk_bf16(f, f); }
__device__ __forceinline__ unsigned pk2(float lo, float hi) { return pg8::cvt_pk_bf16(lo, hi); }
__device__ __forceinline__ float wave_sum(float v) {
#pragma unroll
    for (int o = 1; o < 64; o <<= 1) v += __shfl_xor(v, o);
    return v;
}
__device__ __forceinline__ float sigmoidf_(float x) { return __builtin_amdgcn_rcpf(1.f + __expf(-x)); }

struct EpiIn {
    static constexpr bool PERM = true, AFTER_DRAIN = false;
    bf16_t *GQ, *GK, *GV, *GR, *DQ, *DK, *DV, *GA, *GB; float* GLR; const float* rope;
    __device__ __forceinline__ void operator()(const pg8::f32x4 (&acc)[2][2][4][2], const pg8::Unit& u, int wr, int wc, int fr, int fq) const {
        const int pn = u.pn; const int row0 = u.pm * 256 + wr * 64 + fr;
        if (pn == 32) {
            if (wc == 0) {
#pragma unroll
                for (int ai = 0; ai < 2; ++ai)
#pragma unroll
                    for (int m = 0; m < 4; ++m) { float* p = GLR + (size_t)(row0 + ai * 128 + m * 16) * 32 + 8 * fq;
                        *(f32x4*)p = acc[ai][0][m][0]; *(f32x4*)(p + 4) = acc[ai][0][m][1]; }
            }
            return;
        }
        if (pn >= 12 && pn < 20) {
            bf16_t* base = (pn < 16) ? DQ : DK; const int colt = ((pn - 12) & 3) * 256 + (wc >> 1) * 128; const int i0 = (wc & 1) * 32 + 8 * fq;
#pragma unroll
            for (int ai = 0; ai < 2; ++ai) {
                f32x4 tb[4][4];
#pragma unroll
                for (int m = 0; m < 4; ++m) { const int pos = (row0 + ai * 128 + m * 16) & (SEQ - 1); const f32x4* cs = (const f32x4*)(rope + ((size_t)pos * 64 + i0) * 2);
                    tb[m][0] = cs[0]; tb[m][1] = cs[1]; tb[m][2] = cs[2]; tb[m][3] = cs[3]; }
#pragma unroll
                for (int m = 0; m < 4; ++m) { const int row = row0 + ai * 128 + m * 16;
                    const f32x4 t0 = tb[m][0], t1 = tb[m][1], t2 = tb[m][2], t3 = tb[m][3];
                    const f32x4 xa = acc[ai][0][m][0], xb = acc[ai][0][m][1], ya = acc[ai][1][m][0], yb = acc[ai][1][m][1];
                    u32x4 w1, w2;
                    w1.x = pg8::cvt_pk_bf16(xa[0] * t0[0] - ya[0] * t0[1], xa[1] * t0[2] - ya[1] * t0[3]);
                    w1.y = pg8::cvt_pk_bf16(xa[2] * t1[0] - ya[2] * t1[1], xa[3] * t1[2] - ya[3] * t1[3]);
                    w1.z = pg8::cvt_pk_bf16(xb[0] * t2[0] - yb[0] * t2[1], xb[1] * t2[2] - yb[1] * t2[3]);
                    w1.w = pg8::cvt_pk_bf16(xb[2] * t3[0] - yb[2] * t3[1], xb[3] * t3[2] - yb[3] * t3[3]);
                    w2.x = pg8::cvt_pk_bf16(ya[0] * t0[0] + xa[0] * t0[1], ya[1] * t0[2] + xa[1] * t0[3]);
                    w2.y = pg8::cvt_pk_bf16(ya[2] * t1[0] + xa[2] * t1[1], ya[3] * t1[2] + xa[3] * t1[3]);
                    w2.z = pg8::cvt_pk_bf16(yb[0] * t2[0] + xb[0] * t2[1], yb[1] * t2[2] + xb[1] * t2[3]);
                    w2.w = pg8::cvt_pk_bf16(yb[2] * t3[0] + xb[2] * t3[1], yb[3] * t3[2] + xb[3] * t3[3]);
                    bf16_t* rp = base + (size_t)row * 1024 + colt + i0;
                    *(u32x4*)rp = w1; *(u32x4*)(rp + 64) = w2; } }
            return;
        }
        bf16_t* base; int ld, colt;
        if (pn < 2) { base = GQ; ld = 512; colt = pn * 256; }
        else if (pn < 4) { base = GK; ld = 512; colt = (pn - 2) * 256; }
        else if (pn < 8) { base = GV; ld = 1024; colt = (pn - 4) * 256; }
        else if (pn < 12) { base = GR; ld = 1024; colt = (pn - 8) * 256; }
        else if (pn < 24) { base = DV; ld = 1024; colt = (pn - 20) * 256; }
        else if (pn < 28) { base = GA; ld = 1024; colt = (pn - 24) * 256; }
        else { base = GB; ld = 1024; colt = (pn - 28) * 256; }
        const int col0 = colt + wc * 32 + 8 * fq;
#pragma unroll
        for (int ai = 0; ai < 2; ++ai)
#pragma unroll
            for (int m = 0; m < 4; ++m) { bf16_t* rowp = base + (size_t)(row0 + ai * 128 + m * 16) * ld + col0;
#pragma unroll
                for (int bj = 0; bj < 2; ++bj) { const f32x4 v0 = acc[ai][bj][m][0], v1 = acc[ai][bj][m][1]; u32x4 w;
                    w.x = pg8::cvt_pk_bf16(v0[0], v0[1]); w.y = pg8::cvt_pk_bf16(v0[2], v0[3]); w.z = pg8::cvt_pk_bf16(v1[0], v1[1]); w.w = pg8::cvt_pk_bf16(v1[2], v1[3]);
                    *(u32x4*)(rowp + bj * 128) = w; } }
    }
};
struct EpiOutProj {
    static constexpr bool PERM = true, AFTER_DRAIN = false;
    const float* base; bf16_t* hb; float* ss;
    __device__ __forceinline__ void operator()(const pg8::f32x4 (&acc)[2][2][4][2], const pg8::Unit& u, int wr, int wc, int fr, int fq) const {
        const int row0 = u.pm * 256 + wr * 64 + fr; const int col0 = u.pn * 256 + wc * 32 + 8 * fq;
#pragma unroll
        for (int ai = 0; ai < 2; ++ai) {
            f32x4 xb[4][2][2];
#pragma unroll
            for (int m = 0; m < 4; ++m) { const size_t off = (size_t)(row0 + ai * 128 + m * 16) * 1024 + col0;
#pragma unroll
                for (int bj = 0; bj < 2; ++bj) { xb[m][bj][0] = *(const f32x4*)(base + off + bj * 128); xb[m][bj][1] = *(const f32x4*)(base + off + bj * 128 + 4); } }
#pragma unroll
            for (int m = 0; m < 4; ++m) { const int row = row0 + ai * 128 + m * 16; const size_t off = (size_t)row * 1024 + col0; float s = 0.f;
#pragma unroll
                for (int bj = 0; bj < 2; ++bj) {
                    const f32x4 b0 = xb[m][bj][0], b1 = xb[m][bj][1];
                    const f32x4 h0 = b0 + acc[ai][bj][m][0], h1 = b1 + acc[ai][bj][m][1];
                    s += (h0[0] * h0[0] + h0[1] * h0[1]) + (h0[2] * h0[2] + h0[3] * h0[3]) + (h1[0] * h1[0] + h1[1] * h1[1]) + (h1[2] * h1[2] + h1[3] * h1[3]);
                    u32x4 w; w.x = pg8::cvt_pk_bf16(h0[0], h0[1]); w.y = pg8::cvt_pk_bf16(h0[2], h0[3]); w.z = pg8::cvt_pk_bf16(h1[0], h1[1]); w.w = pg8::cvt_pk_bf16(h1[2], h1[3]);
                    *(u32x4*)(hb + off + bj * 128) = w;
                }
                s += __shfl_xor(s, 16); s += __shfl_xor(s, 32);
                if (fq == 0) atomicAdd(ss + row, s); } }
    }
};
struct EpiFfnOut {
    static constexpr bool PERM = true, AFTER_DRAIN = false;
    const bf16_t* hb; bf16_t* out; float* ss;
    __device__ __forceinline__ void operator()(const pg8::f32x4 (&acc)[2][2][4][2], const pg8::Unit& u, int wr, int wc, int fr, int fq) const {
        const int row0 = u.pm * 256 + wr * 64 + fr; const int col0 = u.pn * 256 + wc * 32 + 8 * fq;
#pragma unroll
        for (int ai = 0; ai < 2; ++ai) {
            u32x4 hq[4][2];
#pragma unroll
            for (int m = 0; m < 4; ++m) { const size_t off = (size_t)(row0 + ai * 128 + m * 16) * 1024 + col0; hq[m][0] = *(const u32x4*)(hb + off); hq[m][1] = *(const u32x4*)(hb + off + 128); }
#pragma unroll
            for (int m = 0; m < 4; ++m) { const int row = row0 + ai * 128 + m * 16; const size_t off = (size_t)row * 1024 + col0; float s = 0.f;
#pragma unroll
                for (int bj = 0; bj < 2; ++bj) {
                    const u32x4 hw = hq[m][bj];
                    f32x4 h0, h1;
                    h0[0] = __uint_as_float(hw.x << 16) + acc[ai][bj][m][0][0]; h0[1] = __uint_as_float(hw.x & 0xffff0000u) + acc[ai][bj][m][0][1];
                    h0[2] = __uint_as_float(hw.y << 16) + acc[ai][bj][m][0][2]; h0[3] = __uint_as_float(hw.y & 0xffff0000u) + acc[ai][bj][m][0][3];
                    h1[0] = __uint_as_float(hw.z << 16) + acc[ai][bj][m][1][0]; h1[1] = __uint_as_float(hw.z & 0xffff0000u) + acc[ai][bj][m][1][1];
                    h1[2] = __uint_as_float(hw.w << 16) + acc[ai][bj][m][1][2]; h1[3] = __uint_as_float(hw.w & 0xffff0000u) + acc[ai][bj][m][1][3];
                    { u32x4 w; w.x = pg8::cvt_pk_bf16(h0[0], h0[1]); w.y = pg8::cvt_pk_bf16(h0[2], h0[3]); w.z = pg8::cvt_pk_bf16(h1[0], h1[1]); w.w = pg8::cvt_pk_bf16(h1[2], h1[3]); *(u32x4*)(out + off + bj * 128) = w; }
                    s += (h0[0] * h0[0] + h0[1] * h0[1]) + (h0[2] * h0[2] + h0[3] * h0[3]) + (h1[0] * h1[0] + h1[1] * h1[1]) + (h1[2] * h1[2] + h1[3] * h1[3]);
                }
                s += __shfl_xor(s, 16); s += __shfl_xor(s, 32);
                if (fq == 0) atomicAdd(ss + row, s); } }
    }
};
struct EpiFfnIn {
    static constexpr bool PERM = true, AFTER_DRAIN = false;
    const float* ss; bf16_t* act;
    __device__ __forceinline__ void operator()(const pg8::f32x4 (&acc)[2][2][4][2], const pg8::Unit& u, int wr, int wc, int fr, int fq) const {
        const int row0 = u.pm * 256 + wr * 64 + fr; const int col0 = u.pn * 128 + wc * 32 + 8 * fq;
        float rsv[2][4];
#pragma unroll
        for (int ai = 0; ai < 2; ++ai)
#pragma unroll
            for (int m = 0; m < 4; ++m) rsv[ai][m] = ss[row0 + ai * 128 + m * 16];
#pragma unroll
        for (int ai = 0; ai < 2; ++ai)
#pragma unroll
            for (int m = 0; m < 4; ++m) { const int row = row0 + ai * 128 + m * 16; const float rstd = rsqrtf(rsv[ai][m] * (1.f / 1024.f) + EPS);
                float o[8];
#pragma unroll
                for (int n = 0; n < 2; ++n)
#pragma unroll
                    for (int e = 0; e < 4; ++e) { const float g = acc[ai][0][m][n][e] * rstd, up = acc[ai][1][m][n][e] * rstd; o[n * 4 + e] = g * sigmoidf_(g) * up; }
                u32x4 w; w.x = pg8::cvt_pk_bf16(o[0], o[1]); w.y = pg8::cvt_pk_bf16(o[2], o[3]); w.z = pg8::cvt_pk_bf16(o[4], o[5]); w.w = pg8::cvt_pk_bf16(o[6], o[7]);
                *(u32x4*)(act + (size_t)row * FFH + col0) = w; }
    }
};

namespace gla {
#define LBAR() do { asm volatile("s_waitcnt lgkmcnt(0)" ::: "memory"); __builtin_amdgcn_s_barrier(); asm volatile("" ::: "memory"); } while (0)
using att::bf16x8; using att::f32x16;
constexpr int LQ = 136, LV = 72;
__device__ __forceinline__ int crow(int r, int hi) { return (r & 3) + 8 * (r >> 2) + 4 * hi; }
constexpr int P_QT = 0, P_KT = 17408, P_GLR = 34816, P_SEG = 38912;
struct Raw { unsigned qv[8], kv[8]; f32x4 gl; };
struct Wd { float wa[16], wb[16]; float ba, bb; };
#define PREP_LOAD(R, item) do { const int dir_ = (item) & 1, h_ = ((item) >> 1) & 3, c_ = ((item) >> 3) & 63, bl_ = (item) >> 9; \
        const long rowb_ = (long)bl_ * SEQ; const int sgn_ = dir_ ? -1 : 1; const int t0_ = dir_ ? (SEQ - 1 - c_ * 64) : c_ * 64; \
        _Pragma("unroll") for (int ii = 0; ii < 8; ++ii) { const long row = rowb_ + t0_ + sgn_ * (seg * 8 + ii); R.qv[ii] = *(const unsigned*)(GQ + row * 512 + h_ * 128 + 2 * d); R.kv[ii] = *(const unsigned*)(GK + row * 512 + h_ * 128 + 2 * d); } \
        if (tid < 256) { const int i = tid >> 2, r4 = tid & 3; R.gl = *(const f32x4*)(GLR + (rowb_ + t0_ + sgn_ * i) * 32 + dir_ * 16 + r4 * 4); } \
        } while (0)
#define PREP_LOADW(W, item) do { const int dir_ = (item) & 1, h_ = ((item) >> 1) & 3; \
        _Pragma("unroll") for (int r = 0; r < 16; ++r) { W.wa[r] = w2g[(dir_ * 16 + r) * 512 + h_ * 128 + 2 * d]; W.wb[r] = w2g[(dir_ * 16 + r) * 512 + h_ * 128 + 2 * d + 1]; } \
        W.ba = bg[dir_ * 512 + h_ * 128 + 2 * d]; W.bb = bg[dir_ * 512 + h_ * 128 + 2 * d + 1]; } while (0)
__device__ __forceinline__ void prep_compute(const Raw& R, const Wd& W, const int it, bf16_t* QT, bf16_t* KST, float* DEC, bf16_t* AM, char* lds,
                                             const int tid, const int lane, const int wid, const int r32, const int hi, const int d, const int seg) {
    bf16_t* Qt = (bf16_t*)(lds + P_QT); bf16_t* Kt = (bf16_t*)(lds + P_KT);
    float* glr_s = (float*)(lds + P_GLR); float* segsum = (float*)(lds + P_SEG);
    typedef float f32x2_ __attribute__((ext_vector_type(2)));
        const int dir = it & 1, h = (it >> 1) & 3, c = (it >> 3) & 63, bl = it >> 9;
        const long rowb = (long)bl * SEQ;
        const size_t cidx = (((size_t)dir * GB + bl) * 4 + h) * 64 + c;
        if (tid < 256) *(f32x4*)(glr_s + (tid >> 2) * 16 + (tid & 3) * 4) = R.gl;
        LBAR();
        float csa[8], csb[8]; float runa = 0.f, runb = 0.f;
#pragma unroll
        for (int ii = 0; ii < 8; ++ii) { const f32x4* gp = (const f32x4*)(glr_s + (seg * 8 + ii) * 16); float la = W.ba, lb = W.bb;
#pragma unroll
            for (int r4 = 0; r4 < 4; ++r4) { const f32x4 gv = gp[r4];
                la += gv[0] * W.wa[4 * r4] + gv[1] * W.wa[4 * r4 + 1] + gv[2] * W.wa[4 * r4 + 2] + gv[3] * W.wa[4 * r4 + 3];
                lb += gv[0] * W.wb[4 * r4] + gv[1] * W.wb[4 * r4 + 1] + gv[2] * W.wb[4 * r4 + 2] + gv[3] * W.wb[4 * r4 + 3]; }
            const float sa = fminf(la, 0.f) - __logf(1.f + __expf(-fabsf(la))), sb = fminf(lb, 0.f) - __logf(1.f + __expf(-fabsf(lb)));
            runa += sa * (1.f / 16.f); runb += sb * (1.f / 16.f); csa[ii] = runa; csb[ii] = runb; }
        *(f32x2_*)(segsum + seg * 128 + 2 * d) = (f32x2_){runa, runb};
        LBAR();
        float prea = 0.f, preb = 0.f, tota = 0.f, totb = 0.f;
#pragma unroll
        for (int s = 0; s < 8; ++s) { const f32x2_ x = *(const f32x2_*)(segsum + s * 128 + 2 * d); tota += x[0]; totb += x[1]; if (s < seg) { prea += x[0]; preb += x[1]; } }
        const float etota = __expf(tota), etotb = __expf(totb);
        bf16_t* qtg = QT + ((size_t)dir * TG + rowb + c * 64 + seg * 8) * 512 + h * 128 + 2 * d;
        float ksa[8], ksb[8];
#pragma unroll
        for (int ii = 0; ii < 8; ++ii) {
            const float ba = csa[ii] + prea, bb = csb[ii] + preb; const float ea = __expf(ba), eb = __expf(bb); const float ia = __builtin_amdgcn_rcpf(ea), ib_ = __builtin_amdgcn_rcpf(eb);
            const float qa = __uint_as_float(R.qv[ii] << 16), qb = __uint_as_float(R.qv[ii] & 0xffff0000u), ka = __uint_as_float(R.kv[ii] << 16), kb = __uint_as_float(R.kv[ii] & 0xffff0000u);
            const unsigned qw = pg8::cvt_pk_bf16(qa * 0.08838834764831845f * ea, qb * 0.08838834764831845f * eb);
            const unsigned kw = pg8::cvt_pk_bf16(ka * ia, kb * ib_);
            ksa[ii] = ka * etota * ia; ksb[ii] = kb * etotb * ib_;
            const int i = seg * 8 + ii;
            *(unsigned*)(Qt + i * LQ + 2 * d) = qw; *(unsigned*)(Kt + i * LQ + 2 * d) = kw;
            *(unsigned*)(qtg + (size_t)ii * 512) = qw; }
        { bf16_t* kp = KST + cidx * 8192 + (2 * d) * 64 + seg * 8;
          *(u32x4*)kp = (u32x4){pg8::cvt_pk_bf16(ksa[0], ksa[1]), pg8::cvt_pk_bf16(ksa[2], ksa[3]), pg8::cvt_pk_bf16(ksa[4], ksa[5]), pg8::cvt_pk_bf16(ksa[6], ksa[7])};
          *(u32x4*)(kp + 64) = (u32x4){pg8::cvt_pk_bf16(ksb[0], ksb[1]), pg8::cvt_pk_bf16(ksb[2], ksb[3]), pg8::cvt_pk_bf16(ksb[4], ksb[5]), pg8::cvt_pk_bf16(ksb[6], ksb[7])}; }
        if (seg == 0) *(f32x2_*)(DEC + cidx * 128 + 2 * d) = (f32x2_){etota, etotb};
        LBAR();
        if (wid < 3) {
            const int ib = wid > 0 ? 1 : 0, jb = wid == 2 ? 1 : 0; f32x16 a = {};
#pragma unroll
            for (int k0 = 0; k0 < 128; k0 += 16) { const bf16x8 A = *(const bf16x8*)(Qt + (ib * 32 + r32) * LQ + k0 + hi * 8); const bf16x8 B = *(const bf16x8*)(Kt + (jb * 32 + r32) * LQ + k0 + hi * 8);
                a = __builtin_amdgcn_mfma_f32_32x32x16_bf16(A, B, a, 0, 0, 0); }
            bf16_t* ap = AM + cidx * 4096;
#pragma unroll
            for (int r = 0; r < 16; ++r) { const int i = ib * 32 + crow(r, hi), j = jb * 32 + r32; ap[i * 64 + j] = f2bf(j <= i ? a[r] : 0.f); }
        } else if (wid == 3) {
            bf16_t* ap = AM + cidx * 4096;
#pragma unroll
            for (int r = 0; r < 16; ++r) ap[crow(r, hi) * 64 + 32 + r32] = 0;
        }
        LBAR();
}
__device__ __forceinline__ void prep_phase(int vcu, int G, int nitems, const bf16_t* GQ, const bf16_t* GK, const float* GLR, const float* w2g, const float* bg,
                                           bf16_t* QT, bf16_t* KST, float* DEC, bf16_t* AM, char* lds) {
    int tid_ = threadIdx.x; asm volatile("" : "+v"(tid_)); const int tid = tid_, lane = tid & 63, wid = tid >> 6, r32 = lane & 31, hi = lane >> 5;
    const int d = tid & 63, seg = tid >> 6;
    int it = vcu; if (it >= nitems) return;
    Raw RA, RB; RA.gl = (f32x4){0.f, 0.f, 0.f, 0.f}; RB.gl = RA.gl;
    PREP_LOAD(RA, it);
    Wd W; int whd = it & 7; PREP_LOADW(W, it);
    for (;;) {
        { const int nx = it + G; if (nx < nitems) PREP_LOAD(RB, nx); prep_compute(RA, W, it, QT, KST, DEC, AM, lds, tid, lane, wid, r32, hi, d, seg); it = nx; if (it >= nitems) break; if ((it & 7) != whd) { whd = it & 7; PREP_LOADW(W, it); } }
        { const int nx = it + G; if (nx < nitems) PREP_LOAD(RA, nx); prep_compute(RB, W, it, QT, KST, DEC, AM, lds, tid, lane, wid, r32, hi, d, seg); it = nx; if (it >= nitems) break; if ((it & 7) != whd) { whd = it & 7; PREP_LOADW(W, it); } }
    }
    LBAR();
}
#undef PREP_LOAD
#undef PREP_LOADW
constexpr int S_ST = 0, S_QT = 17408, S_KST = 34816, S_AM = 53248, S_VT = 62464, S_DC = 71680;
struct Pre { u32x4 q0, q1, k0, k1, am, vr; float dcv; };
__device__ __forceinline__ void scan_item(int item, const bf16_t* GV, const bf16_t* QT, const bf16_t* KST, const float* DEC, const bf16_t* AM, bf16_t* OF, bf16_t* OB, char* lds) {
    int tid_ = threadIdx.x; asm volatile("" : "+v"(tid_)); const int tid = tid_, lane = tid & 63, wid = tid >> 6, r32 = lane & 31, hi = lane >> 5;
    const int vs = item & 3, dir = (item >> 2) & 1, h = (item >> 3) & 3, bl = item >> 5;
    bf16_t* St = (bf16_t*)(lds + S_ST); bf16_t* Qs = (bf16_t*)(lds + S_QT); bf16_t* Ks = (bf16_t*)(lds + S_KST); bf16_t* As = (bf16_t*)(lds + S_AM);
    bf16_t* Vt = (bf16_t*)(lds + S_VT); float* dcs = (float*)(lds + S_DC);
    for (int i = tid; i < 64 * LQ / 2; i += 512) ((unsigned*)St)[i] = 0u;
    f32x16 Sacc = {};
    const int db = wid >> 1, vb = wid & 1, ib = (wid >> 1) & 1, ov = wid & 1;
    bf16_t* Oout = (dir ? OB : OF) + h * 256 + vs * 64 + ov * 32 + r32;
    const long rowb = (long)bl * SEQ; const int sgn = dir ? -1 : 1;
    const int vj = tid & 63, vg = tid >> 6;
    const size_t bh = (((size_t)dir * GB + bl) * 4 + h) * 64;
    const bf16_t* qsrc = QT + ((size_t)dir * TG + rowb + (tid >> 3)) * 512 + h * 128 + (tid & 7) * 16;
    const bf16_t* ksrc = KST + bh * 8192 + (tid >> 2) * 64 + (tid & 3) * 16;
    const bf16_t* asrc = AM + bh * 4096 + (tid >> 3) * 64 + (tid & 7) * 8;
    const float* decb = DEC + bh * 128 + (tid & 127);
    const bf16_t* gvb = GV + h * 256 + vs * 64 + vg * 8;
    bf16_t* qdst = Qs + (tid >> 3) * LQ + (tid & 7) * 16; bf16_t* kdst = Ks + (tid >> 2) * LV + (tid & 3) * 16; bf16_t* adst = As + (tid >> 3) * LV + (tid & 7) * 8;
#define GLA_LOAD(P, c) do { const int t0_ = dir ? (SEQ - 1 - (c) * 64) : (c) * 64; \
        P.q0 = *(const u32x4*)(qsrc + (size_t)(c) * 64 * 512); P.q1 = *(const u32x4*)(qsrc + (size_t)(c) * 64 * 512 + 8); \
        P.k0 = *(const u32x4*)(ksrc + (size_t)(c) * 8192); P.k1 = *(const u32x4*)(ksrc + (size_t)(c) * 8192 + 8); \
        P.am = *(const u32x4*)(asrc + (size_t)(c) * 4096); \
        if (tid < 128) P.dcv = decb[(size_t)(c) * 128]; \
        P.vr = *(const u32x4*)(gvb + (rowb + t0_ + sgn * vj) * 1024); } while (0)
#define GLA_STEP(P, c) do { const int t0_ = dir ? (SEQ - 1 - (c) * 64) : (c) * 64; \
        *(u32x4*)qdst = P.q0; *(u32x4*)(qdst + 8) = P.q1; *(u32x4*)kdst = P.k0; *(u32x4*)(kdst + 8) = P.k1; *(u32x4*)adst = P.am; \
        _Pragma("unroll") for (int e = 0; e < 8; ++e) Vt[(vg * 8 + e) * LV + vj] = (unsigned short)(P.vr[e >> 1] >> ((e & 1) * 16)); \
        if (tid < 128) dcs[tid] = P.dcv; \
        LBAR(); \
        if (wid < 4) { f32x16 o = {}, o2 = {}; \
            _Pragma("unroll") for (int t = 0; t < 8; ++t) { const bf16x8 A = *(const bf16x8*)(Qs + (ib * 32 + r32) * LQ + 16 * t + hi * 8); const bf16x8 B = *(const bf16x8*)(St + (ov * 32 + r32) * LQ + 16 * t + hi * 8); \
                o = __builtin_amdgcn_mfma_f32_32x32x16_bf16(A, B, o, 0, 0, 0); } \
            _Pragma("unroll") for (int t = 0; t < 4; ++t) { const bf16x8 A = *(const bf16x8*)(As + (ib * 32 + r32) * LV + 16 * t + hi * 8); const bf16x8 B = *(const bf16x8*)(Vt + (ov * 32 + r32) * LV + 16 * t + hi * 8); \
                o2 = __builtin_amdgcn_mfma_f32_32x32x16_bf16(A, B, o2, 0, 0, 0); } \
            _Pragma("unroll") for (int r = 0; r < 16; ++r) Oout[(rowb + t0_ + sgn * (ib * 32 + crow(r, hi))) * 1024] = f2bf(o[r] + o2[r]); } \
        _Pragma("unroll") for (int g = 0; g < 4; ++g) { const f32x4 dc = *(const f32x4*)(dcs + db * 32 + 8 * g + 4 * hi); \
            Sacc[4 * g] *= dc[0]; Sacc[4 * g + 1] *= dc[1]; Sacc[4 * g + 2] *= dc[2]; Sacc[4 * g + 3] *= dc[3]; } \
        _Pragma("unroll") for (int t = 0; t < 4; ++t) { const bf16x8 A = *(const bf16x8*)(Ks + (db * 32 + r32) * LV + 16 * t + hi * 8); const bf16x8 B = *(const bf16x8*)(Vt + (vb * 32 + r32) * LV + 16 * t + hi * 8); \
            Sacc = __builtin_amdgcn_mfma_f32_32x32x16_bf16(A, B, Sacc, 0, 0, 0); } \
        LBAR(); \
        _Pragma("unroll") for (int g = 0; g < 4; ++g) { u32x2 w; w.x = pk2(Sacc[4 * g], Sacc[4 * g + 1]); w.y = pk2(Sacc[4 * g + 2], Sacc[4 * g + 3]); \
            *(u32x2*)(St + (vb * 32 + r32) * LQ + db * 32 + 8 * g + 4 * hi) = w; } } while (0)
    Pre P0, P1, P2, P3; P0.dcv = 0.f; P1.dcv = 0.f; P2.dcv = 0.f; P3.dcv = 0.f;
    GLA_LOAD(P0, 0); GLA_LOAD(P1, 1); GLA_LOAD(P2, 2); GLA_LOAD(P3, 3);
    LBAR();
    for (int c = 0; c < 64; c += 4) {
        GLA_STEP(P0, c);     if (c + 4 < 64) GLA_LOAD(P0, c + 4);
        GLA_STEP(P1, c + 1); if (c + 5 < 64) GLA_LOAD(P1, c + 5);
        GLA_STEP(P2, c + 2); if (c + 6 < 64) GLA_LOAD(P2, c + 6);
        GLA_STEP(P3, c + 3); if (c + 7 < 64) GLA_LOAD(P3, c + 7);
    }
    LBAR();
#undef GLA_LOAD
#undef GLA_STEP
}
}

#define LASF __attribute__((address_space(3)))
__device__ __forceinline__ void tr_item(const float* W, int K, int N, bf16_t* WT, int n0, int c0, int k0, const float* kscale, float* scr, int lane) {
    float tv[32];
#pragma unroll
    for (int i = 0; i < 32; ++i) { const int kk = 2 * i + (lane >> 5); tv[i] = (c0 >= 0) ? W[(size_t)(k0 + kk) * N + c0 + (lane & 31)] : 0.f; }
#pragma unroll
    for (int i = 0; i < 32; ++i) { const int kk = 2 * i + (lane >> 5); float v = tv[i]; if (kscale) v *= kscale[k0 + kk]; scr[kk * 33 + (lane & 31)] = v; }
    asm volatile("s_waitcnt lgkmcnt(0)" ::: "memory");
    const int c = lane & 7;
#pragma unroll
    for (int j = 0; j < 4; ++j) { const int n = (lane >> 3) + 8 * j; const float* s = scr + (8 * c) * 33 + n;
        u32x4 o; o.x = pk2(s[0 * 33], s[1 * 33]); o.y = pk2(s[2 * 33], s[3 * 33]); o.z = pk2(s[4 * 33], s[5 * 33]); o.w = pk2(s[6 * 33], s[7 * 33]);
        *(u32x4*)(WT + (size_t)(n0 + n) * K + k0 + 8 * c) = o; }
    asm volatile("s_waitcnt lgkmcnt(0)" ::: "memory");
}
__device__ __forceinline__ int win_src(int n0) {
    if (n0 < 3072) return n0;
    if (n0 < 5120) { const int t = n0 & ~255, p = n0 & 255; const int bj = p >> 7, blk = (p >> 6) & 1, i = p & 63; return t + 32 + blk * 128 + bj * 64 + i; }
    if (n0 < 8192) return n0 + 32;
    if (n0 == 8192) return 3072;
    return -1;
}
__device__ __forceinline__ int wfi_src(int n0) { const int pn = n0 >> 8, p = n0 & 255, bj = p >> 7, j = p & 127; return bj * FFH + pn * 128 + j; }

struct KArgs { const float* in[16]; float* out; unsigned char* ws; int ph_lo, ph_hi; };

__device__ __forceinline__ void phase_prologue(const KArgs& a, char* lds, int vcu, int G) {
    int tid_ = threadIdx.x; asm volatile("" : "+v"(tid_)); const int tid = tid_, lane = tid & 63, wid = tid >> 6;
    unsigned char* ws = a.ws;
    float* scr = (float*)(lds + wid * 8704);
    const int gw = vcu * 8 + wid, NGW = G * 8;
    constexpr int I_IN = (NIN / 32) * 16, I_OUT = 32 * 16, I_FI = (NFI / 32) * 16, I_FO = 32 * 44;
    for (int it = gw; it < I_IN + I_OUT + I_FI + I_FO; it += NGW) {
        int r = it;
        if (r < I_IN) { const int nb = r >> 4, kb = r & 15; tr_item(a.in[2], DM, INW, (bf16_t*)(ws + WS_WIN), nb * 32, win_src(nb * 32), kb * 64, nullptr, scr, lane); continue; } r -= I_IN;
        if (r < I_OUT) { const int nb = r >> 4, kb = r & 15; tr_item(a.in[11], DM, DM, (bf16_t*)(ws + WS_WOUT), nb * 32, nb * 32, kb * 64, nullptr, scr, lane); continue; } r -= I_OUT;
        if (r < I_FI) { const int nb = r >> 4, kb = r & 15; tr_item(a.in[13], DM, NFI, (bf16_t*)(ws + WS_WFI), nb * 32, wfi_src(nb * 32), kb * 64, a.in[12], scr, lane); continue; } r -= I_FI;
        { const int nb = r / 44, kb = r % 44; tr_item(a.in[14], FFH, DM, (bf16_t*)(ws + WS_WFO), nb * 32, nb * 32, kb * 64, nullptr, scr, lane); }
    }
    { const float* nw = a.in[1]; bf16_t* U = (bf16_t*)(ws + WS_U);
      f32x4 wv[4];
#pragma unroll
      for (int j = 0; j < 4; ++j) wv[j] = *((const f32x4*)nw + lane + 64 * j);
      for (int m0 = gw; m0 < NTOK; m0 += 4 * NGW) {
        f32x4 v[4][4]; float s[4];
#pragma unroll
        for (int k = 0; k < 4; ++k) { const int m = m0 + k * NGW; s[k] = 0.f; if (m < NTOK) { const f32x4* __restrict__ xr = (const f32x4*)(a.in[0] + (size_t)m * DM) + lane;
#pragma unroll
            for (int j = 0; j < 4; ++j) v[k][j] = xr[64 * j]; } else {
#pragma unroll
            for (int j = 0; j < 4; ++j) v[k][j] = (f32x4){0.f, 0.f, 0.f, 0.f}; } }
#pragma unroll
        for (int k = 0; k < 4; ++k) {
#pragma unroll
            for (int j = 0; j < 4; ++j) s[k] += (v[k][j][0] * v[k][j][0] + v[k][j][1] * v[k][j][1]) + (v[k][j][2] * v[k][j][2] + v[k][j][3] * v[k][j][3]); }
#pragma unroll
        for (int k = 0; k < 4; ++k) { const int m = m0 + k * NGW; if (m < NTOK) { const float rstd = rsqrtf(wave_sum(s[k]) * (1.f / DM) + EPS);
            u32x2* __restrict__ o8 = (u32x2*)(U + (size_t)m * DM) + lane;
#pragma unroll
            for (int j = 0; j < 4; ++j) { u32x2 w; w.x = pk2(v[k][j][0] * rstd * wv[j][0], v[k][j][1] * rstd * wv[j][1]); w.y = pk2(v[k][j][2] * rstd * wv[j][2], v[k][j][3] * rstd * wv[j][3]); o8[64 * j] = w; } } }
      } }
    { float* rope = (float*)(ws + WS_ROPE);
      for (int idx = vcu * 512 + tid; idx < SEQ * 64; idx += G * 512) { const int pos = idx >> 6, i = idx & 63;
          const double inv = exp(-9.210340371976184 * (double)i / 64.0); const double ang = (double)pos * inv;
          rope[2 * idx] = (float)cos(ang); rope[2 * idx + 1] = (float)sin(ang); } }
    { float* ss = (float*)(ws + WS_SS1);
      for (int idx = vcu * 512 + tid; idx < 2 * NTOK; idx += G * 512) ss[idx] = 0.f; }
    if (vcu == 0 && wid == 0) {
        const float s1 = wave_sum(a.in[6][lane] * a.in[7][lane] + a.in[6][lane + 64] * a.in[7][lane + 64]);
        const float s2 = wave_sum(a.in[8][lane] * a.in[9][lane] + a.in[8][lane + 64] * a.in[9][lane + 64]);
        if (lane == 0) *(float*)(ws + WS_CTL) = expf(s1) - expf(s2) + LAMBDA_INIT;
    }
}

__device__ __forceinline__ void phase_merge(const KArgs& a, int g, int vcu, int G) {
    int tid_ = threadIdx.x; asm volatile("" : "+v"(tid_)); const int tid = tid_, lane = tid & 63, wid = tid >> 6;
    unsigned char* ws = a.ws;
    const bf16_t* __restrict__ OF = (const bf16_t*)(ws + WS_OF); const bf16_t* __restrict__ OB = (const bf16_t*)(ws + WS_OB); const bf16_t* __restrict__ GR = (const bf16_t*)(ws + WS_GR);
    const bf16_t* __restrict__ O2 = (const bf16_t*)(ws + WS_O2C); const bf16_t* __restrict__ GA = (const bf16_t*)(ws + WS_GA); const bf16_t* __restrict__ GBb = (const bf16_t*)(ws + WS_GB);
    bf16_t* __restrict__ MG = (bf16_t*)(ws + WS_MERGED) + (size_t)g * TG * DM;
    const int e0 = lane * 16, c0 = e0 & 255;
    float gw_[16], sw_[16];
#pragma unroll
    for (int e = 0; e < 16; ++e) { gw_[e] = a.in[5][c0 + e]; sw_[e] = a.in[10][c0 + e] * (1.f - LAMBDA_INIT); }
#pragma unroll 2
    for (int m = vcu * 8 + wid; m < TG; m += G * 8) {
        const size_t off = (size_t)m * DM + e0;
        u32x4 vf[2], vb[2], vr[2], v2[2], va[2], vg[2];
#pragma unroll
        for (int q = 0; q < 2; ++q) { vf[q] = *(const u32x4*)(OF + off + 8 * q); vb[q] = *(const u32x4*)(OB + off + 8 * q); vr[q] = *(const u32x4*)(GR + off + 8 * q);
            v2[q] = *(const u32x4*)(O2 + off + 8 * q); va[q] = *(const u32x4*)(GA + off + 8 * q); vg[q] = *(const u32x4*)(GBb + off + 8 * q); }
        float oa[16], o2[16]; float sa = 0.f, sb = 0.f;
#pragma unroll
        for (int e = 0; e < 16; ++e) { const int q = e >> 3, w = (e >> 1) & 3, sh = (e & 1) * 16;
            const float f = bf2f((unsigned short)(vf[q][w] >> sh)) + bf2f((unsigned short)(vb[q][w] >> sh)); const float t = bf2f((unsigned short)(v2[q][w] >> sh));
            oa[e] = f; o2[e] = t; sa += f * f; sb += t * t; }
#pragma unroll
        for (int o = 1; o < 16; o <<= 1) { sa += __shfl_xor(sa, o); sb += __shfl_xor(sb, o); }
        const float ra = rsqrtf(sa * (1.f / 256.f) + EPS), rb = rsqrtf(sb * (1.f / 256.f) + SUBLN_EPS);
        float mo[16];
#pragma unroll
        for (int e = 0; e < 16; ++e) { const int q = e >> 3, w = (e >> 1) & 3, sh = (e & 1) * 16;
            const float gr = bf2f((unsigned short)(vr[q][w] >> sh)), ga = bf2f((unsigned short)(va[q][w] >> sh)), gb = bf2f((unsigned short)(vg[q][w] >> sh));
            const float ya = oa[e] * ra * gw_[e] * (gr * sigmoidf_(gr)); const float yb = o2[e] * rb * sw_[e];
            mo[e] = sigmoidf_(ga) * ya + sigmoidf_(gb) * yb; }
        u32x4 w0, w1;
        w0.x = pk2(mo[0], mo[1]); w0.y = pk2(mo[2], mo[3]); w0.z = pk2(mo[4], mo[5]); w0.w = pk2(mo[6], mo[7]);
        w1.x = pk2(mo[8], mo[9]); w1.y = pk2(mo[10], mo[11]); w1.z = pk2(mo[12], mo[13]); w1.w = pk2(mo[14], mo[15]);
        *(u32x4*)(MG + off) = w0; *(u32x4*)(MG + off + 8) = w1;
    }
}

__device__ __forceinline__ void glr_panels(const bf16_t* U, const bf16_t* WT, float* GLR, int vcu, int G) {
    int tid_ = threadIdx.x; asm volatile("" : "+v"(tid_)); const int lane = tid_ & 63, wid = tid_ >> 6, r32 = lane & 31, hi = lane >> 5;
    const bf16_t* bp = WT + (size_t)r32 * DM + hi * 8;
    for (int p = vcu * 8 + wid; p < TG / 32; p += G * 8) {
        const bf16_t* ap = U + (size_t)(p * 32 + r32) * DM + hi * 8;
        att::f32x16 acc = {};
        att::bf16x8 fa[8], fb[8], ga[8], gb[8];
#define GLR_LD(A_, B_, t0_) do { _Pragma("unroll") for (int t = 0; t < 8; ++t) { A_[t] = *(const att::bf16x8*)(ap + 16 * ((t0_) + t)); B_[t] = *(const att::bf16x8*)(bp + 16 * ((t0_) + t)); } } while (0)
#define GLR_MM(A_, B_) do { _Pragma("unroll") for (int t = 0; t < 8; ++t) acc = __builtin_amdgcn_mfma_f32_32x32x16_bf16(A_[t], B_[t], acc, 0, 0, 0); } while (0)
        GLR_LD(fa, fb, 0);
#pragma unroll 1
        for (int t0 = 0; t0 < 64; t0 += 16) { GLR_LD(ga, gb, t0 + 8); GLR_MM(fa, fb); if (t0 + 16 < 64) GLR_LD(fa, fb, t0 + 16); GLR_MM(ga, gb); }
#undef GLR_LD
#undef GLR_MM
#pragma unroll
        for (int r = 0; r < 16; ++r) GLR[(size_t)(p * 32 + gla::crow(r, hi)) * 32 + r32] = acc[r];
    }
}
#define LAS __attribute__((address_space(3)))
#define XB_TMO      128
#define XB_XCNT(j)  (256  + 64 * (j))
#define XB_XSUB(j)  (1280 + 64 * (j))
#define XB_XGEN(j)  (2304 + 64 * (j))
#define XB_TOP      3328
#define XB_TOPGEN   3392
#define XCD_BAR_WORDS 3456
#define XB_SPIN_CAP (1u << 18)

__device__ __forceinline__ unsigned xb_ld(unsigned* p)              { return __hip_atomic_load(p, __ATOMIC_RELAXED, __HIP_MEMORY_SCOPE_AGENT); }
__device__ __forceinline__ unsigned xb_add(unsigned* p, unsigned v) { return __hip_atomic_fetch_add(p, v, __ATOMIC_RELAXED, __HIP_MEMORY_SCOPE_AGENT); }
__device__ __forceinline__ unsigned xb_xcc_id() { return (unsigned)__builtin_amdgcn_s_getreg((3 << 11) | 20) & 0xFu; }
#define XB_SPIN(cond, bar) do { unsigned _sp = 0; while (cond) { __builtin_amdgcn_s_sleep(1); \
    if ((++_sp & 255u) == 0u) { if (xb_ld(&(bar)[XB_TMO])) break; if (_sp > XB_SPIN_CAP) { atomicAdd(&(bar)[XB_TMO], 1u); break; } } } } while (0)

struct XcdBarrier {
    unsigned* bar; unsigned x;
    volatile LAS unsigned* st;
};

__device__ __forceinline__ XcdBarrier xcd_barrier_post(unsigned* bar, volatile LAS unsigned* st) {
    XcdBarrier b; b.bar = bar; b.x = xb_xcc_id(); b.st = st;
    if (threadIdx.x == 0) st[2] = xb_add(&bar[XB_XCNT(b.x)], 1u);
    return b;
}
__device__ __forceinline__ void xcd_barrier_complete(unsigned* bar, unsigned x, unsigned& nloc, unsigned& nx) {
    const unsigned G = gridDim.x * gridDim.y * gridDim.z;
    unsigned sum, cnt, mine, sp = 0u;
    for (;;) {
        sum = 0u; cnt = 0u; mine = 0u;
#pragma unroll
        for (unsigned j = 0; j < 16; ++j) { const unsigned c = xb_ld(&bar[XB_XCNT(j)]); sum += c; cnt += (c > 0u) ? 1u : 0u; mine = (j == x) ? c : mine; }
        if (sum == G) break;
        __builtin_amdgcn_s_sleep(1);
        if ((++sp & 255u) == 0u) { if (xb_ld(&bar[XB_TMO])) break; if (sp > XB_SPIN_CAP) { atomicAdd(&bar[XB_TMO], 1u); break; } }
    }
    nloc = mine > 0u ? mine : 1u; nx = cnt > 0u ? cnt : 1u;
}

__device__ __forceinline__ void xcd_barrier(const XcdBarrier& b) {
    asm volatile("s_waitcnt vmcnt(0)" ::: "memory");
    __syncthreads();
    if (threadIdx.x == 0) {
        unsigned* bar = b.bar;
        __builtin_amdgcn_s_waitcnt(0);
        unsigned nloc = b.st[0], nx = b.st[1];
        if (nloc == 0u) { xcd_barrier_complete(bar, b.x, nloc, nx); b.st[0] = nloc; b.st[1] = nx; }
        const unsigned old = xb_add(&bar[XB_XSUB(b.x)], 1u);
        const unsigned gen = old / nloc;
        if (old + 1u == (gen + 1u) * nloc) {
            __builtin_amdgcn_fence(__ATOMIC_RELEASE, "agent");
            asm volatile("s_waitcnt vmcnt(0)" ::: "memory");
            const unsigned og = xb_add(&bar[XB_TOP], 1u);
            const unsigned tg = og / nx;
            if (og + 1u == (tg + 1u) * nx) xb_add(&bar[XB_TOPGEN], 1u);
            else XB_SPIN(xb_ld(&bar[XB_TOPGEN]) == tg, bar);
            __builtin_amdgcn_fence(__ATOMIC_ACQUIRE, "agent");
            xb_add(&bar[XB_XGEN(b.x)], 1u);
            asm volatile("s_waitcnt vmcnt(0)" ::: "memory");
        } else {
            XB_SPIN(xb_ld(&bar[XB_XGEN(b.x)]) == gen, bar);
            __builtin_amdgcn_fence(__ATOMIC_ACQUIRE, "agent");
            asm volatile("s_waitcnt vmcnt(0)" ::: "memory");
        }
    }
    __syncthreads();
}

__global__ void __launch_bounds__(512) hybrid_fwd(KArgs a) {
    extern __shared__ __attribute__((aligned(16))) unsigned char lds[];
    cg::grid_group grid = cg::this_grid();
    const int G = gridDim.x, bx = blockIdx.x;
    int vcu = (G % 8 == 0) ? (bx % 8) * (G / 8) + bx / 8 : bx;
    int cg_ = bx;
#define IN(k) (lo <= (k) && (k) < hi)
#define SEAM(k) do { if (IN(k) && IN((k) + 1)) xcd_barrier(xbar); } while (0)
#define WSP unsigned char* ws = a.ws
    const int lo = a.ph_lo, hi = a.ph_hi;
    if (lo > NPHASE) grid.sync();
    volatile LAS unsigned* xst = (volatile LAS unsigned*)((LAS unsigned char*)lds + 150528);
    if (threadIdx.x < 4) xst[threadIdx.x] = 0u;
    __syncthreads();
    XcdBarrier xbar; xbar.bar = (unsigned*)(a.ws + WS_BAR); xbar.x = 0; xbar.st = xst;
    if (hi - lo > 2) xbar = xcd_barrier_post((unsigned*)(a.ws + WS_BAR), xst);
    if (IN(0)) {
#ifndef DIS_PRO
        phase_prologue(a, (char*)lds, vcu, G);
#endif
    }
    SEAM(0);
    if (IN(0) && IN(1) && G % 8 == 0) {
        if (threadIdx.x == 0) { bool ok = xbar.x < 8u; for (unsigned j = 0; j < 16; ++j) { const unsigned c = xb_ld(&xbar.bar[XB_XCNT(j)]); ok = ok && (c == (j < 8u ? (unsigned)G / 8u : 0u)); }
            xst[3] = ok ? 1u : 0u; }
        __syncthreads();
        if (xst[3]) { const int rk = (int)xst[2], xc = (int)xbar.x; vcu = xc * (G / 8) + rk; cg_ = rk * 8 + xc; }
    }
    { constexpr int g = 0;
      if (IN(1)) { WSP;
                glr_panels((const bf16_t*)(ws + WS_U) + (size_t)g * TG * DM, (const bf16_t*)(ws + WS_WIN) + (size_t)8192 * DM, (float*)(ws + WS_GLR), vcu, G);
                pg8::Gemm gm{(const bf16_t*)(ws + WS_U) + (size_t)g * TG * DM, (const bf16_t*)(ws + WS_WIN), TG, 8192, DM};
                pg8::StaticOrder S; S.init(TG, 8192, G, cg_);
                EpiIn E{(bf16_t*)(ws + WS_GQ), (bf16_t*)(ws + WS_GK), (bf16_t*)(ws + WS_GV), (bf16_t*)(ws + WS_GR), (bf16_t*)(ws + WS_DQ), (bf16_t*)(ws + WS_DK), (bf16_t*)(ws + WS_DV),
                        (bf16_t*)(ws + WS_GA), (bf16_t*)(ws + WS_GB), (float*)(ws + WS_GLR), (const float*)(ws + WS_ROPE)};
#ifndef DIS_G1
                pg8::gemm_phase<EpiIn, pg8::StaticOrder, true, true>((PG8_LAS unsigned char*)lds, gm, S, E);
#endif
      }
      SEAM(1);
            if (IN(2)) { WSP;
#ifndef DIS_GLA
                gla::prep_phase(vcu, G, GB * 512, (const bf16_t*)(ws + WS_GQ), (const bf16_t*)(ws + WS_GK), (const float*)(ws + WS_GLR), a.in[3], a.in[4],
                                (bf16_t*)((unsigned char*)a.out + OUT_QT), (bf16_t*)((unsigned char*)a.out + OUT_KST), (float*)(ws + WS_DEC), (bf16_t*)(ws + WS_MERGED + 64 * MiB), (char*)lds);
#endif
      }
      SEAM(2);
      if (IN(3)) { WSP;
#ifndef DIS_GLA
                for (int it = vcu; it < GB * 32; it += G)
                    gla::scan_item(it, (const bf16_t*)(ws + WS_GV), (const bf16_t*)((unsigned char*)a.out + OUT_QT), (const bf16_t*)((unsigned char*)a.out + OUT_KST), (const float*)(ws + WS_DEC), (const bf16_t*)(ws + WS_MERGED + 64 * MiB),
                                   (bf16_t*)(ws + WS_OF), (bf16_t*)(ws + WS_OB), (char*)lds);
#endif
#ifndef DIS_ATT
                const float lam = *(const float*)(ws + WS_CTL);
                for (int un = vcu; un < GB * 64; un += G) {
                    const int qb = un & 15, h = (un >> 4) & 3, bl = un >> 6;
                    const size_t r0 = (size_t)bl * SEQ * 1024;
                    const att::bf16* Q = (const att::bf16*)(ws + WS_DQ) + r0 + (size_t)qb * 256 * 1024 + h * 256;
                    const att::bf16* Kp = (const att::bf16*)(ws + WS_DK) + r0 + h * 256;
                    const att::bf16* Vp = (const att::bf16*)(ws + WS_DV) + r0 + h * 256;
                    float* O1 = a.out + r0 + (size_t)qb * 256 * 1024 + h * 256;
                    bf16_t* O2 = (bf16_t*)(ws + WS_O2C) + r0 + (size_t)qb * 256 * 1024 + h * 256;
#pragma unroll 1
                    for (int p = 0; p < 2; ++p) att2::attn256_body(Q + 128 * p, Kp + 128 * p, Vp, O1, O2, p, lam, SEQ, (char*)lds);
                }
#endif
      }
      SEAM(3);
      if (IN(4)) {
#ifndef DIS_MRG
                phase_merge(a, g, vcu, G);
#endif
      }
      SEAM(4);
    }
    { constexpr int g = 1;
      if (IN(5)) { WSP;
                glr_panels((const bf16_t*)(ws + WS_U) + (size_t)g * TG * DM, (const bf16_t*)(ws + WS_WIN) + (size_t)8192 * DM, (float*)(ws + WS_GLR), vcu, G);
                pg8::Gemm gm{(const bf16_t*)(ws + WS_U) + (size_t)g * TG * DM, (const bf16_t*)(ws + WS_WIN), TG, 8192, DM};
                pg8::StaticOrder S; S.init(TG, 8192, G, cg_);
                EpiIn E{(bf16_t*)(ws + WS_GQ), (bf16_t*)(ws + WS_GK), (bf16_t*)(ws + WS_GV), (bf16_t*)(ws + WS_GR), (bf16_t*)(ws + WS_DQ), (bf16_t*)(ws + WS_DK), (bf16_t*)(ws + WS_DV),
                        (bf16_t*)(ws + WS_GA), (bf16_t*)(ws + WS_GB), (float*)(ws + WS_GLR), (const float*)(ws + WS_ROPE)};
#ifndef DIS_G1
                pg8::gemm_phase<EpiIn, pg8::StaticOrder, true, true>((PG8_LAS unsigned char*)lds, gm, S, E);
#endif
      }
      SEAM(5);
            if (IN(6)) { WSP;
#ifndef DIS_GLA
                gla::prep_phase(vcu, G, GB * 512, (const bf16_t*)(ws + WS_GQ), (const bf16_t*)(ws + WS_GK), (const float*)(ws + WS_GLR), a.in[3], a.in[4],
                                (bf16_t*)((unsigned char*)a.out + OUT_QT), (bf16_t*)((unsigned char*)a.out + OUT_KST), (float*)(ws + WS_DEC), (bf16_t*)(ws + WS_MERGED + 64 * MiB), (char*)lds);
#endif
      }
      SEAM(6);
      if (IN(7)) { WSP;
#ifndef DIS_GLA
                for (int it = vcu; it < GB * 32; it += G)
                    gla::scan_item(it, (const bf16_t*)(ws + WS_GV), (const bf16_t*)((unsigned char*)a.out + OUT_QT), (const bf16_t*)((unsigned char*)a.out + OUT_KST), (const float*)(ws + WS_DEC), (const bf16_t*)(ws + WS_MERGED + 64 * MiB),
                                   (bf16_t*)(ws + WS_OF), (bf16_t*)(ws + WS_OB), (char*)lds);
#endif
#ifndef DIS_ATT
                const float lam = *(const float*)(ws + WS_CTL);
                for (int un = vcu; un < GB * 64; un += G) {
                    const int qb = un & 15, h = (un >> 4) & 3, bl = un >> 6;
                    const size_t r0 = (size_t)bl * SEQ * 1024;
                    const att::bf16* Q = (const att::bf16*)(ws + WS_DQ) + r0 + (size_t)qb * 256 * 1024 + h * 256;
                    const att::bf16* Kp = (const att::bf16*)(ws + WS_DK) + r0 + h * 256;
                    const att::bf16* Vp = (const att::bf16*)(ws + WS_DV) + r0 + h * 256;
                    float* O1 = a.out + r0 + (size_t)qb * 256 * 1024 + h * 256;
                    bf16_t* O2 = (bf16_t*)(ws + WS_O2C) + r0 + (size_t)qb * 256 * 1024 + h * 256;
#pragma unroll 1
                    for (int p = 0; p < 2; ++p) att2::attn256_body(Q + 128 * p, Kp + 128 * p, Vp, O1, O2, p, lam, SEQ, (char*)lds);
                }
#endif
      }
      SEAM(7);
      if (IN(8)) {
#ifndef DIS_MRG
                phase_merge(a, g, vcu, G);
#endif
      }
      SEAM(8);
    }
    if (IN(9)) { WSP;
            pg8::Gemm gm{(const bf16_t*)(ws + WS_MERGED), (const bf16_t*)(ws + WS_WOUT), NTOK, DM, DM};
            pg8::StaticOrder S; S.init(NTOK, DM, G, cg_);
            EpiOutProj E{a.in[0], (bf16_t*)(ws + WS_H1B), (float*)(ws + WS_SS1)};
#ifndef DIS_G2
            pg8::gemm_phase<EpiOutProj, pg8::StaticOrder, true, true>((PG8_LAS unsigned char*)lds, gm, S, E);
#endif
    }
    SEAM(9);
    if (IN(10)) { WSP;
            pg8::Gemm gm{(const bf16_t*)(ws + WS_H1B), (const bf16_t*)(ws + WS_WFI), NTOK, NFI, DM};
            pg8::StaticOrder S; S.init(NTOK, NFI, G, cg_);
            EpiFfnIn E{(const float*)(ws + WS_SS1), (bf16_t*)(ws + WS_ACT)};
#ifndef DIS_G3
            pg8::gemm_phase<EpiFfnIn, pg8::StaticOrder, true, true>((PG8_LAS unsigned char*)lds, gm, S, E);
#endif
    }
    SEAM(10);
    if (IN(11)) { WSP;
            pg8::Gemm gm{(const bf16_t*)(ws + WS_ACT), (const bf16_t*)(ws + WS_WFO), NTOK, DM, FFH};
            pg8::StaticOrder S; S.init(NTOK, DM, G, cg_);
            EpiFfnOut E{(const bf16_t*)(ws + WS_H1B), (bf16_t*)(ws + WS_MERGED), (float*)(ws + WS_SS2)};
#ifndef DIS_G4
            pg8::gemm_phase<EpiFfnOut, pg8::StaticOrder, true, true>((PG8_LAS unsigned char*)lds, gm, S, E);
#endif
    }
    SEAM(11);
    if (IN(12)) { WSP;
            const float* ss = (const float*)(ws + WS_SS2); const f32x4* wf = (const f32x4*)a.in[15]; f32x4* o4 = (f32x4*)a.out; const u32x2* h2 = (const u32x2*)(ws + WS_MERGED);
            {
                const size_t stride = (size_t)G * 512, total = (size_t)NTOK * 256; size_t idx = (size_t)vcu * 512 + threadIdx.x; const f32x4 wv = wf[idx & 255];
                for (; idx + 3 * stride < total; idx += 4 * stride) { u32x2 hw[4]; float sv[4];
#pragma unroll
                    for (int k = 0; k < 4; ++k) { hw[k] = h2[idx + k * stride]; sv[k] = ss[(idx + k * stride) >> 8]; }
#pragma unroll
                    for (int k = 0; k < 4; ++k) { const float rstd = rsqrtf(sv[k] * (1.f / 1024.f) + EPS); f32x4 h; h[0] = __uint_as_float(hw[k].x << 16); h[1] = __uint_as_float(hw[k].x & 0xffff0000u); h[2] = __uint_as_float(hw[k].y << 16); h[3] = __uint_as_float(hw[k].y & 0xffff0000u);
                        o4[idx + k * stride] = h * rstd * wv; } }
                for (; idx < total; idx += stride) { const float rstd = rsqrtf(ss[idx >> 8] * (1.f / 1024.f) + EPS); const u32x2 hw = h2[idx]; f32x4 h; h[0] = __uint_as_float(hw.x << 16); h[1] = __uint_as_float(hw.x & 0xffff0000u); h[2] = __uint_as_float(hw.y << 16); h[3] = __uint_as_float(hw.y & 0xffff0000u);
                    o4[idx] = h * rstd * wv; } }
    }
#undef IN
#undef SEAM
#undef WSP
}

extern "C" void kernel_launch(void* const* d_in, const int* in_sizes, int n_in, void* d_out, int out_size, void* d_ws, size_t ws_size, hipStream_t stream) {
    static int grid = 0;
    if (grid == 0) {
        if (n_in != 16 || in_sizes[0] != NTOK * DM || out_size != NTOK * DM || ws_size < WS_END) {
            fprintf(stderr, "kernel_launch: shape/workspace mismatch (n_in %d, in0 %d, out %d, ws %zu, need %zu)\n", n_in, n_in > 0 ? in_sizes[0] : -1, out_size, ws_size, (size_t)WS_END); grid = -1; return; }
        int dev = 0, cus = 0, per_cu = 0;
        hipGetDevice(&dev); hipDeviceGetAttribute(&cus, hipDeviceAttributeMultiprocessorCount, dev);
        if (hipFuncSetAttribute((const void*)hybrid_fwd, hipFuncAttributeMaxDynamicSharedMemorySize, LDS_BYTES) != hipSuccess) { fprintf(stderr, "kernel_launch: hipFuncSetAttribute failed\n"); grid = -1; return; }
        if (hipOccupancyMaxActiveBlocksPerMultiprocessor(&per_cu, (const void*)hybrid_fwd, 512, LDS_BYTES) != hipSuccess || per_cu < 1) { fprintf(stderr, "kernel_launch: occupancy query gave %d\n", per_cu); per_cu = 1; }
        (void)hipGetLastError();
        grid = cus * 1;
        if (grid <= 0) grid = 256;
    }
    if (grid < 0) return;
    if (hipMemsetAsync((char*)d_ws + WS_BAR, 0, WS_BAR_BYTES, stream) != hipSuccess) { fprintf(stderr, "kernel_launch: hipMemsetAsync of the barrier words failed\n"); return; }
    KArgs a{};
    for (int i = 0; i < 16; ++i) a.in[i] = (const float*)d_in[i];
    a.out = (float*)d_out; a.ws = (unsigned char*)d_ws;
#if N_LAUNCH_MODE == 1
    a.ph_lo = 0; a.ph_hi = NPHASE;
    { void* args[] = {&a};
      hipError_t e = hipLaunchCooperativeKernel((const void*)hybrid_fwd, dim3(grid), dim3(512), args, LDS_BYTES, stream);
      if (e != hipSuccess) fprintf(stderr, "cooperative launch failed: %s (grid %d)\n", hipGetErrorString(e), grid); }
#else
    for (int ph = 0; ph < NPHASE; ++ph) {
        a.ph_lo = ph; a.ph_hi = ph + 1; void* args[] = {&a};
        hipError_t e = hipLaunchCooperativeKernel((const void*)hybrid_fwd, dim3(grid), dim3(512), args, LDS_BYTES, stream);
        if (e != hipSuccess) { fprintf(stderr, "cooperative launch %d failed: %s (grid %d)\n", ph, hipGetErrorString(e), grid); break; }
    }
#endif
}
```

```cpp
#include <hip/hip_runtime.h>
#include <hip/hip_bf16.h>
#include <hip/hip_cooperative_groups.h>
#include <cstdio>
#include <cstdint>
namespace cg = cooperative_groups;
#ifndef N_LAUNCH_MODE
#define N_LAUNCH_MODE 1
#endif
namespace pg8 {
#define PG8_LAS __attribute__((address_space(3)))
typedef unsigned short bf16_t;
typedef short bf16x8 __attribute__((ext_vector_type(8)));
typedef float f32x4 __attribute__((ext_vector_type(4)));
typedef unsigned u32x4 __attribute__((ext_vector_type(4)));
constexpr int BM = 256, BK = 64, HALF = 128, HTB = HALF * BK * 2  , STAGE_BYTES = 8 * HTB, NXCD = 8, WGM = 8;

__host__ __device__ __forceinline__ int lds_byte(int r, int c) { const int st = (r >> 4) * 2 + (c >> 5), rr = r & 15, cc = c & 31, ob = rr * 64 + cc * 2; return st * 1024 + (ob ^ (((ob >> 9) & 1) << 5)); }
__host__ __device__ __forceinline__ void stage_rc(int b, int& R, int& C) { const int st = b / 1024, sb = b % 1024, swz = sb ^ (((sb >> 9) & 1) << 5); R = (st >> 1) * 16 + swz / 64; C = (st & 1) * 32 + (swz % 64) / 2; }
__host__ __device__ __forceinline__ int perm32(int rho) { const int n = rho >> 4, i = rho & 15; return 8 * (i >> 2) + 4 * n + (i & 3); }

struct Unit { int pm, pn; };
struct Gemm { const bf16_t* A; const bf16_t* Bt; int M, N, K; };

struct StaticOrder {
    int nM, nN, nwg, G, c;
    __host__ __device__ void init(int M, int N, int G_, int c_) { nM = M / BM; nN = N / BM; nwg = nM * nN; G = G_; c = c_; }
    __host__ __device__ bool next(int i, Unit& u) const {
        const long L = (long)i * G + c; if (L >= nwg) return false;
        int wgid = (int)L; { const int q = nwg / NXCD, r = nwg % NXCD, xcd = wgid % NXCD, off = wgid / NXCD; wgid = (xcd < r ? xcd * (q + 1) : r * (q + 1) + (xcd - r) * q) + off; }
        const int nig = WGM * nN, gid = wgid / nig, fm = gid * WGM, gsz = (nM - fm) < WGM ? (nM - fm) : WGM;
        u.pm = fm + ((wgid % nig) % gsz); u.pn = (wgid % nig) / gsz; return true;
    }
    __device__ __forceinline__ void a_ready(const Unit&) const {}
    __device__ __forceinline__ void done(const Unit&) const {}
};

typedef float cvt_f32x2_t __attribute__((ext_vector_type(2))); typedef __bf16 cvt_bf16x2_t __attribute__((ext_vector_type(2)));
__device__ __forceinline__ unsigned cvt_pk_bf16(float lo, float hi) { cvt_f32x2_t v = {lo, hi}; cvt_bf16x2_t b = __builtin_convertvector(v, cvt_bf16x2_t); return __builtin_bit_cast(unsigned, b); }
typedef float f32x2 __attribute__((ext_vector_type(2)));
template <class Epi, class Sched, bool ALIGN_EPI = false, bool SP2 = false>
__device__ __forceinline__ void gemm_phase(PG8_LAS unsigned char* lds, const Gemm g, const Sched& S, const Epi& E) {
    int tid_ = threadIdx.x; asm volatile("" : "+v"(tid_)); const int tid = tid_, wid = __builtin_amdgcn_readfirstlane(tid >> 6), lane = tid & 63, wr = wid >> 2, wc = wid & 3, fr = lane & 15, fq = lane >> 4;
    const int K = g.K, nt = K / BK;
    unsigned voffA[2], voffB[2];
#pragma unroll
    for (int i = 0; i < 2; ++i) { int R, C; stage_rc(tid * 16 + i * 8192, R, C); const int Rb = Epi::PERM ? ((R & ~31) + perm32(R & 31)) : R;
        voffA[i] = (unsigned)(R * K + C) * 2u; voffB[i] = (unsigned)(Rb * K + C) * 2u; }
    const size_t kstep = (size_t)(BK * 2);
    const size_t hstep = (size_t)HALF * K * 2;
    const size_t tstep = 2 * hstep;
    const unsigned ldsw = (unsigned)wid * 1024u;
    const int aoff = lds_byte(wr * 64 + fr, fq * 8), boff = lds_byte(wc * 32 + fr, fq * 8);
#define PG8_SA(b, h) (((b) * 2 + (h)) * HTB)
#define PG8_SB(b, h) ((4 + (b) * 2 + (h)) * HTB)
#define PG8_STAGE(bufoff, gbase, voff) do { _Pragma("unroll") for (int _i = 0; _i < 2; ++_i) \
        __builtin_amdgcn_global_load_lds((const unsigned*)((const char*)(gbase) + (voff)[_i]), (PG8_LAS unsigned*)(lds + (bufoff) + ldsw + _i * 8192), 16, 0, 0); } while (0)
#define PG8_LDA(dst, b, h) do { _Pragma("unroll") for (int m = 0; m < 4; ++m) _Pragma("unroll") for (int k = 0; k < 2; ++k) dst[m][k] = *(const PG8_LAS bf16x8*)(lds + PG8_SA(b, h) + aoff + m * 2048 + k * 1024); } while (0)
#define PG8_LDB(dst, b, h) do { _Pragma("unroll") for (int n = 0; n < 2; ++n) _Pragma("unroll") for (int k = 0; k < 2; ++k) dst[n][k] = *(const PG8_LAS bf16x8*)(lds + PG8_SB(b, h) + boff + n * 2048 + k * 1024); } while (0)
#define PG8_MMA(ai, bj, At, Bt) do { __builtin_amdgcn_s_setprio(1); _Pragma("unroll") for (int m = 0; m < 4; ++m) _Pragma("unroll") for (int n = 0; n < 2; ++n) _Pragma("unroll") for (int k = 0; k < 2; ++k) \
        acc[ai][bj][m][n] = __builtin_amdgcn_mfma_f32_16x16x32_bf16(Bt[n][k], At[m][k], acc[ai][bj][m][n], 0, 0, 0); __builtin_amdgcn_s_setprio(0); } while (0)
#define PG8_WAIT_V(n) asm volatile("s_waitcnt vmcnt(" #n ")" ::: "memory")
#define PG8_WAIT_L(n) asm volatile("s_waitcnt lgkmcnt(" #n ")" ::: "memory")
#define PG8_BAR __builtin_amdgcn_s_barrier()
#define PG8_SCHED __builtin_amdgcn_sched_barrier(0)
    Unit cur, nxt; int ui = 0;
    if (!S.next(0, cur)) return;
    f32x4 acc[2][2][4][2];
#pragma unroll
    for (int a = 0; a < 2; ++a)
#pragma unroll
        for (int b = 0; b < 2; ++b)
#pragma unroll
            for (int m = 0; m < 4; ++m)
#pragma unroll
                for (int n = 0; n < 2; ++n) acc[a][b][m][n] = (f32x4){0.f, 0.f, 0.f, 0.f};
    bf16x8 At[4][2], B0[2][2], B1[2][2];
    const char* cA = (const char*)g.A + (size_t)cur.pm * tstep; const char* cB = (const char*)g.Bt + (size_t)cur.pn * tstep;
    S.a_ready(cur);
    if constexpr (SP2) {
        PG8_STAGE(PG8_SB(0, 0), cB, voffB); PG8_STAGE(PG8_SB(0, 1), cB + hstep, voffB); PG8_STAGE(PG8_SA(0, 0), cA, voffA); PG8_STAGE(PG8_SA(0, 1), cA + hstep, voffA);
        if (wr == 1) PG8_BAR;
        PG8_WAIT_V(2); PG8_BAR;
        PG8_STAGE(PG8_SB(1, 0), cB + kstep, voffB); PG8_STAGE(PG8_SA(1, 0), cA + kstep, voffA); PG8_STAGE(PG8_SB(1, 1), cB + hstep + kstep, voffB);
        PG8_WAIT_V(6); PG8_BAR;
    } else {
        PG8_STAGE(PG8_SB(0, 0), cB, voffB); PG8_STAGE(PG8_SA(0, 0), cA, voffA); PG8_STAGE(PG8_SB(0, 1), cB + hstep, voffB); PG8_STAGE(PG8_SA(0, 1), cA + hstep, voffA);
        if (wr == 1) PG8_BAR;
        PG8_WAIT_V(4); PG8_BAR;
        PG8_STAGE(PG8_SB(1, 0), cB + kstep, voffB); PG8_STAGE(PG8_SA(1, 0), cA + kstep, voffA); PG8_STAGE(PG8_SB(1, 1), cB + hstep + kstep, voffB);
        PG8_WAIT_V(6); PG8_BAR;
    }
    for (;;) {
        const bool has_next = S.next(ui + 1, nxt);
        const char* nA = has_next ? (const char*)g.A + (size_t)nxt.pm * tstep : cA; const char* nB = has_next ? (const char*)g.Bt + (size_t)nxt.pn * tstep : cB;
        for (int t = 0; t < nt; t += 2) {
            const bool last = (t == nt - 2);
            const char* a1 = cA + (size_t)(t + 1) * kstep;
            const char* a2 = last ? nA : cA + (size_t)(t + 2) * kstep; const char* b2 = last ? nB : cB + (size_t)(t + 2) * kstep;
            const char* a3 = a2 + kstep; const char* b3 = b2 + kstep;
            if (last && has_next) S.a_ready(nxt);
            if constexpr (SP2) {
            PG8_LDB(B0, 0, 0); PG8_LDB(B1, 0, 1); PG8_SCHED; PG8_LDA(At, 0, 0); PG8_STAGE(PG8_SA(1, 1), a1 + hstep, voffA);
            PG8_WAIT_V(8); PG8_WAIT_L(0); PG8_BAR; PG8_MMA(0, 0, At, B0); PG8_MMA(0, 1, At, B1); PG8_BAR; PG8_SCHED;
            PG8_LDA(At, 0, 1); PG8_STAGE(PG8_SB(0, 0), b2, voffB); PG8_STAGE(PG8_SB(0, 1), b2 + hstep, voffB); PG8_STAGE(PG8_SA(0, 0), a2, voffA);
            PG8_WAIT_V(8); PG8_WAIT_L(0); PG8_BAR; PG8_MMA(1, 0, At, B0); PG8_MMA(1, 1, At, B1); PG8_BAR; PG8_SCHED;
            PG8_LDB(B0, 1, 0); PG8_LDB(B1, 1, 1); PG8_SCHED; PG8_LDA(At, 1, 0); PG8_STAGE(PG8_SA(0, 1), a2 + hstep, voffA);
            PG8_WAIT_V(8); PG8_WAIT_L(0); PG8_BAR; PG8_MMA(0, 0, At, B0); PG8_MMA(0, 1, At, B1); PG8_BAR; PG8_SCHED;
            PG8_LDA(At, 1, 1); PG8_STAGE(PG8_SB(1, 0), b3, voffB); PG8_STAGE(PG8_SB(1, 1), b3 + hstep, voffB); PG8_STAGE(PG8_SA(1, 0), a3, voffA);
            PG8_WAIT_V(8); PG8_WAIT_L(0); PG8_BAR; PG8_MMA(1, 0, At, B0); PG8_MMA(1, 1, At, B1); PG8_BAR; PG8_SCHED;
            } else {
            PG8_LDB(B0, 0, 0); PG8_SCHED; PG8_LDA(At, 0, 0); PG8_STAGE(PG8_SA(1, 1), a1 + hstep, voffA);
            PG8_WAIT_L(8); PG8_BAR; PG8_WAIT_L(0); PG8_MMA(0, 0, At, B0); PG8_BAR; PG8_SCHED;
            PG8_LDB(B1, 0, 1); PG8_STAGE(PG8_SB(0, 0), b2, voffB);
            PG8_BAR; PG8_WAIT_L(0); PG8_MMA(0, 1, At, B1); PG8_BAR;
            PG8_LDA(At, 0, 1); PG8_STAGE(PG8_SA(0, 0), a2, voffA);
            PG8_BAR; PG8_WAIT_L(0); PG8_MMA(1, 0, At, B0); PG8_BAR; PG8_SCHED;
            PG8_STAGE(PG8_SB(0, 1), b2 + hstep, voffB);
            PG8_WAIT_V(6); PG8_BAR; PG8_MMA(1, 1, At, B1); PG8_BAR;
            PG8_LDB(B0, 1, 0); PG8_SCHED; PG8_LDA(At, 1, 0); PG8_STAGE(PG8_SA(0, 1), a2 + hstep, voffA);
            PG8_WAIT_L(8); PG8_BAR; PG8_WAIT_L(0); PG8_MMA(0, 0, At, B0); PG8_BAR; PG8_SCHED;
            PG8_LDB(B1, 1, 1); PG8_STAGE(PG8_SB(1, 0), b3, voffB);
            PG8_BAR; PG8_WAIT_L(0); PG8_MMA(0, 1, At, B1); PG8_BAR;
            PG8_LDA(At, 1, 1); PG8_STAGE(PG8_SA(1, 0), a3, voffA);
            PG8_BAR; PG8_WAIT_L(0); PG8_MMA(1, 0, At, B0); PG8_BAR; PG8_SCHED;
            PG8_STAGE(PG8_SB(1, 1), b3 + hstep, voffB);
            PG8_WAIT_V(6); PG8_BAR; PG8_MMA(1, 1, At, B1); PG8_BAR;
            }
        }
        if constexpr (ALIGN_EPI) { if (wr == 0) PG8_BAR; }
        if constexpr (!Epi::AFTER_DRAIN) { E(acc, cur, wr, wc, fr, fq); S.done(cur); }
        if (!has_next) break;
#pragma unroll
        for (int a = 0; a < 2; ++a)
#pragma unroll
            for (int b = 0; b < 2; ++b)
#pragma unroll
                for (int m = 0; m < 4; ++m)
#pragma unroll
                    for (int n = 0; n < 2; ++n) acc[a][b][m][n] = (f32x4){0.f, 0.f, 0.f, 0.f};
        cur = nxt; cA = nA; cB = nB; ++ui;
        if constexpr (ALIGN_EPI) { if (wr == 1) PG8_BAR; }
    }
    PG8_WAIT_V(0);
    if constexpr (!ALIGN_EPI) { if (wr == 0) PG8_BAR; }
    PG8_BAR;
    if constexpr (Epi::AFTER_DRAIN) { E.fused(acc, cur, wr, wc, fr, fq, lds, wid, lane); S.done(cur); }
#undef PG8_SA
#undef PG8_SB
#undef PG8_STAGE
#undef PG8_LDA
#undef PG8_LDB
#undef PG8_MMA
#undef PG8_WAIT_V
#undef PG8_WAIT_L
#undef PG8_BAR
#undef PG8_SCHED
}
}
namespace att {
using bf16 = __hip_bfloat16;
constexpr int   D = 128, NW = 8, QBLK = 32, KVBLK = 64;
constexpr float SCALE = 0.088388347648318440f;
constexpr float THR = 8.f;
constexpr int SDEPTH = 2;
constexpr int LDQ = 1024, LDK = 1024, LDO = 1024;
constexpr size_t SHM_V = KVBLK * D * 2, SHM_K = KVBLK * D * 2, SHM_ATTN = 2 * SHM_V + 2 * SHM_K + NW * 64 * 4;
__device__ __forceinline__ unsigned short f2bf_rne(float f) { unsigned u = __float_as_uint(f); return (unsigned short)((u + 0x7fffu + ((u >> 16) & 1u)) >> 16); }
using bf16x8 = __attribute__((ext_vector_type(8))) short;
using s16x4  = __attribute__((ext_vector_type(4))) short;
using f32x16 = __attribute__((ext_vector_type(16))) float;
using f32x8  = __attribute__((ext_vector_type(8))) float;
using u32x4  = __attribute__((ext_vector_type(4))) unsigned;
#define KSWZ(row, colB) ((row) * 256 + ((colB) ^ (((row) & 7) << 4)))
#define SBAR() __builtin_amdgcn_sched_barrier(0)
__device__ __forceinline__ int crow(int r, int hi) { return (r & 3) + 8 * (r >> 2) + 4 * hi; }
__device__ __forceinline__ unsigned cvtpk(float lo, float hi) {
  unsigned r; asm volatile("v_cvt_pk_bf16_f32 %0, %1, %2" : "=v"(r) : "v"(lo), "v"(hi)); return r;
}
template <typename TIn> struct Stage;
template <> struct Stage<bf16>  { using T = bf16x8;
  __device__ static __forceinline__ T ld8(const bf16* p) { return *reinterpret_cast<const bf16x8*>(p); }
  __device__ static __forceinline__ bf16x8 tobf(T x) { return x; } };
template <> struct Stage<float> { using T = f32x8;
  __device__ static __forceinline__ T ld8(const float* p) { return *reinterpret_cast<const f32x8*>(p); }
  __device__ static __forceinline__ bf16x8 tobf(T x) {
    u32x4 w = {cvtpk(x[0], x[1]), cvtpk(x[2], x[3]), cvtpk(x[4], x[5]), cvtpk(x[6], x[7])}; return *reinterpret_cast<bf16x8*>(&w); } };

__device__ __forceinline__ void partialSM(f32x16& p0, f32x16& p1, float& m_reg, float& mn, float& alpha) {
  constexpr float C = SCALE * 1.4426950408889634f;
  float pmax = p0[0]; _Pragma("unroll") for (int r = 1; r < 16; ++r) pmax = fmaxf(pmax, p0[r]); _Pragma("unroll") for (int r = 0; r < 16; ++r) pmax = fmaxf(pmax, p1[r]);
  { auto rr = __builtin_amdgcn_permlane32_swap(__float_as_uint(pmax), __float_as_uint(pmax), false, false);
    pmax = fmaxf(__uint_as_float(rr[0]), __uint_as_float(rr[1])); }
  if (__builtin_expect(__all(pmax - m_reg <= THR / SCALE), 1)) { mn = m_reg; alpha = 1.f; }
  else { mn = fmaxf(m_reg, pmax); alpha = __builtin_amdgcn_exp2f((m_reg - mn) * C); m_reg = mn; }
  float mnC = -mn * C;
  _Pragma("unroll") for (int r = 0; r < 16; ++r) p0[r] = fmaf(p0[r], C, mnC); _Pragma("unroll") for (int r = 0; r < 16; ++r) p1[r] = fmaf(p1[r], C, mnC);
  _Pragma("unroll") for (int r = 0; r < 16; ++r) p0[r] = __builtin_amdgcn_exp2f(p0[r]);
}
__device__ __forceinline__ void finishSM(f32x16& p0, f32x16& p1, float alpha, float& l_reg, bf16x8& pa0, bf16x8& pa1, bf16x8& pa2, bf16x8& pa3) {
  _Pragma("unroll") for (int r = 0; r < 16; ++r) p1[r] = __builtin_amdgcn_exp2f(p1[r]);
  float ps = 0; _Pragma("unroll") for (int r = 0; r < 16; ++r) ps += p0[r]; _Pragma("unroll") for (int r = 0; r < 16; ++r) ps += p1[r];
  { auto rr = __builtin_amdgcn_permlane32_swap(__float_as_uint(ps), __float_as_uint(ps), false, false);
    ps = __uint_as_float(rr[0]) + __uint_as_float(rr[1]); }
  l_reg = l_reg * alpha + ps;
#define PK4(P, BASE, OUT) do { unsigned a0 = cvtpk(P[BASE + 0], P[BASE + 1]), a1 = cvtpk(P[BASE + 2], P[BASE + 3]);   \
    unsigned b0 = cvtpk(P[BASE + 4], P[BASE + 5]), b1 = cvtpk(P[BASE + 6], P[BASE + 7]);                              \
    auto r0 = __builtin_amdgcn_permlane32_swap(a0, b0, false, false); auto r1 = __builtin_amdgcn_permlane32_swap(a1, b1, false, false); \
    u32x4 w = {r0[0], r1[0], r0[1], r1[1]}; OUT = *reinterpret_cast<bf16x8*>(&w); } while (0)
  PK4(p0, 0, pa0); PK4(p0, 8, pa1); PK4(p1, 0, pa2); PK4(p1, 8, pa3);
#undef PK4
}
__device__ __forceinline__ void qkt(f32x16& p0, f32x16& p1, const bf16* Ks, const bf16x8* qr, int r32, int hi) {
  p0 = f32x16{}; p1 = f32x16{};
  _Pragma("unroll") for (int d0 = 0; d0 < 8; ++d0) { int cb = (d0 * 16 + hi * 8) * 2;
    bf16x8 b0 = *reinterpret_cast<const bf16x8*>((const char*)Ks + KSWZ(r32, cb));
    bf16x8 b1 = *reinterpret_cast<const bf16x8*>((const char*)Ks + KSWZ(32 + r32, cb));
    p0 = __builtin_amdgcn_mfma_f32_32x32x16_bf16(b0, qr[d0], p0, 0, 0, 0);
    p1 = __builtin_amdgcn_mfma_f32_32x32x16_bf16(b1, qr[d0], p1, 0, 0, 0); }
}
__device__ __forceinline__ int v_st(int k, int c) { const int kk = (k & ~0xC) | ((k & 4) << 1) | ((k & 8) >> 1); return ((kk >> 3) * 4 + (c >> 5)) * 512 + ((kk & 7) * 32 + (c & 31)) * 2; }
__device__ __forceinline__ int v_rd_base(int lane) { return ((lane & 3) << 3) | (((lane >> 2) & 3) << 6) | (((lane >> 4) & 1) << 5) | (((lane >> 5) & 1) << 8); }
constexpr int v_rd_off(int d0, int ks, int half) { return d0 * 512 + ks * 4096 + half * 2048; }
template <int OFF> __device__ __forceinline__ s16x4 tr_read(int vb) {
  s16x4 r; asm volatile("ds_read_b64_tr_b16 %0, %1 offset:%2" : "=&v"(r) : "v"(vb), "i"(OFF) : "memory"); return r;
}
template <int D0> __device__ __forceinline__ void pv_one(f32x16& od, int vb, bf16x8 pa0, bf16x8 pa1, bf16x8 pa2, bf16x8 pa3) {
  const s16x4 l0 = tr_read<v_rd_off(D0, 0, 0)>(vb), h0 = tr_read<v_rd_off(D0, 0, 1)>(vb), l1 = tr_read<v_rd_off(D0, 1, 0)>(vb), h1 = tr_read<v_rd_off(D0, 1, 1)>(vb);
  const s16x4 l2 = tr_read<v_rd_off(D0, 2, 0)>(vb), h2 = tr_read<v_rd_off(D0, 2, 1)>(vb), l3 = tr_read<v_rd_off(D0, 3, 0)>(vb), h3 = tr_read<v_rd_off(D0, 3, 1)>(vb);
  asm volatile("s_waitcnt lgkmcnt(0)" ::: "memory"); SBAR();
#define PK(L, H) (bf16x8){L[0], L[1], L[2], L[3], H[0], H[1], H[2], H[3]}
  od = __builtin_amdgcn_mfma_f32_32x32x16_bf16(pa0, PK(l0, h0), od, 0, 0, 0);
  od = __builtin_amdgcn_mfma_f32_32x32x16_bf16(pa1, PK(l1, h1), od, 0, 0, 0);
  od = __builtin_amdgcn_mfma_f32_32x32x16_bf16(pa2, PK(l2, h2), od, 0, 0, 0);
  od = __builtin_amdgcn_mfma_f32_32x32x16_bf16(pa3, PK(l3, h3), od, 0, 0, 0);
#undef PK
}
__device__ __forceinline__ void pv_d0(f32x16* o, int vb, bf16x8 pa0, bf16x8 pa1, bf16x8 pa2, bf16x8 pa3) {
  pv_one<0>(o[0], vb, pa0, pa1, pa2, pa3); pv_one<1>(o[1], vb, pa0, pa1, pa2, pa3); pv_one<2>(o[2], vb, pa0, pa1, pa2, pa3); pv_one<3>(o[3], vb, pa0, pa1, pa2, pa3);
}
__device__ __forceinline__ void attn_dense_body(const bf16* __restrict__ Qb, const bf16* __restrict__ Kh, const bf16* __restrict__ Vh,
                                                float* O1b, unsigned short* O2b, const int pass, const float lam, int seq, char* lds) {
  using St = Stage<bf16>; using SQ = Stage<bf16>;
  int tid_ = threadIdx.x; asm volatile("" : "+v"(tid_));
  const int tid = tid_, wid = tid >> 6, lane = tid & 63, r32 = lane & 31, hi = lane >> 5;
  bf16* V_lds = (bf16*)lds; bf16* K_lds = (bf16*)(lds + 2 * SHM_V);
  float* ws = (float*)(lds + 2 * SHM_V + 2 * SHM_K) + wid * 64; float* li_l = ws; float* al_l = ws + 32;
  float m_reg = -1e30f, l_reg = 0; f32x16 o[4] = {}; bf16x8 qr[8];
  const bf16* Qw = Qb + (long)(wid * QBLK + r32) * LDQ + hi * 8;
  _Pragma("unroll") for (int d0 = 0; d0 < 8; ++d0) qr[d0] = SQ::tobf(SQ::ld8(Qw + d0 * 16));
  const int sr = tid >> 4, sc = (tid & 15) * 8, vst0 = v_st(sr, sc), vst1 = v_st(32 + sr, sc);
  const int vb0 = (int)(uintptr_t)V_lds + v_rd_base(lane);
  struct { typename St::T vs0, vs1, ks0, ks1; } sr_[SDEPTH];
#define SLOAD(i, k0) do { sr_[i].vs0 = St::ld8(&Vh[(long)((k0) + sr) * LDK + sc]); sr_[i].vs1 = St::ld8(&Vh[(long)((k0) + 32 + sr) * LDK + sc]); \
    sr_[i].ks0 = St::ld8(&Kh[(long)((k0) + sr) * LDK + sc]); sr_[i].ks1 = St::ld8(&Kh[(long)((k0) + 32 + sr) * LDK + sc]); } while (0)
#define SWRITE(b, i) do { *(bf16x8*)((char*)V_lds + (b) * SHM_V + vst0) = St::tobf(sr_[i].vs0);          \
    *(bf16x8*)((char*)V_lds + (b) * SHM_V + vst1) = St::tobf(sr_[i].vs1); int kc = sc * 2;               \
    *(bf16x8*)((char*)K_lds + (b) * SHM_K + KSWZ(sr, kc)) = St::tobf(sr_[i].ks0);                       \
    *(bf16x8*)((char*)K_lds + (b) * SHM_K + KSWZ(32 + sr, kc)) = St::tobf(sr_[i].ks1); } while (0)
#define SWAIT() do { if constexpr (SDEPTH == 2) asm volatile("s_waitcnt vmcnt(4)" ::: "memory"); else asm volatile("s_waitcnt vmcnt(0)" ::: "memory"); } while (0)
#define RESC(a) do { if (__any((a) < 1.f)) { if (hi == 0) al_l[r32] = (a); asm volatile("s_waitcnt lgkmcnt(0)" ::: "memory"); \
    _Pragma("unroll") for (int d = 0; d < 4; ++d) _Pragma("unroll") for (int r = 0; r < 16; ++r) o[d][r] *= al_l[crow(r, hi)]; } } while (0)
  f32x16 pA0, pA1, pB0, pB1; float mnA, mnB, alA, alB; bf16x8 pa0, pa1, pa2, pa3; const int NT = seq / KVBLK;
  constexpr int SE = 0, SO = SDEPTH - 1;
  SLOAD(SE, 0); asm volatile("s_waitcnt vmcnt(0)" ::: "memory"); SWRITE(0, SE); __syncthreads();
  qkt(pA0, pA1, K_lds, qr, r32, hi); partialSM(pA0, pA1, m_reg, mnA, alA);
  SLOAD(SO, KVBLK); if constexpr (SDEPTH == 2) { if (2 < NT) SLOAD(SE, 2 * KVBLK); }
  SWAIT(); SWRITE(1, SO); __syncthreads();
  for (int j = 1; j + 1 < NT; j += 2) {
    SBAR(); qkt(pB0, pB1, (bf16*)((char*)K_lds + SHM_K), qr, r32, hi);
    finishSM(pA0, pA1, alA, l_reg, pa0, pa1, pa2, pa3); SBAR();
    SLOAD(SO, (j + SDEPTH) * KVBLK); SBAR();
    pv_d0(o, vb0, pa0, pa1, pa2, pa3); partialSM(pB0, pB1, m_reg, mnB, alB);
    __syncthreads(); SWAIT(); SWRITE(0, SE);
    RESC(alB); __syncthreads();
    SBAR(); qkt(pA0, pA1, K_lds, qr, r32, hi);
    finishSM(pB0, pB1, alB, l_reg, pa0, pa1, pa2, pa3); SBAR();
    if (SDEPTH == 1 || j + 3 < NT) SLOAD(SE, (j + 1 + SDEPTH) * KVBLK); SBAR();
    pv_d0(o, vb0 + (int)SHM_V, pa0, pa1, pa2, pa3); partialSM(pA0, pA1, m_reg, mnA, alA);
    __syncthreads(); SWAIT(); SWRITE(1, SO);
    RESC(alA); __syncthreads();
  }
  SBAR(); qkt(pB0, pB1, (bf16*)((char*)K_lds + SHM_K), qr, r32, hi);
  finishSM(pA0, pA1, alA, l_reg, pa0, pa1, pa2, pa3); SBAR();
  pv_d0(o, vb0, pa0, pa1, pa2, pa3); partialSM(pB0, pB1, m_reg, mnB, alB);
  __syncthreads(); RESC(alB);
  finishSM(pB0, pB1, alB, l_reg, pa0, pa1, pa2, pa3); SBAR();
  pv_d0(o, vb0 + (int)SHM_V, pa0, pa1, pa2, pa3);
  if (hi == 0) li_l[r32] = l_reg; asm volatile("s_waitcnt lgkmcnt(0)" ::: "memory");
  float rli[16];
  _Pragma("unroll") for (int r = 0; r < 16; ++r) rli[r] = __builtin_amdgcn_rcpf(li_l[crow(r, hi)]);
  float* Ow = O1b + (long)(wid * QBLK) * LDO; unsigned short* Cw = O2b + (long)(wid * QBLK) * LDO;
  _Pragma("unroll") for (int r = 0; r < 16; ++r) { int orow = crow(r, hi);
    _Pragma("unroll") for (int d0 = 0; d0 < 4; ++d0) { const long idx = (long)orow * LDO + d0 * 32 + r32; const float val = o[d0][r] * rli[r];
      if (pass == 0) Ow[idx] = val; else Cw[idx] = f2bf_rne(Ow[idx] - lam * val); } }
#undef SLOAD
#undef SWRITE
#undef SWAIT
#undef RESC
}
}
namespace att2 {
using namespace att;
constexpr int KBUF = 16384, VBUF = 32768, L_K = 0, L_V = 3 * KBUF, L_WS = 3 * KBUF + 3 * VBUF;
__device__ __forceinline__ void glds16(const void* gsrc, unsigned lds_dst) { unsigned keep;
  asm volatile("s_mov_b32 %0, m0\n\ts_mov_b32 m0, %2\n\ts_nop 0\n\tglobal_load_lds_dwordx4 %1, off\n\ts_mov_b32 m0, %0" : "=&s"(keep) : "v"(gsrc), "s"(lds_dst) : "memory"); }
constexpr int v_rd_off8(int d0, int ks, int half) { return d0 * 512 + ks * 8192 + half * 4096; }
template <int D0> __device__ __forceinline__ void pv_one8(f32x16& od, int vb, bf16x8 pa0, bf16x8 pa1, bf16x8 pa2, bf16x8 pa3) {
  const s16x4 l0 = tr_read<v_rd_off8(D0, 0, 0)>(vb), h0 = tr_read<v_rd_off8(D0, 0, 1)>(vb), l1 = tr_read<v_rd_off8(D0, 1, 0)>(vb), h1 = tr_read<v_rd_off8(D0, 1, 1)>(vb);
  const s16x4 l2 = tr_read<v_rd_off8(D0, 2, 0)>(vb), h2 = tr_read<v_rd_off8(D0, 2, 1)>(vb), l3 = tr_read<v_rd_off8(D0, 3, 0)>(vb), h3 = tr_read<v_rd_off8(D0, 3, 1)>(vb);
  asm volatile("s_waitcnt lgkmcnt(0)" ::: "memory"); SBAR();
#define PK(L, H) (bf16x8){L[0], L[1], L[2], L[3], H[0], H[1], H[2], H[3]}
  od = __builtin_amdgcn_mfma_f32_32x32x16_bf16(pa0, PK(l0, h0), od, 0, 0, 0);
  od = __builtin_amdgcn_mfma_f32_32x32x16_bf16(pa1, PK(l1, h1), od, 0, 0, 0);
  od = __builtin_amdgcn_mfma_f32_32x32x16_bf16(pa2, PK(l2, h2), od, 0, 0, 0);
  od = __builtin_amdgcn_mfma_f32_32x32x16_bf16(pa3, PK(l3, h3), od, 0, 0, 0);
#undef PK
}
__device__ __forceinline__ void attn256_body(const bf16* __restrict__ Qb, const bf16* __restrict__ Kh, const bf16* __restrict__ Vh, float* O1b, unsigned short* O2b,
                                             const int pass, const float lam, int seq, char* lds) {
  int tid_ = threadIdx.x; asm volatile("" : "+v"(tid_));
  const int tid = tid_, lane = tid & 63, r32 = lane & 31, hi = lane >> 5; const int wid = __builtin_amdgcn_readfirstlane(tid >> 6);
  const unsigned lds0 = (unsigned)(uintptr_t)lds;
  float* ws = (float*)(lds + L_WS) + wid * 64; float* li_l = ws; float* al_l = ws + 32;
  float m_reg = -1e30f, l_reg = 0; f32x16 o[8] = {}; bf16x8 qr[8];
  const bf16* Qw = Qb + (long)(wid * QBLK + r32) * LDQ + hi * 8;
  _Pragma("unroll") for (int d0 = 0; d0 < 8; ++d0) qr[d0] = *reinterpret_cast<const bf16x8*>(Qw + d0 * 16);
  long ksrc[2], vsrc[4];
  _Pragma("unroll") for (int p = 0; p < 2; ++p) { const int q = wid * 2 + p, row = 4 * q + (lane >> 4), c = (lane & 15) ^ (row & 7); ksrc[p] = (long)row * LDK + c * 8; }
  _Pragma("unroll") for (int p = 0; p < 4; ++p) { const int q = wid * 4 + p, s = 2 * q + (lane >> 5), kgrp = s >> 3, cb = s & 7, rowin = (lane & 31) >> 2, chunk = lane & 3;
    const int kk = kgrp * 8 + rowin, key = (kk & ~0xC) | ((kk & 4) << 1) | ((kk & 8) >> 1); vsrc[p] = (long)key * LDK + cb * 32 + chunk * 8; }
#define DMA_TILE(t, kb, vo) do { const bf16* kt_ = Kh + (long)(t) * KVBLK * LDK; const bf16* vt_ = Vh + (long)(t) * KVBLK * LDK; \
    _Pragma("unroll") for (int p = 0; p < 2; ++p) glds16(kt_ + ksrc[p], (unsigned)__builtin_amdgcn_readfirstlane(lds0 + L_K + (kb) * KBUF + (wid * 2 + p) * 1024)); \
    _Pragma("unroll") for (int p = 0; p < 4; ++p) glds16(vt_ + vsrc[p], (unsigned)__builtin_amdgcn_readfirstlane(lds0 + L_V + (vo) + (wid * 4 + p) * 1024)); } while (0)
#define PV_RD(S, D0) do { S##l0 = tr_read<v_rd_off8(D0, 0, 0)>(vb); S##h0 = tr_read<v_rd_off8(D0, 0, 1)>(vb); S##l1 = tr_read<v_rd_off8(D0, 1, 0)>(vb); S##h1 = tr_read<v_rd_off8(D0, 1, 1)>(vb); \
    S##l2 = tr_read<v_rd_off8(D0, 2, 0)>(vb); S##h2 = tr_read<v_rd_off8(D0, 2, 1)>(vb); S##l3 = tr_read<v_rd_off8(D0, 3, 0)>(vb); S##h3 = tr_read<v_rd_off8(D0, 3, 1)>(vb); } while (0)
#define PV_PK(L, H) (bf16x8){L[0], L[1], L[2], L[3], H[0], H[1], H[2], H[3]}
#define PV_MM(S, D0) do { o[D0] = __builtin_amdgcn_mfma_f32_32x32x16_bf16(pa0, PV_PK(S##l0, S##h0), o[D0], 0, 0, 0); o[D0] = __builtin_amdgcn_mfma_f32_32x32x16_bf16(pa1, PV_PK(S##l1, S##h1), o[D0], 0, 0, 0); \
    o[D0] = __builtin_amdgcn_mfma_f32_32x32x16_bf16(pa2, PV_PK(S##l2, S##h2), o[D0], 0, 0, 0); o[D0] = __builtin_amdgcn_mfma_f32_32x32x16_bf16(pa3, PV_PK(S##l3, S##h3), o[D0], 0, 0, 0); } while (0)
#define PV_W8() do { asm volatile("s_waitcnt lgkmcnt(8)" ::: "memory"); SBAR(); } while (0)
#define PV_W0() do { asm volatile("s_waitcnt lgkmcnt(0)" ::: "memory"); SBAR(); } while (0)
#define PV8(vb_) do { const int vb = (vb_); s16x4 Al0, Ah0, Al1, Ah1, Al2, Ah2, Al3, Ah3, Bl0, Bh0, Bl1, Bh1, Bl2, Bh2, Bl3, Bh3; \
    PV_RD(A, 0); PV_RD(B, 1); PV_W8(); PV_MM(A, 0); SBAR(); PV_RD(A, 2); PV_W8(); PV_MM(B, 1); SBAR(); PV_RD(B, 3); PV_W8(); PV_MM(A, 2); SBAR(); PV_RD(A, 4); PV_W8(); PV_MM(B, 3); SBAR(); \
    PV_RD(B, 5); PV_W8(); PV_MM(A, 4); SBAR(); PV_RD(A, 6); PV_W8(); PV_MM(B, 5); SBAR(); PV_RD(B, 7); PV_W8(); PV_MM(A, 6); SBAR(); PV_W0(); PV_MM(B, 7); } while (0)
  const int vb0 = (int)lds0 + L_V + v_rd_base(lane);
  const int NT = seq / KVBLK;
  bf16x8 pa0, pa1, pa2, pa3;
  DMA_TILE(0, 0, 0); if (NT > 1) DMA_TILE(1, 1, VBUF);
  int scur = 0, snext2 = 2;
  for (int j = 0; j < NT; ++j) {
    if (j + 1 < NT) asm volatile("s_waitcnt vmcnt(6) lgkmcnt(0)\n\ts_barrier" ::: "memory");
    else            asm volatile("s_waitcnt vmcnt(0) lgkmcnt(0)\n\ts_barrier" ::: "memory");
    if (j + 2 < NT) DMA_TILE(j + 2, snext2, snext2 * VBUF);
    f32x16 p0, p1; float mn, alpha;
    qkt(p0, p1, (const bf16*)(lds + L_K + scur * KBUF), qr, r32, hi);
    partialSM(p0, p1, m_reg, mn, alpha);
    if (__any(alpha < 1.f)) { if (hi == 0) al_l[r32] = alpha; asm volatile("s_waitcnt lgkmcnt(0)" ::: "memory");
      _Pragma("unroll") for (int d = 0; d < 8; ++d) _Pragma("unroll") for (int r = 0; r < 16; ++r) o[d][r] *= al_l[crow(r, hi)]; }
    finishSM(p0, p1, alpha, l_reg, pa0, pa1, pa2, pa3); SBAR();
    PV8(vb0 + scur * VBUF);
    scur = (scur == 2) ? 0 : scur + 1; snext2 = (snext2 == 2) ? 0 : snext2 + 1;
  }
#undef PV8
#undef PV_RD
#undef PV_PK
#undef PV_MM
#undef PV_W8
#undef PV_W0
#undef DMA_TILE
  if (hi == 0) li_l[r32] = l_reg; asm volatile("s_waitcnt lgkmcnt(0)" ::: "memory");
  float rli[16];
  _Pragma("unroll") for (int r = 0; r < 16; ++r) rli[r] = __builtin_amdgcn_rcpf(li_l[crow(r, hi)]);
  float* Ow = O1b + (long)(wid * QBLK) * LDO; unsigned short* Cw = O2b + (long)(wid * QBLK) * LDO;
  if (pass == 0) {
    _Pragma("unroll") for (int r = 0; r < 16; ++r) { const int orow = crow(r, hi);
      _Pragma("unroll") for (int d0 = 0; d0 < 8; ++d0) Ow[(long)orow * LDO + d0 * 32 + r32] = o[d0][r] * rli[r]; }
  } else {
    _Pragma("unroll") for (int r = 0; r < 16; r += 2) { float o1[2][8];
      _Pragma("unroll") for (int k = 0; k < 2; ++k) _Pragma("unroll") for (int d0 = 0; d0 < 8; ++d0) o1[k][d0] = Ow[(long)crow(r + k, hi) * LDO + d0 * 32 + r32];
      _Pragma("unroll") for (int k = 0; k < 2; ++k) _Pragma("unroll") for (int d0 = 0; d0 < 8; ++d0) Cw[(long)crow(r + k, hi) * LDO + d0 * 32 + r32] = f2bf_rne(o1[k][d0] - lam * (o[d0][r + k] * rli[r + k])); }
  }
  asm volatile("s_waitcnt lgkmcnt(0)\n\ts_barrier" ::: "memory");
}
}
typedef unsigned short bf16_t;
typedef float f32x4 __attribute__((ext_vector_type(4)));
typedef unsigned u32x4 __attribute__((ext_vector_type(4)));
typedef unsigned u32x2 __attribute__((ext_vector_type(2)));
constexpr int DM = 1024, SEQ = 4096, NBATCH = 16, NTOK = NBATCH * SEQ;
constexpr int NGRP = 2, GB = NBATCH / NGRP, TG = GB * SEQ;
constexpr int INW = 8224, NIN = 8448;
constexpr int FFH = 2816, NFI = 2 * FFH;
constexpr float EPS = 1e-6f, SUBLN_EPS = 1e-5f, LAMBDA_INIT = 0.2f;
constexpr size_t MiB = 1u << 20;
constexpr size_t WS_CTL = 0;
constexpr size_t WS_SS1 = 4096, WS_SS2 = 4096 + 262144;
constexpr size_t WS_BAR = 768 * 1024, WS_BAR_BYTES = 16384;
constexpr size_t WS_ROPE = 1 * MiB;
constexpr size_t WS_WIN = 4 * MiB;
constexpr size_t WS_WOUT = 21 * MiB;
constexpr size_t WS_WFI = 23 * MiB;
constexpr size_t WS_WFO = 34 * MiB;
constexpr size_t WS_MERGED = 40 * MiB;
constexpr size_t WS_U = 168 * MiB;
constexpr size_t WS_GQ = 296 * MiB, WS_GK = 328 * MiB, WS_GV = 360 * MiB, WS_GR = 424 * MiB, WS_DQ = 488 * MiB, WS_DK = 552 * MiB, WS_DV = 616 * MiB,
                 WS_GA = 680 * MiB, WS_GB = 744 * MiB, WS_GLR = 808 * MiB;
constexpr size_t WS_OF = 812 * MiB, WS_OB = 876 * MiB, WS_O2C = 940 * MiB, WS_DEC = 1004 * MiB, WS_END = 1006 * MiB;
constexpr size_t OUT_QT = 128 * MiB, OUT_KST = 192 * MiB;
constexpr size_t WS_H1B = 296 * MiB, WS_ACT = 424 * MiB;
static_assert(WS_ACT + (size_t)NTOK * FFH * 2 <= WS_GLR, "tail overlay");
constexpr int LDS_BYTES = 151552;
constexpr int NPHASE = 13;

__device__ __forceinline__ float bf2f(unsigned short b) { return __uint_as_float((unsigned)b << 16); }
__device__ __forceinline__ unsigned short f2bf(float f) { return (unsigned short)pg8::cvt_pk_bf16(f, f); }
__device__ __forceinline__ unsigned pk2(float lo, float hi) { return pg8::cvt_pk_bf16(lo, hi); }
__device__ __forceinline__ float wave_sum(float v) {
#pragma unroll
    for (int o = 1; o < 64; o <<= 1) v += __shfl_xor(v, o);
    return v;
}
__device__ __forceinline__ float sigmoidf_(float x) { return __builtin_amdgcn_rcpf(1.f + __expf(-x)); }

struct EpiIn {
    static constexpr bool PERM = true, AFTER_DRAIN = false;
    bf16_t *GQ, *GK, *GV, *GR, *DQ, *DK, *DV, *GA, *GB; float* GLR; const float* rope;
    __device__ __forceinline__ void operator()(const pg8::f32x4 (&acc)[2][2][4][2], const pg8::Unit& u, int wr, int wc, int fr, int fq) const {
        const int pn = u.pn; const int row0 = u.pm * 256 + wr * 64 + fr;
        if (pn == 32) {
            if (wc == 0) {
#pragma unroll
                for (int ai = 0; ai < 2; ++ai)
#pragma unroll
                    for (int m = 0; m < 4; ++m) { float* p = GLR + (size_t)(row0 + ai * 128 + m * 16) * 32 + 8 * fq;
                        *(f32x4*)p = acc[ai][0][m][0]; *(f32x4*)(p + 4) = acc[ai][0][m][1]; }
            }
            return;
        }
        if (pn >= 12 && pn < 20) {
            bf16_t* base = (pn < 16) ? DQ : DK; const int colt = ((pn - 12) & 3) * 256 + (wc >> 1) * 128; const int i0 = (wc & 1) * 32 + 8 * fq;
#pragma unroll
            for (int ai = 0; ai < 2; ++ai) {
                f32x4 tb[4][4];
#pragma unroll
                for (int m = 0; m < 4; ++m) { const int pos = (row0 + ai * 128 + m * 16) & (SEQ - 1); const f32x4* cs = (const f32x4*)(rope + ((size_t)pos * 64 + i0) * 2);
                    tb[m][0] = cs[0]; tb[m][1] = cs[1]; tb[m][2] = cs[2]; tb[m][3] = cs[3]; }
#pragma unroll
                for (int m = 0; m < 4; ++m) { const int row = row0 + ai * 128 + m * 16;
                    const f32x4 t0 = tb[m][0], t1 = tb[m][1], t2 = tb[m][2], t3 = tb[m][3];
                    const f32x4 xa = acc[ai][0][m][0], xb = acc[ai][0][m][1], ya = acc[ai][1][m][0], yb = acc[ai][1][m][1];
                    u32x4 w1, w2;
                    w1.x = pg8::cvt_pk_bf16(xa[0] * t0[0] - ya[0] * t0[1], xa[1] * t0[2] - ya[1] * t0[3]);
                    w1.y = pg8::cvt_pk_bf16(xa[2] * t1[0] - ya[2] * t1[1], xa[3] * t1[2] - ya[3] * t1[3]);
                    w1.z = pg8::cvt_pk_bf16(xb[0] * t2[0] - yb[0] * t2[1], xb[1] * t2[2] - yb[1] * t2[3]);
                    w1.w = pg8::cvt_pk_bf16(xb[2] * t3[0] - yb[2] * t3[1], xb[3] * t3[2] - yb[3] * t3[3]);
                    w2.x = pg8::cvt_pk_bf16(ya[0] * t0[0] + xa[0] * t0[1], ya[1] * t0[2] + xa[1] * t0[3]);
                    w2.y = pg8::cvt_pk_bf16(ya[2] * t1[0] + xa[2] * t1[1], ya[3] * t1[2] + xa[3] * t1[3]);
                    w2.z = pg8::cvt_pk_bf16(yb[0] * t2[0] + xb[0] * t2[1], yb[1] * t2[2] + xb[1] * t2[3]);
                    w2.w = pg8::cvt_pk_bf16(yb[2] * t3[0] + xb[2] * t3[1], yb[3] * t3[2] + xb[3] * t3[3]);
                    bf16_t* rp = base + (size_t)row * 1024 + colt + i0;
                    *(u32x4*)rp = w1; *(u32x4*)(rp + 64) = w2; } }
            return;
        }
        bf16_t* base; int ld, colt;
        if (pn < 2) { base = GQ; ld = 512; colt = pn * 256; }
        else if (pn < 4) { base = GK; ld = 512; colt = (pn - 2) * 256; }
        else if (pn < 8) { base = GV; ld = 1024; colt = (pn - 4) * 256; }
        else if (pn < 12) { base = GR; ld = 1024; colt = (pn - 8) * 256; }
        else if (pn < 24) { base = DV; ld = 1024; colt = (pn - 20) * 256; }
        else if (pn < 28) { base = GA; ld = 1024; colt = (pn - 24) * 256; }
        else { base = GB; ld = 1024; colt = (pn - 28) * 256; }
        const int col0 = colt + wc * 32 + 8 * fq;
#pragma unroll
        for (int ai = 0; ai < 2; ++ai)
#pragma unroll
            for (int m = 0; m < 4; ++m) { bf16_t* rowp = base + (size_t)(row0 + ai * 128 + m * 16) * ld + col0;
#pragma unroll
                for (int bj = 0; bj < 2; ++bj) { const f32x4 v0 = acc[ai][bj][m][0], v1 = acc[ai][bj][m][1]; u32x4 w;
                    w.x = pg8::cvt_pk_bf16(v0[0], v0[1]); w.y = pg8::cvt_pk_bf16(v0[2], v0[3]); w.z = pg8::cvt_pk_bf16(v1[0], v1[1]); w.w = pg8::cvt_pk_bf16(v1[2], v1[3]);
                    *(u32x4*)(rowp + bj * 128) = w; } }
    }
};
struct EpiOutProj {
    static constexpr bool PERM = true, AFTER_DRAIN = false;
    const float* base; bf16_t* hb; float* ss;
    __device__ __forceinline__ void operator()(const pg8::f32x4 (&acc)[2][2][4][2], const pg8::Unit& u, int wr, int wc, int fr, int fq) const {
        const int row0 = u.pm * 256 + wr * 64 + fr; const int col0 = u.pn * 256 + wc * 32 + 8 * fq;
#pragma unroll
        for (int ai = 0; ai < 2; ++ai) {
            f32x4 xb[4][2][2];
#pragma unroll
            for (int m = 0; m < 4; ++m) { const size_t off = (size_t)(row0 + ai * 128 + m * 16) * 1024 + col0;
#pragma unroll
                for (int bj = 0; bj < 2; ++bj) { xb[m][bj][0] = *(const f32x4*)(base + off + bj * 128); xb[m][bj][1] = *(const f32x4*)(base + off + bj * 128 + 4); } }
#pragma unroll
            for (int m = 0; m < 4; ++m) { const int row = row0 + ai * 128 + m * 16; const size_t off = (size_t)row * 1024 + col0; float s = 0.f;
#pragma unroll
                for (int bj = 0; bj < 2; ++bj) {
                    const f32x4 b0 = xb[m][bj][0], b1 = xb[m][bj][1];
                    const f32x4 h0 = b0 + acc[ai][bj][m][0], h1 = b1 + acc[ai][bj][m][1];
                    s += (h0[0] * h0[0] + h0[1] * h0[1]) + (h0[2] * h0[2] + h0[3] * h0[3]) + (h1[0] * h1[0] + h1[1] * h1[1]) + (h1[2] * h1[2] + h1[3] * h1[3]);
                    u32x4 w; w.x = pg8::cvt_pk_bf16(h0[0], h0[1]); w.y = pg8::cvt_pk_bf16(h0[2], h0[3]); w.z = pg8::cvt_pk_bf16(h1[0], h1[1]); w.w = pg8::cvt_pk_bf16(h1[2], h1[3]);
                    *(u32x4*)(hb + off + bj * 128) = w;
                }
                s += __shfl_xor(s, 16); s += __shfl_xor(s, 32);
                if (fq == 0) atomicAdd(ss + row, s); } }
    }
};
struct EpiFfnOut {
    static constexpr bool PERM = true, AFTER_DRAIN = false;
    const bf16_t* hb; bf16_t* out; float* ss;
    __device__ __forceinline__ void operator()(const pg8::f32x4 (&acc)[2][2][4][2], const pg8::Unit& u, int wr, int wc, int fr, int fq) const {
        const int row0 = u.pm * 256 + wr * 64 + fr; const int col0 = u.pn * 256 + wc * 32 + 8 * fq;
#pragma unroll
        for (int ai = 0; ai < 2; ++ai) {
            u32x4 hq[4][2];
#pragma unroll
            for (int m = 0; m < 4; ++m) { const size_t off = (size_t)(row0 + ai * 128 + m * 16) * 1024 + col0; hq[m][0] = *(const u32x4*)(hb + off); hq[m][1] = *(const u32x4*)(hb + off + 128); }
#pragma unroll
            for (int m = 0; m < 4; ++m) { const int row = row0 + ai * 128 + m * 16; const size_t off = (size_t)row * 1024 + col0; float s = 0.f;
#pragma unroll
                for (int bj = 0; bj < 2; ++bj) {
                    const u32x4 hw = hq[m][bj];
                    f32x4 h0, h1;
                    h0[0] = __uint_as_float(hw.x << 16) + acc[ai][bj][m][0][0]; h0[1] = __uint_as_float(hw.x & 0xffff0000u) + acc[ai][bj][m][0][1];
                    h0[2] = __uint_as_float(hw.y << 16) + acc[ai][bj][m][0][2]; h0[3] = __uint_as_float(hw.y & 0xffff0000u) + acc[ai][bj][m][0][3];
                    h1[0] = __uint_as_float(hw.z << 16) + acc[ai][bj][m][1][0]; h1[1] = __uint_as_float(hw.z & 0xffff0000u) + acc[ai][bj][m][1][1];
                    h1[2] = __uint_as_float(hw.w << 16) + acc[ai][bj][m][1][2]; h1[3] = __uint_as_float(hw.w & 0xffff0000u) + acc[ai][bj][m][1][3];
                    { u32x4 w; w.x = pg8::cvt_pk_bf16(h0[0], h0[1]); w.y = pg8::cvt_pk_bf16(h0[2], h0[3]); w.z = pg8::cvt_pk_bf16(h1[0], h1[1]); w.w = pg8::cvt_pk_bf16(h1[2], h1[3]); *(u32x4*)(out + off + bj * 128) = w; }
                    s += (h0[0] * h0[0] + h0[1] * h0[1]) + (h0[2] * h0[2] + h0[3] * h0[3]) + (h1[0] * h1[0] + h1[1] * h1[1]) + (h1[2] * h1[2] + h1[3] * h1[3]);
                }
                s += __shfl_xor(s, 16); s += __shfl_xor(s, 32);
                if (fq == 0) atomicAdd(ss + row, s); } }
    }
};
struct EpiFfnIn {
    static constexpr bool PERM = true, AFTER_DRAIN = false;
    const float* ss; bf16_t* act;
    __device__ __forceinline__ void operator()(const pg8::f32x4 (&acc)[2][2][4][2], const pg8::Unit& u, int wr, int wc, int fr, int fq) const {
        const int row0 = u.pm * 256 + wr * 64 + fr; const int col0 = u.pn * 128 + wc * 32 + 8 * fq;
        float rsv[2][4];
#pragma unroll
        for (int ai = 0; ai < 2; ++ai)
#pragma unroll
            for (int m = 0; m < 4; ++m) rsv[ai][m] = ss[row0 + ai * 128 + m * 16];
#pragma unroll
        for (int ai = 0; ai < 2; ++ai)
#pragma unroll
            for (int m = 0; m < 4; ++m) { const int row = row0 + ai * 128 + m * 16; const float rstd = rsqrtf(rsv[ai][m] * (1.f / 1024.f) + EPS);
                float o[8];
#pragma unroll
                for (int n = 0; n < 2; ++n)
#pragma unroll
                    for (int e = 0; e < 4; ++e) { const float g = acc[ai][0][m][n][e] * rstd, up = acc[ai][1][m][n][e] * rstd; o[n * 4 + e] = g * sigmoidf_(g) * up; }
                u32x4 w; w.x = pg8::cvt_pk_bf16(o[0], o[1]); w.y = pg8::cvt_pk_bf16(o[2], o[3]); w.z = pg8::cvt_pk_bf16(o[4], o[5]); w.w = pg8::cvt_pk_bf16(o[6], o[7]);
                *(u32x4*)(act + (size_t)row * FFH + col0) = w; }
    }
};

namespace gla {
#define LBAR() do { asm volatile("s_waitcnt lgkmcnt(0)" ::: "memory"); __builtin_amdgcn_s_barrier(); asm volatile("" ::: "memory"); } while (0)
using att::bf16x8; using att::f32x16;
constexpr int LQ = 136, LV = 72;
__device__ __forceinline__ int crow(int r, int hi) { return (r & 3) + 8 * (r >> 2) + 4 * hi; }
constexpr int P_QT = 0, P_KT = 17408, P_GLR = 34816, P_SEG = 38912;
struct Raw { unsigned qv[8], kv[8]; f32x4 gl; };
struct Wd { float wa[16], wb[16]; float ba, bb; };
#define PREP_LOAD(R, item) do { const int dir_ = (item) & 1, h_ = ((item) >> 1) & 3, c_ = ((item) >> 3) & 63, bl_ = (item) >> 9; \
        const long rowb_ = (long)bl_ * SEQ; const int sgn_ = dir_ ? -1 : 1; const int t0_ = dir_ ? (SEQ - 1 - c_ * 64) : c_ * 64; \
        _Pragma("unroll") for (int ii = 0; ii < 8; ++ii) { const long row = rowb_ + t0_ + sgn_ * (seg * 8 + ii); R.qv[ii] = *(const unsigned*)(GQ + row * 512 + h_ * 128 + 2 * d); R.kv[ii] = *(const unsigned*)(GK + row * 512 + h_ * 128 + 2 * d); } \
        if (tid < 256) { const int i = tid >> 2, r4 = tid & 3; R.gl = *(const f32x4*)(GLR + (rowb_ + t0_ + sgn_ * i) * 32 + dir_ * 16 + r4 * 4); } \
        } while (0)
#define PREP_LOADW(W, item) do { const int dir_ = (item) & 1, h_ = ((item) >> 1) & 3; \
        _Pragma("unroll") for (int r = 0; r < 16; ++r) { W.wa[r] = w2g[(dir_ * 16 + r) * 512 + h_ * 128 + 2 * d]; W.wb[r] = w2g[(dir_ * 16 + r) * 512 + h_ * 128 + 2 * d + 1]; } \
        W.ba = bg[dir_ * 512 + h_ * 128 + 2 * d]; W.bb = bg[dir_ * 512 + h_ * 128 + 2 * d + 1]; } while (0)
__device__ __forceinline__ void prep_compute(const Raw& R, const Wd& W, const int it, bf16_t* QT, bf16_t* KST, float* DEC, bf16_t* AM, char* lds,
                                             const int tid, const int lane, const int wid, const int r32, const int hi, const int d, const int seg) {
    bf16_t* Qt = (bf16_t*)(lds + P_QT); bf16_t* Kt = (bf16_t*)(lds + P_KT);
    float* glr_s = (float*)(lds + P_GLR); float* segsum = (float*)(lds + P_SEG);
    typedef float f32x2_ __attribute__((ext_vector_type(2)));
        const int dir = it & 1, h = (it >> 1) & 3, c = (it >> 3) & 63, bl = it >> 9;
        const long rowb = (long)bl * SEQ;
        const size_t cidx = (((size_t)dir * GB + bl) * 4 + h) * 64 + c;
        if (tid < 256) *(f32x4*)(glr_s + (tid >> 2) * 16 + (tid & 3) * 4) = R.gl;
        LBAR();
        float csa[8], csb[8]; float runa = 0.f, runb = 0.f;
#pragma unroll
        for (int ii = 0; ii < 8; ++ii) { const f32x4* gp = (const f32x4*)(glr_s + (seg * 8 + ii) * 16); float la = W.ba, lb = W.bb;
#pragma unroll
            for (int r4 = 0; r4 < 4; ++r4) { const f32x4 gv = gp[r4];
                la += gv[0] * W.wa[4 * r4] + gv[1] * W.wa[4 * r4 + 1] + gv[2] * W.wa[4 * r4 + 2] + gv[3] * W.wa[4 * r4 + 3];
                lb += gv[0] * W.wb[4 * r4] + gv[1] * W.wb[4 * r4 + 1] + gv[2] * W.wb[4 * r4 + 2] + gv[3] * W.wb[4 * r4 + 3]; }
            const float sa = fminf(la, 0.f) - __logf(1.f + __expf(-fabsf(la))), sb = fminf(lb, 0.f) - __logf(1.f + __expf(-fabsf(lb)));
            runa += sa * (1.f / 16.f); runb += sb * (1.f / 16.f); csa[ii] = runa; csb[ii] = runb; }
        *(f32x2_*)(segsum + seg * 128 + 2 * d) = (f32x2_){runa, runb};
        LBAR();
        float prea = 0.f, preb = 0.f, tota = 0.f, totb = 0.f;
#pragma unroll
        for (int s = 0; s < 8; ++s) { const f32x2_ x = *(const f32x2_*)(segsum + s * 128 + 2 * d); tota += x[0]; totb += x[1]; if (s < seg) { prea += x[0]; preb += x[1]; } }
        const float etota = __expf(tota), etotb = __expf(totb);
        bf16_t* qtg = QT + ((size_t)dir * TG + rowb + c * 64 + seg * 8) * 512 + h * 128 + 2 * d;
        float ksa[8], ksb[8];
#pragma unroll
        for (int ii = 0; ii < 8; ++ii) {
            const float ba = csa[ii] + prea, bb = csb[ii] + preb; const float ea = __expf(ba), eb = __expf(bb); const float ia = __builtin_amdgcn_rcpf(ea), ib_ = __builtin_amdgcn_rcpf(eb);
            const float qa = __uint_as_float(R.qv[ii] << 16), qb = __uint_as_float(R.qv[ii] & 0xffff0000u), ka = __uint_as_float(R.kv[ii] << 16), kb = __uint_as_float(R.kv[ii] & 0xffff0000u);
            const unsigned qw = pg8::cvt_pk_bf16(qa * 0.08838834764831845f * ea, qb * 0.08838834764831845f * eb);
            const unsigned kw = pg8::cvt_pk_bf16(ka * ia, kb * ib_);
            ksa[ii] = ka * etota * ia; ksb[ii] = kb * etotb * ib_;
            const int i = seg * 8 + ii;
            *(unsigned*)(Qt + i * LQ + 2 * d) = qw; *(unsigned*)(Kt + i * LQ + 2 * d) = kw;
            *(unsigned*)(qtg + (size_t)ii * 512) = qw; }
        { bf16_t* kp = KST + cidx * 8192 + (2 * d) * 64 + seg * 8;
          *(u32x4*)kp = (u32x4){pg8::cvt_pk_bf16(ksa[0], ksa[1]), pg8::cvt_pk_bf16(ksa[2], ksa[3]), pg8::cvt_pk_bf16(ksa[4], ksa[5]), pg8::cvt_pk_bf16(ksa[6], ksa[7])};
          *(u32x4*)(kp + 64) = (u32x4){pg8::cvt_pk_bf16(ksb[0], ksb[1]), pg8::cvt_pk_bf16(ksb[2], ksb[3]), pg8::cvt_pk_bf16(ksb[4], ksb[5]), pg8::cvt_pk_bf16(ksb[6], ksb[7])}; }
        if (seg == 0) *(f32x2_*)(DEC + cidx * 128 + 2 * d) = (f32x2_){etota, etotb};
        LBAR();
        if (wid < 3) {
            const int ib = wid > 0 ? 1 : 0, jb = wid == 2 ? 1 : 0; f32x16 a = {};
#pragma unroll
            for (int k0 = 0; k0 < 128; k0 += 16) { const bf16x8 A = *(const bf16x8*)(Qt + (ib * 32 + r32) * LQ + k0 + hi * 8); const bf16x8 B = *(const bf16x8*)(Kt + (jb * 32 + r32) * LQ + k0 + hi * 8);
                a = __builtin_amdgcn_mfma_f32_32x32x16_bf16(A, B, a, 0, 0, 0); }
            bf16_t* ap = AM + cidx * 4096;
#pragma unroll
            for (int r = 0; r < 16; ++r) { const int i = ib * 32 + crow(r, hi), j = jb * 32 + r32; ap[i * 64 + j] = f2bf(j <= i ? a[r] : 0.f); }
        } else if (wid == 3) {
            bf16_t* ap = AM + cidx * 4096;
#pragma unroll
            for (int r = 0; r < 16; ++r) ap[crow(r, hi) * 64 + 32 + r32] = 0;
        }
        LBAR();
}
__device__ __forceinline__ void prep_phase(int vcu, int G, int nitems, const bf16_t* GQ, const bf16_t* GK, const float* GLR, const float* w2g, const float* bg,
                                           bf16_t* QT, bf16_t* KST, float* DEC, bf16_t* AM, char* lds) {
    int tid_ = threadIdx.x; asm volatile("" : "+v"(tid_)); const int tid = tid_, lane = tid & 63, wid = tid >> 6, r32 = lane & 31, hi = lane >> 5;
    const int d = tid & 63, seg = tid >> 6;
    int it = vcu; if (it >= nitems) return;
    Raw RA, RB; RA.gl = (f32x4){0.f, 0.f, 0.f, 0.f}; RB.gl = RA.gl;
    PREP_LOAD(RA, it);
    Wd W; int whd = it & 7; PREP_LOADW(W, it);
    for (;;) {
        { const int nx = it + G; if (nx < nitems) PREP_LOAD(RB, nx); prep_compute(RA, W, it, QT, KST, DEC, AM, lds, tid, lane, wid, r32, hi, d, seg); it = nx; if (it >= nitems) break; if ((it & 7) != whd) { whd = it & 7; PREP_LOADW(W, it); } }
        { const int nx = it + G; if (nx < nitems) PREP_LOAD(RA, nx); prep_compute(RB, W, it, QT, KST, DEC, AM, lds, tid, lane, wid, r32, hi, d, seg); it = nx; if (it >= nitems) break; if ((it & 7) != whd) { whd = it & 7; PREP_LOADW(W, it); } }
    }
    LBAR();
}
#undef PREP_LOAD
#undef PREP_LOADW
constexpr int S_ST = 0, S_QT = 17408, S_KST = 34816, S_AM = 53248, S_VT = 62464, S_DC = 71680;
struct Pre { u32x4 q0, q1, k0, k1, am, vr; float dcv; };
__device__ __forceinline__ void scan_item(int item, const bf16_t* GV, const bf16_t* QT, const bf16_t* KST, const float* DEC, const bf16_t* AM, bf16_t* OF, bf16_t* OB, char* lds) {
    int tid_ = threadIdx.x; asm volatile("" : "+v"(tid_)); const int tid = tid_, lane = tid & 63, wid = tid >> 6, r32 = lane & 31, hi = lane >> 5;
    const int vs = item & 3, dir = (item >> 2) & 1, h = (item >> 3) & 3, bl = item >> 5;
    bf16_t* St = (bf16_t*)(lds + S_ST); bf16_t* Qs = (bf16_t*)(lds + S_QT); bf16_t* Ks = (bf16_t*)(lds + S_KST); bf16_t* As = (bf16_t*)(lds + S_AM);
    bf16_t* Vt = (bf16_t*)(lds + S_VT); float* dcs = (float*)(lds + S_DC);
    for (int i = tid; i < 64 * LQ / 2; i += 512) ((unsigned*)St)[i] = 0u;
    f32x16 Sacc = {};
    const int db = wid >> 1, vb = wid & 1, ib = (wid >> 1) & 1, ov = wid & 1;
    bf16_t* Oout = (dir ? OB : OF) + h * 256 + vs * 64 + ov * 32 + r32;
    const long rowb = (long)bl * SEQ; const int sgn = dir ? -1 : 1;
    const int vj = tid & 63, vg = tid >> 6;
    const size_t bh = (((size_t)dir * GB + bl) * 4 + h) * 64;
    const bf16_t* qsrc = QT + ((size_t)dir * TG + rowb + (tid >> 3)) * 512 + h * 128 + (tid & 7) * 16;
    const bf16_t* ksrc = KST + bh * 8192 + (tid >> 2) * 64 + (tid & 3) * 16;
    const bf16_t* asrc = AM + bh * 4096 + (tid >> 3) * 64 + (tid & 7) * 8;
    const float* decb = DEC + bh * 128 + (tid & 127);
    const bf16_t* gvb = GV + h * 256 + vs * 64 + vg * 8;
    bf16_t* qdst = Qs + (tid >> 3) * LQ + (tid & 7) * 16; bf16_t* kdst = Ks + (tid >> 2) * LV + (tid & 3) * 16; bf16_t* adst = As + (tid >> 3) * LV + (tid & 7) * 8;
#define GLA_LOAD(P, c) do { const int t0_ = dir ? (SEQ - 1 - (c) * 64) : (c) * 64; \
        P.q0 = *(const u32x4*)(qsrc + (size_t)(c) * 64 * 512); P.q1 = *(const u32x4*)(qsrc + (size_t)(c) * 64 * 512 + 8); \
        P.k0 = *(const u32x4*)(ksrc + (size_t)(c) * 8192); P.k1 = *(const u32x4*)(ksrc + (size_t)(c) * 8192 + 8); \
        P.am = *(const u32x4*)(asrc + (size_t)(c) * 4096); \
        if (tid < 128) P.dcv = decb[(size_t)(c) * 128]; \
        P.vr = *(const u32x4*)(gvb + (rowb + t0_ + sgn * vj) * 1024); } while (0)
#define GLA_STEP(P, c) do { const int t0_ = dir ? (SEQ - 1 - (c) * 64) : (c) * 64; \
        *(u32x4*)qdst = P.q0; *(u32x4*)(qdst + 8) = P.q1; *(u32x4*)kdst = P.k0; *(u32x4*)(kdst + 8) = P.k1; *(u32x4*)adst = P.am; \
        _Pragma("unroll") for (int e = 0; e < 8; ++e) Vt[(vg * 8 + e) * LV + vj] = (unsigned short)(P.vr[e >> 1] >> ((e & 1) * 16)); \
        if (tid < 128) dcs[tid] = P.dcv; \
        LBAR(); \
        if (wid < 4) { f32x16 o = {}, o2 = {}; \
            _Pragma("unroll") for (int t = 0; t < 8; ++t) { const bf16x8 A = *(const bf16x8*)(Qs + (ib * 32 + r32) * LQ + 16 * t + hi * 8); const bf16x8 B = *(const bf16x8*)(St + (ov * 32 + r32) * LQ + 16 * t + hi * 8); \
                o = __builtin_amdgcn_mfma_f32_32x32x16_bf16(A, B, o, 0, 0, 0); } \
            _Pragma("unroll") for (int t = 0; t < 4; ++t) { const bf16x8 A = *(const bf16x8*)(As + (ib * 32 + r32) * LV + 16 * t + hi * 8); const bf16x8 B = *(const bf16x8*)(Vt + (ov * 32 + r32) * LV + 16 * t + hi * 8); \
                o2 = __builtin_amdgcn_mfma_f32_32x32x16_bf16(A, B, o2, 0, 0, 0); } \
            _Pragma("unroll") for (int r = 0; r < 16; ++r) Oout[(rowb + t0_ + sgn * (ib * 32 + crow(r, hi))) * 1024] = f2bf(o[r] + o2[r]); } \
        _Pragma("unroll") for (int g = 0; g < 4; ++g) { const f32x4 dc = *(const f32x4*)(dcs + db * 32 + 8 * g + 4 * hi); \
            Sacc[4 * g] *= dc[0]; Sacc[4 * g + 1] *= dc[1]; Sacc[4 * g + 2] *= dc[2]; Sacc[4 * g + 3] *= dc[3]; } \
        _Pragma("unroll") for (int t = 0; t < 4; ++t) { const bf16x8 A = *(const bf16x8*)(Ks + (db * 32 + r32) * LV + 16 * t + hi * 8); const bf16x8 B = *(const bf16x8*)(Vt + (vb * 32 + r32) * LV + 16 * t + hi * 8); \
            Sacc = __builtin_amdgcn_mfma_f32_32x32x16_bf16(A, B, Sacc, 0, 0, 0); } \
        LBAR(); \
        _Pragma("unroll") for (int g = 0; g < 4; ++g) { u32x2 w; w.x = pk2(Sacc[4 * g], Sacc[4 * g + 1]); w.y = pk2(Sacc[4 * g + 2], Sacc[4 * g + 3]); \
            *(u32x2*)(St + (vb * 32 + r32) * LQ + db * 32 + 8 * g + 4 * hi) = w; } } while (0)
    Pre P0, P1, P2, P3; P0.dcv = 0.f; P1.dcv = 0.f; P2.dcv = 0.f; P3.dcv = 0.f;
    GLA_LOAD(P0, 0); GLA_LOAD(P1, 1); GLA_LOAD(P2, 2); GLA_LOAD(P3, 3);
    LBAR();
    for (int c = 0; c < 64; c += 4) {
        GLA_STEP(P0, c);     if (c + 4 < 64) GLA_LOAD(P0, c + 4);
        GLA_STEP(P1, c + 1); if (c + 5 < 64) GLA_LOAD(P1, c + 5);
        GLA_STEP(P2, c + 2); if (c + 6 < 64) GLA_LOAD(P2, c + 6);
        GLA_STEP(P3, c + 3); if (c + 7 < 64) GLA_LOAD(P3, c + 7);
    }
    LBAR();
#undef GLA_LOAD
#undef GLA_STEP
}
}

#define LASF __attribute__((address_space(3)))
__device__ __forceinline__ void tr_item(const float* W, int K, int N, bf16_t* WT, int n0, int c0, int k0, const float* kscale, float* scr, int lane) {
    float tv[32];
#pragma unroll
    for (int i = 0; i < 32; ++i) { const int kk = 2 * i + (lane >> 5); tv[i] = (c0 >= 0) ? W[(size_t)(k0 + kk) * N + c0 + (lane & 31)] : 0.f; }
#pragma unroll
    for (int i = 0; i < 32; ++i) { const int kk = 2 * i + (lane >> 5); float v = tv[i]; if (kscale) v *= kscale[k0 + kk]; scr[kk * 33 + (lane & 31)] = v; }
    asm volatile("s_waitcnt lgkmcnt(0)" ::: "memory");
    const int c = lane & 7;
#pragma unroll
    for (int j = 0; j < 4; ++j) { const int n = (lane >> 3) + 8 * j; const float* s = scr + (8 * c) * 33 + n;
        u32x4 o; o.x = pk2(s[0 * 33], s[1 * 33]); o.y = pk2(s[2 * 33], s[3 * 33]); o.z = pk2(s[4 * 33], s[5 * 33]); o.w = pk2(s[6 * 33], s[7 * 33]);
        *(u32x4*)(WT + (size_t)(n0 + n) * K + k0 + 8 * c) = o; }
    asm volatile("s_waitcnt lgkmcnt(0)" ::: "memory");
}
__device__ __forceinline__ int win_src(int n0) {
    if (n0 < 3072) return n0;
    if (n0 < 5120) { const int t = n0 & ~255, p = n0 & 255; const int bj = p >> 7, blk = (p >> 6) & 1, i = p & 63; return t + 32 + blk * 128 + bj * 64 + i; }
    if (n0 < 8192) return n0 + 32;
    if (n0 == 8192) return 3072;
    return -1;
}
__device__ __forceinline__ int wfi_src(int n0) { const int pn = n0 >> 8, p = n0 & 255, bj = p >> 7, j = p & 127; return bj * FFH + pn * 128 + j; }

struct KArgs { const float* in[16]; float* out; unsigned char* ws; int ph_lo, ph_hi; };

__device__ __forceinline__ void phase_prologue(const KArgs& a, char* lds, int vcu, int G) {
    int tid_ = threadIdx.x; asm volatile("" : "+v"(tid_)); const int tid = tid_, lane = tid & 63, wid = tid >> 6;
    unsigned char* ws = a.ws;
    float* scr = (float*)(lds + wid * 8704);
    const int gw = vcu * 8 + wid, NGW = G * 8;
    constexpr int I_IN = (NIN / 32) * 16, I_OUT = 32 * 16, I_FI = (NFI / 32) * 16, I_FO = 32 * 44;
    for (int it = gw; it < I_IN + I_OUT + I_FI + I_FO; it += NGW) {
        int r = it;
        if (r < I_IN) { const int nb = r >> 4, kb = r & 15; tr_item(a.in[2], DM, INW, (bf16_t*)(ws + WS_WIN), nb * 32, win_src(nb * 32), kb * 64, nullptr, scr, lane); continue; } r -= I_IN;
        if (r < I_OUT) { const int nb = r >> 4, kb = r & 15; tr_item(a.in[11], DM, DM, (bf16_t*)(ws + WS_WOUT), nb * 32, nb * 32, kb * 64, nullptr, scr, lane); continue; } r -= I_OUT;
        if (r < I_FI) { const int nb = r >> 4, kb = r & 15; tr_item(a.in[13], DM, NFI, (bf16_t*)(ws + WS_WFI), nb * 32, wfi_src(nb * 32), kb * 64, a.in[12], scr, lane); continue; } r -= I_FI;
        { const int nb = r / 44, kb = r % 44; tr_item(a.in[14], FFH, DM, (bf16_t*)(ws + WS_WFO), nb * 32, nb * 32, kb * 64, nullptr, scr, lane); }
    }
    { const float* nw = a.in[1]; bf16_t* U = (bf16_t*)(ws + WS_U);
      f32x4 wv[4];
#pragma unroll
      for (int j = 0; j < 4; ++j) wv[j] = *((const f32x4*)nw + lane + 64 * j);
      for (int m0 = gw; m0 < NTOK; m0 += 4 * NGW) {
        f32x4 v[4][4]; float s[4];
#pragma unroll
        for (int k = 0; k < 4; ++k) { const int m = m0 + k * NGW; s[k] = 0.f; if (m < NTOK) { const f32x4* __restrict__ xr = (const f32x4*)(a.in[0] + (size_t)m * DM) + lane;
#pragma unroll
            for (int j = 0; j < 4; ++j) v[k][j] = xr[64 * j]; } else {
#pragma unroll
            for (int j = 0; j < 4; ++j) v[k][j] = (f32x4){0.f, 0.f, 0.f, 0.f}; } }
#pragma unroll
        for (int k = 0; k < 4; ++k) {
#pragma unroll
            for (int j = 0; j < 4; ++j) s[k] += (v[k][j][0] * v[k][j][0] + v[k][j][1] * v[k][j][1]) + (v[k][j][2] * v[k][j][2] + v[k][j][3] * v[k][j][3]); }
#pragma unroll
        for (int k = 0; k < 4; ++k) { const int m = m0 + k * NGW; if (m < NTOK) { const float rstd = rsqrtf(wave_sum(s[k]) * (1.f / DM) + EPS);
            u32x2* __restrict__ o8 = (u32x2*)(U + (size_t)m * DM) + lane;
#pragma unroll
            for (int j = 0; j < 4; ++j) { u32x2 w; w.x = pk2(v[k][j][0] * rstd * wv[j][0], v[k][j][1] * rstd * wv[j][1]); w.y = pk2(v[k][j][2] * rstd * wv[j][2], v[k][j][3] * rstd * wv[j][3]); o8[64 * j] = w; } } }
      } }
    { float* rope = (float*)(ws + WS_ROPE);
      for (int idx = vcu * 512 + tid; idx < SEQ * 64; idx += G * 512) { const int pos = idx >> 6, i = idx & 63;
          const double inv = exp(-9.210340371976184 * (double)i / 64.0); const double ang = (double)pos * inv;
          rope[2 * idx] = (float)cos(ang); rope[2 * idx + 1] = (float)sin(ang); } }
    { float* ss = (float*)(ws + WS_SS1);
      for (int idx = vcu * 512 + tid; idx < 2 * NTOK; idx += G * 512) ss[idx] = 0.f; }
    if (vcu == 0 && wid == 0) {
        const float s1 = wave_sum(a.in[6][lane] * a.in[7][lane] + a.in[6][lane + 64] * a.in[7][lane + 64]);
        const float s2 = wave_sum(a.in[8][lane] * a.in[9][lane] + a.in[8][lane + 64] * a.in[9][lane + 64]);
        if (lane == 0) *(float*)(ws + WS_CTL) = expf(s1) - expf(s2) + LAMBDA_INIT;
    }
}

__device__ __forceinline__ void phase_merge(const KArgs& a, int g, int vcu, int G) {
    int tid_ = threadIdx.x; asm volatile("" : "+v"(tid_)); const int tid = tid_, lane = tid & 63, wid = tid >> 6;
    unsigned char* ws = a.ws;
    const bf16_t* __restrict__ OF = (const bf16_t*)(ws + WS_OF); const bf16_t* __restrict__ OB = (const bf16_t*)(ws + WS_OB); const bf16_t* __restrict__ GR = (const bf16_t*)(ws + WS_GR);
    const bf16_t* __restrict__ O2 = (const bf16_t*)(ws + WS_O2C); const bf16_t* __restrict__ GA = (const bf16_t*)(ws + WS_GA); const bf16_t* __restrict__ GBb = (const bf16_t*)(ws + WS_GB);
    bf16_t* __restrict__ MG = (bf16_t*)(ws + WS_MERGED) + (size_t)g * TG * DM;
    const int e0 = lane * 16, c0 = e0 & 255;
    float gw_[16], sw_[16];
#pragma unroll
    for (int e = 0; e < 16; ++e) { gw_[e] = a.in[5][c0 + e]; sw_[e] = a.in[10][c0 + e] * (1.f - LAMBDA_INIT); }
#pragma unroll 2
    for (int m = vcu * 8 + wid; m < TG; m += G * 8) {
        const size_t off = (size_t)m * DM + e0;
        u32x4 vf[2], vb[2], vr[2], v2[2], va[2], vg[2];
#pragma unroll
        for (int q = 0; q < 2; ++q) { vf[q] = *(const u32x4*)(OF + off + 8 * q); vb[q] = *(const u32x4*)(OB + off + 8 * q); vr[q] = *(const u32x4*)(GR + off + 8 * q);
            v2[q] = *(const u32x4*)(O2 + off + 8 * q); va[q] = *(const u32x4*)(GA + off + 8 * q); vg[q] = *(const u32x4*)(GBb + off + 8 * q); }
        float oa[16], o2[16]; float sa = 0.f, sb = 0.f;
#pragma unroll
        for (int e = 0; e < 16; ++e) { const int q = e >> 3, w = (e >> 1) & 3, sh = (e & 1) * 16;
            const float f = bf2f((unsigned short)(vf[q][w] >> sh)) + bf2f((unsigned short)(vb[q][w] >> sh)); const float t = bf2f((unsigned short)(v2[q][w] >> sh));
            oa[e] = f; o2[e] = t; sa += f * f; sb += t * t; }
#pragma unroll
        for (int o = 1; o < 16; o <<= 1) { sa += __shfl_xor(sa, o); sb += __shfl_xor(sb, o); }
        const float ra = rsqrtf(sa * (1.f / 256.f) + EPS), rb = rsqrtf(sb * (1.f / 256.f) + SUBLN_EPS);
        float mo[16];
#pragma unroll
        for (int e = 0; e < 16; ++e) { const int q = e >> 3, w = (e >> 1) & 3, sh = (e & 1) * 16;
            const float gr = bf2f((unsigned short)(vr[q][w] >> sh)), ga = bf2f((unsigned short)(va[q][w] >> sh)), gb = bf2f((unsigned short)(vg[q][w] >> sh));
            const float ya = oa[e] * ra * gw_[e] * (gr * sigmoidf_(gr)); const float yb = o2[e] * rb * sw_[e];
            mo[e] = sigmoidf_(ga) * ya + sigmoidf_(gb) * yb; }
        u32x4 w0, w1;
        w0.x = pk2(mo[0], mo[1]); w0.y = pk2(mo[2], mo[3]); w0.z = pk2(mo[4], mo[5]); w0.w = pk2(mo[6], mo[7]);
        w1.x = pk2(mo[8], mo[9]); w1.y = pk2(mo[10], mo[11]); w1.z = pk2(mo[12], mo[13]); w1.w = pk2(mo[14], mo[15]);
        *(u32x4*)(MG + off) = w0; *(u32x4*)(MG + off + 8) = w1;
    }
}

__device__ __forceinline__ void glr_panels(const bf16_t* U, const bf16_t* WT, float* GLR, int vcu, int G) {
    int tid_ = threadIdx.x; asm volatile("" : "+v"(tid_)); const int lane = tid_ & 63, wid = tid_ >> 6, r32 = lane & 31, hi = lane >> 5;
    const bf16_t* bp = WT + (size_t)r32 * DM + hi * 8;
    for (int p = vcu * 8 + wid; p < TG / 32; p += G * 8) {
        const bf16_t* ap = U + (size_t)(p * 32 + r32) * DM + hi * 8;
        att::f32x16 acc = {};
        att::bf16x8 fa[8], fb[8], ga[8], gb[8];
#define GLR_LD(A_, B_, t0_) do { _Pragma("unroll") for (int t = 0; t < 8; ++t) { A_[t] = *(const att::bf16x8*)(ap + 16 * ((t0_) + t)); B_[t] = *(const att::bf16x8*)(bp + 16 * ((t0_) + t)); } } while (0)
#define GLR_MM(A_, B_) do { _Pragma("unroll") for (int t = 0; t < 8; ++t) acc = __builtin_amdgcn_mfma_f32_32x32x16_bf16(A_[t], B_[t], acc, 0, 0, 0); } while (0)
        GLR_LD(fa, fb, 0);
#pragma unroll 1
        for (int t0 = 0; t0 < 64; t0 += 16) { GLR_LD(ga, gb, t0 + 8); GLR_MM(fa, fb); if (t0 + 16 < 64) GLR_LD(fa, fb, t0 + 16); GLR_MM(ga, gb); }
#undef GLR_LD
#undef GLR_MM
#pragma unroll
        for (int r = 0; r < 16; ++r) GLR[(size_t)(p * 32 + gla::crow(r, hi)) * 32 + r32] = acc[r];
    }
}
#define LAS __attribute__((address_space(3)))
#define XB_TMO      128
#define XB_XCNT(j)  (256  + 64 * (j))
#define XB_XSUB(j)  (1280 + 64 * (j))
#define XB_XGEN(j)  (2304 + 64 * (j))
#define XB_TOP      3328
#define XB_TOPGEN   3392
#define XCD_BAR_WORDS 3456
#define XB_SPIN_CAP (1u << 18)

__device__ __forceinline__ unsigned xb_ld(unsigned* p)              { return __hip_atomic_load(p, __ATOMIC_RELAXED, __HIP_MEMORY_SCOPE_AGENT); }
__device__ __forceinline__ unsigned xb_add(unsigned* p, unsigned v) { return __hip_atomic_fetch_add(p, v, __ATOMIC_RELAXED, __HIP_MEMORY_SCOPE_AGENT); }
__device__ __forceinline__ unsigned xb_xcc_id() { return (unsigned)__builtin_amdgcn_s_getreg((3 << 11) | 20) & 0xFu; }
#define XB_SPIN(cond, bar) do { unsigned _sp = 0; while (cond) { __builtin_amdgcn_s_sleep(1); \
    if ((++_sp & 255u) == 0u) { if (xb_ld(&(bar)[XB_TMO])) break; if (_sp > XB_SPIN_CAP) { atomicAdd(&(bar)[XB_TMO], 1u); break; } } } } while (0)

struct XcdBarrier {
    unsigned* bar; unsigned x;
    volatile LAS unsigned* st;
};

__device__ __forceinline__ XcdBarrier xcd_barrier_post(unsigned* bar, volatile LAS unsigned* st) {
    XcdBarrier b; b.bar = bar; b.x = xb_xcc_id(); b.st = st;
    if (threadIdx.x == 0) st[2] = xb_add(&bar[XB_XCNT(b.x)], 1u);
    return b;
}
__device__ __forceinline__ void xcd_barrier_complete(unsigned* bar, unsigned x, unsigned& nloc, unsigned& nx) {
    const unsigned G = gridDim.x * gridDim.y * gridDim.z;
    unsigned sum, cnt, mine, sp = 0u;
    for (;;) {
        sum = 0u; cnt = 0u; mine = 0u;
#pragma unroll
        for (unsigned j = 0; j < 16; ++j) { const unsigned c = xb_ld(&bar[XB_XCNT(j)]); sum += c; cnt += (c > 0u) ? 1u : 0u; mine = (j == x) ? c : mine; }
        if (sum == G) break;
        __builtin_amdgcn_s_sleep(1);
        if ((++sp & 255u) == 0u) { if (xb_ld(&bar[XB_TMO])) break; if (sp > XB_SPIN_CAP) { atomicAdd(&bar[XB_TMO], 1u); break; } }
    }
    nloc = mine > 0u ? mine : 1u; nx = cnt > 0u ? cnt : 1u;
}

__device__ __forceinline__ void xcd_barrier(const XcdBarrier& b) {
    asm volatile("s_waitcnt vmcnt(0)" ::: "memory");
    __syncthreads();
    if (threadIdx.x == 0) {
        unsigned* bar = b.bar;
        __builtin_amdgcn_s_waitcnt(0);
        unsigned nloc = b.st[0], nx = b.st[1];
        if (nloc == 0u) { xcd_barrier_complete(bar, b.x, nloc, nx); b.st[0] = nloc; b.st[1] = nx; }
        const unsigned old = xb_add(&bar[XB_XSUB(b.x)], 1u);
        const unsigned gen = old / nloc;
        if (old + 1u == (gen + 1u) * nloc) {
            __builtin_amdgcn_fence(__ATOMIC_RELEASE, "agent");
            asm volatile("s_waitcnt vmcnt(0)" ::: "memory");
            const unsigned og = xb_add(&bar[XB_TOP], 1u);
            const unsigned tg = og / nx;
            if (og + 1u == (tg + 1u) * nx) xb_add(&bar[XB_TOPGEN], 1u);
            else XB_SPIN(xb_ld(&bar[XB_TOPGEN]) == tg, bar);
            __builtin_amdgcn_fence(__ATOMIC_ACQUIRE, "agent");
            xb_add(&bar[XB_XGEN(b.x)], 1u);
            asm volatile("s_waitcnt vmcnt(0)" ::: "memory");
        } else {
            XB_SPIN(xb_ld(&bar[XB_XGEN(b.x)]) == gen, bar);
            __builtin_amdgcn_fence(__ATOMIC_ACQUIRE, "agent");
            asm volatile("s_waitcnt vmcnt(0)" ::: "memory");
        }
    }
    __syncthreads();
}

__global__ void __launch_bounds__(512) hybrid_fwd(KArgs a) {
    extern __shared__ __attribute__((aligned(16))) unsigned char lds[];
    cg::grid_group grid = cg::this_grid();
    const int G = gridDim.x, bx = blockIdx.x;
    int vcu = (G % 8 == 0) ? (bx % 8) * (G / 8) + bx / 8 : bx;
    int cg_ = bx;
#define IN(k) (lo <= (k) && (k) < hi)
#define SEAM(k) do { if (IN(k) && IN((k) + 1)) xcd_barrier(xbar); } while (0)
#define WSP unsigned char* ws = a.ws
    const int lo = a.ph_lo, hi = a.ph_hi;
    if (lo > NPHASE) grid.sync();
    volatile LAS unsigned* xst = (volatile LAS unsigned*)((LAS unsigned char*)lds + 150528);
    if (threadIdx.x < 4) xst[threadIdx.x] = 0u;
    __syncthreads();
    XcdBarrier xbar; xbar.bar = (unsigned*)(a.ws + WS_BAR); xbar.x = 0; xbar.st = xst;
    if (hi - lo > 2) xbar = xcd_barrier_post((unsigned*)(a.ws + WS_BAR), xst);
    if (IN(0)) {
#ifndef DIS_PRO
        phase_prologue(a, (char*)lds, vcu, G);
#endif
    }
    SEAM(0);
    if (IN(0) && IN(1) && G % 8 == 0) {
        if (threadIdx.x == 0) { bool ok = xbar.x < 8u; for (unsigned j = 0; j < 16; ++j) { const unsigned c = xb_ld(&xbar.bar[XB_XCNT(j)]); ok = ok && (c == (j < 8u ? (unsigned)G / 8u : 0u)); }
            xst[3] = ok ? 1u : 0u; }
        __syncthreads();
        if (xst[3]) { const int rk = (int)xst[2], xc = (int)xbar.x; vcu = xc * (G / 8) + rk; cg_ = rk * 8 + xc; }
    }
    { constexpr int g = 0;
      if (IN(1)) { WSP;
                glr_panels((const bf16_t*)(ws + WS_U) + (size_t)g * TG * DM, (const bf16_t*)(ws + WS_WIN) + (size_t)8192 * DM, (float*)(ws + WS_GLR), vcu, G);
                pg8::Gemm gm{(const bf16_t*)(ws + WS_U) + (size_t)g * TG * DM, (const bf16_t*)(ws + WS_WIN), TG, 8192, DM};
                pg8::StaticOrder S; S.init(TG, 8192, G, cg_);
                EpiIn E{(bf16_t*)(ws + WS_GQ), (bf16_t*)(ws + WS_GK), (bf16_t*)(ws + WS_GV), (bf16_t*)(ws + WS_GR), (bf16_t*)(ws + WS_DQ), (bf16_t*)(ws + WS_DK), (bf16_t*)(ws + WS_DV),
                        (bf16_t*)(ws + WS_GA), (bf16_t*)(ws + WS_GB), (float*)(ws + WS_GLR), (const float*)(ws + WS_ROPE)};
#ifndef DIS_G1
                pg8::gemm_phase<EpiIn, pg8::StaticOrder, true, true>((PG8_LAS unsigned char*)lds, gm, S, E);
#endif
      }
      SEAM(1);
            if (IN(2)) { WSP;
#ifndef DIS_GLA
                gla::prep_phase(vcu, G, GB * 512, (const bf16_t*)(ws + WS_GQ), (const bf16_t*)(ws + WS_GK), (const float*)(ws + WS_GLR), a.in[3], a.in[4],
                                (bf16_t*)((unsigned char*)a.out + OUT_QT), (bf16_t*)((unsigned char*)a.out + OUT_KST), (float*)(ws + WS_DEC), (bf16_t*)(ws + WS_MERGED + 64 * MiB), (char*)lds);
#endif
      }
      SEAM(2);
      if (IN(3)) { WSP;
#ifndef DIS_GLA
                for (int it = vcu; it < GB * 32; it += G)
                    gla::scan_item(it, (const bf16_t*)(ws + WS_GV), (const bf16_t*)((unsigned char*)a.out + OUT_QT), (const bf16_t*)((unsigned char*)a.out + OUT_KST), (const float*)(ws + WS_DEC), (const bf16_t*)(ws + WS_MERGED + 64 * MiB),
                                   (bf16_t*)(ws + WS_OF), (bf16_t*)(ws + WS_OB), (char*)lds);
#endif
#ifndef DIS_ATT
                const float lam = *(const float*)(ws + WS_CTL);
                for (int un = vcu; un < GB * 64; un += G) {
                    const int qb = un & 15, h = (un >> 4) & 3, bl = un >> 6;
                    const size_t r0 = (size_t)bl * SEQ * 1024;
                    const att::bf16* Q = (const att::bf16*)(ws + WS_DQ) + r0 + (size_t)qb * 256 * 1024 + h * 256;
                    const att::bf16* Kp = (const att::bf16*)(ws + WS_DK) + r0 + h * 256;
                    const att::bf16* Vp = (const att::bf16*)(ws + WS_DV) + r0 + h * 256;
                    float* O1 = a.out + r0 + (size_t)qb * 256 * 1024 + h * 256;
                    bf16_t* O2 = (bf16_t*)(ws + WS_O2C) + r0 + (size_t)qb * 256 * 1024 + h * 256;
#pragma unroll 1
                    for (int p = 0; p < 2; ++p) att2::attn256_body(Q + 128 * p, Kp + 128 * p, Vp, O1, O2, p, lam, SEQ, (char*)lds);
                }
#endif
      }
      SEAM(3);
      if (IN(4)) {
#ifndef DIS_MRG
                phase_merge(a, g, vcu, G);
#endif
      }
      SEAM(4);
    }
    { constexpr int g = 1;
      if (IN(5)) { WSP;
                glr_panels((const bf16_t*)(ws + WS_U) + (size_t)g * TG * DM, (const bf16_t*)(ws + WS_WIN) + (size_t)8192 * DM, (float*)(ws + WS_GLR), vcu, G);
                pg8::Gemm gm{(const bf16_t*)(ws + WS_U) + (size_t)g * TG * DM, (const bf16_t*)(ws + WS_WIN), TG, 8192, DM};
                pg8::StaticOrder S; S.init(TG, 8192, G, cg_);
                EpiIn E{(bf16_t*)(ws + WS_GQ), (bf16_t*)(ws + WS_GK), (bf16_t*)(ws + WS_GV), (bf16_t*)(ws + WS_GR), (bf16_t*)(ws + WS_DQ), (bf16_t*)(ws + WS_DK), (bf16_t*)(ws + WS_DV),
                        (bf16_t*)(ws + WS_GA), (bf16_t*)(ws + WS_GB), (float*)(ws + WS_GLR), (const float*)(ws + WS_ROPE)};
#ifndef DIS_G1
                pg8::gemm_phase<EpiIn, pg8::StaticOrder, true, true>((PG8_LAS unsigned char*)lds, gm, S, E);
#endif
      }
      SEAM(5);
            if (IN(6)) { WSP;
#ifndef DIS_GLA
                gla::prep_phase(vcu, G, GB * 512, (const bf16_t*)(ws + WS_GQ), (const bf16_t*)(ws + WS_GK), (const float*)(ws + WS_GLR), a.in[3], a.in[4],
                                (bf16_t*)((unsigned char*)a.out + OUT_QT), (bf16_t*)((unsigned char*)a.out + OUT_KST), (float*)(ws + WS_DEC), (bf16_t*)(ws + WS_MERGED + 64 * MiB), (char*)lds);
#endif
      }
      SEAM(6);
      if (IN(7)) { WSP;
#ifndef DIS_GLA
                for (int it = vcu; it < GB * 32; it += G)
                    gla::scan_item(it, (const bf16_t*)(ws + WS_GV), (const bf16_t*)((unsigned char*)a.out + OUT_QT), (const bf16_t*)((unsigned char*)a.out + OUT_KST), (const float*)(ws + WS_DEC), (const bf16_t*)(ws + WS_MERGED + 64 * MiB),
                                   (bf16_t*)(ws + WS_OF), (bf16_t*)(ws + WS_OB), (char*)lds);
#endif
#ifndef DIS_ATT
                const float lam = *(const float*)(ws + WS_CTL);
                for (int un = vcu; un < GB * 64; un += G) {
                    const int qb = un & 15, h = (un >> 4) & 3, bl = un >> 6;
                    const size_t r0 = (size_t)bl * SEQ * 1024;
                    const att::bf16* Q = (const att::bf16*)(ws + WS_DQ) + r0 + (size_t)qb * 256 * 1024 + h * 256;
                    const att::bf16* Kp = (const att::bf16*)(ws + WS_DK) + r0 + h * 256;
                    const att::bf16* Vp = (const att::bf16*)(ws + WS_DV) + r0 + h * 256;
                    float* O1 = a.out + r0 + (size_t)qb * 256 * 1024 + h * 256;
                    bf16_t* O2 = (bf16_t*)(ws + WS_O2C) + r0 + (size_t)qb * 256 * 1024 + h * 256;
#pragma unroll 1
                    for (int p = 0; p < 2; ++p) att2::attn256_body(Q + 128 * p, Kp + 128 * p, Vp, O1, O2, p, lam, SEQ, (char*)lds);
                }
#endif
      }
      SEAM(7);
      if (IN(8)) {
#ifndef DIS_MRG
                phase_merge(a, g, vcu, G);
#endif
      }
      SEAM(8);
    }
    if (IN(9)) { WSP;
            pg8::Gemm gm{(const bf16_t*)(ws + WS_MERGED), (const bf16_t*)(ws + WS_WOUT), NTOK, DM, DM};
            pg8::StaticOrder S; S.init(NTOK, DM, G, cg_);
            EpiOutProj E{a.in[0], (bf16_t*)(ws + WS_H1B), (float*)(ws + WS_SS1)};
#ifndef DIS_G2
            pg8::gemm_phase<EpiOutProj, pg8::StaticOrder, true, true>((PG8_LAS unsigned char*)lds, gm, S, E);
#endif
    }
    SEAM(9);
    if (IN(10)) { WSP;
            pg8::Gemm gm{(const bf16_t*)(ws + WS_H1B), (const bf16_t*)(ws + WS_WFI), NTOK, NFI, DM};
            pg8::StaticOrder S; S.init(NTOK, NFI, G, cg_);
            EpiFfnIn E{(const float*)(ws + WS_SS1), (bf16_t*)(ws + WS_ACT)};
#ifndef DIS_G3
            pg8::gemm_phase<EpiFfnIn, pg8::StaticOrder, true, true>((PG8_LAS unsigned char*)lds, gm, S, E);
#endif
    }
    SEAM(10);
    if (IN(11)) { WSP;
            pg8::Gemm gm{(const bf16_t*)(ws + WS_ACT), (const bf16_t*)(ws + WS_WFO), NTOK, DM, FFH};
            pg8::StaticOrder S; S.init(NTOK, DM, G, cg_);
            EpiFfnOut E{(const bf16_t*)(ws + WS_H1B), (bf16_t*)(ws + WS_MERGED), (float*)(ws + WS_SS2)};
#ifndef DIS_G4
            pg8::gemm_phase<EpiFfnOut, pg8::StaticOrder, true, true>((PG8_LAS unsigned char*)lds, gm, S, E);
#endif
    }
    SEAM(11);
    if (IN(12)) { WSP;
            const float* ss = (const float*)(ws + WS_SS2); const f32x4* wf = (const f32x4*)a.in[15]; f32x4* o4 = (f32x4*)a.out; const u32x2* h2 = (const u32x2*)(ws + WS_MERGED);
            {
                const size_t stride = (size_t)G * 512, total = (size_t)NTOK * 256; size_t idx = (size_t)vcu * 512 + threadIdx.x; const f32x4 wv = wf[idx & 255];
                for (; idx + 3 * stride < total; idx += 4 * stride) { u32x2 hw[4]; float sv[4];
#pragma unroll
                    for (int k = 0; k < 4; ++k) { hw[k] = h2[idx + k * stride]; sv[k] = ss[(idx + k * stride) >> 8]; }
#pragma unroll
                    for (int k = 0; k < 4; ++k) { const float rstd = rsqrtf(sv[k] * (1.f / 1024.f) + EPS); f32x4 h; h[0] = __uint_as_float(hw[k].x << 16); h[1] = __uint_as_float(hw[k].x & 0xffff0000u); h[2] = __uint_as_float(hw[k].y << 16); h[3] = __uint_as_float(hw[k].y & 0xffff0000u);
                        o4[idx + k * stride] = h * rstd * wv; } }
                for (; idx < total; idx += stride) { const float rstd = rsqrtf(ss[idx >> 8] * (1.f / 1024.f) + EPS); const u32x2 hw = h2[idx]; f32x4 h; h[0] = __uint_as_float(hw.x << 16); h[1] = __uint_as_float(hw.x & 0xffff0000u); h[2] = __uint_as_float(hw.y << 16); h[3] = __uint_as_float(hw.y & 0xffff0000u);
                    o4[idx] = h * rstd * wv; } }
    }
#undef IN
#undef SEAM
#undef WSP
}

extern "C" void kernel_launch(void* const* d_in, const int* in_sizes, int n_in, void* d_out, int out_size, void* d_ws, size_t ws_size, hipStream_t stream) {
    static int grid = 0;
    if (grid == 0) {
        if (n_in != 16 || in_sizes[0] != NTOK * DM || out_size != NTOK * DM || ws_size < WS_END) {
            fprintf(stderr, "kernel_launch: shape/workspace mismatch (n_in %d, in0 %d, out %d, ws %zu, need %zu)\n", n_in, n_in > 0 ? in_sizes[0] : -1, out_size, ws_size, (size_t)WS_END); grid = -1; return; }
        int dev = 0, cus = 0, per_cu = 0;
        hipGetDevice(&dev); hipDeviceGetAttribute(&cus, hipDeviceAttributeMultiprocessorCount, dev);
        if (hipFuncSetAttribute((const void*)hybrid_fwd, hipFuncAttributeMaxDynamicSharedMemorySize, LDS_BYTES) != hipSuccess) { fprintf(stderr, "kernel_launch: hipFuncSetAttribute failed\n"); grid = -1; return; }
        if (hipOccupancyMaxActiveBlocksPerMultiprocessor(&per_cu, (const void*)hybrid_fwd, 512, LDS_BYTES) != hipSuccess || per_cu < 1) { fprintf(stderr, "kernel_launch: occupancy query gave %d\n", per_cu); per_cu = 1; }
        (void)hipGetLastError();
        grid = cus * 1;
        if (grid <= 0) grid = 256;
    }
    if (grid < 0) return;
    if (hipMemsetAsync((char*)d_ws + WS_BAR, 0, WS_BAR_BYTES, stream) != hipSuccess) { fprintf(stderr, "kernel_launch: hipMemsetAsync of the barrier words failed\n"); return; }
    KArgs a{};
    for (int i = 0; i < 16; ++i) a.in[i] = (const float*)d_in[i];
    a.out = (float*)d_out; a.ws = (unsigned char*)d_ws;
#if N_LAUNCH_MODE == 1
    a.ph_lo = 0; a.ph_hi = NPHASE;
    { void* args[] = {&a};
      hipError_t e = hipLaunchCooperativeKernel((const void*)hybrid_fwd, dim3(grid), dim3(512), args, LDS_BYTES, stream);
      if (e != hipSuccess) fprintf(stderr, "cooperative launch failed: %s (grid %d)\n", hipGetErrorString(e), grid); }
#else
    for (int ph = 0; ph < NPHASE; ++ph) {
        a.ph_lo = ph; a.ph_hi = ph + 1; void* args[] = {&a};
        hipError_t e = hipLaunchCooperativeKernel((const void*)hybrid_fwd, dim3(grid), dim3(512), args, LDS_BYTES, stream);
        if (e != hipSuccess) { fprintf(stderr, "cooperative launch %d failed: %s (grid %d)\n", ph, hipGetErrorString(e), grid); break; }
    }
#endif
}
```

```cpp
#include <hip/hip_runtime.h>
#include <hip/hip_bf16.h>
#include <hip/hip_cooperative_groups.h>
#include <cstdio>
#include <cstdint>
namespace cg = cooperative_groups;
#ifndef N_LAUNCH_MODE
#define N_LAUNCH_MODE 1
#endif
namespace pg8 {
#define PG8_LAS __attribute__((address_space(3)))
typedef unsigned short bf16_t;
typedef short bf16x8 __attribute__((ext_vector_type(8)));
typedef float f32x4 __attribute__((ext_vector_type(4)));
typedef unsigned u32x4 __attribute__((ext_vector_type(4)));
constexpr int BM = 256, BK = 64, HALF = 128, HTB = HALF * BK * 2  , STAGE_BYTES = 8 * HTB, NXCD = 8, WGM = 8;

__host__ __device__ __forceinline__ int lds_byte(int r, int c) { const int st = (r >> 4) * 2 + (c >> 5), rr = r & 15, cc = c & 31, ob = rr * 64 + cc * 2; return st * 1024 + (ob ^ (((ob >> 9) & 1) << 5)); }
__host__ __device__ __forceinline__ void stage_rc(int b, int& R, int& C) { const int st = b / 1024, sb = b % 1024, swz = sb ^ (((sb >> 9) & 1) << 5); R = (st >> 1) * 16 + swz / 64; C = (st & 1) * 32 + (swz % 64) / 2; }
__host__ __device__ __forceinline__ int perm32(int rho) { const int n = rho >> 4, i = rho & 15; return 8 * (i >> 2) + 4 * n + (i & 3); }

struct Unit { int pm, pn; };
struct Gemm { const bf16_t* A; const bf16_t* Bt; int M, N, K; };

struct StaticOrder {
    int nM, nN, nwg, G, c;
    __host__ __device__ void init(int M, int N, int G_, int c_) { nM = M / BM; nN = N / BM; nwg = nM * nN; G = G_; c = c_; }
    __host__ __device__ bool next(int i, Unit& u) const {
        const long L = (long)i * G + c; if (L >= nwg) return false;
        int wgid = (int)L; { const int q = nwg / NXCD, r = nwg % NXCD, xcd = wgid % NXCD, off = wgid / NXCD; wgid = (xcd < r ? xcd * (q + 1) : r * (q + 1) + (xcd - r) * q) + off; }
        const int nig = WGM * nN, gid = wgid / nig, fm = gid * WGM, gsz = (nM - fm) < WGM ? (nM - fm) : WGM;
        u.pm = fm + ((wgid % nig) % gsz); u.pn = (wgid % nig) / gsz; return true;
    }
    __device__ __forceinline__ void a_ready(const Unit&) const {}
    __device__ __forceinline__ void done(const Unit&) const {}
};

typedef float cvt_f32x2_t __attribute__((ext_vector_type(2))); typedef __bf16 cvt_bf16x2_t __attribute__((ext_vector_type(2)));
__device__ __forceinline__ unsigned cvt_pk_bf16(float lo, float hi) { cvt_f32x2_t v = {lo, hi}; cvt_bf16x2_t b = __builtin_convertvector(v, cvt_bf16x2_t); return __builtin_bit_cast(unsigned, b); }
typedef float f32x2 __attribute__((ext_vector_type(2)));
template <class Epi, class Sched, bool ALIGN_EPI = false, bool SP2 = false>
__device__ __forceinline__ void gemm_phase(PG8_LAS unsigned char* lds, const Gemm g, const Sched& S, const Epi& E) {
    int tid_ = threadIdx.x; asm volatile("" : "+v"(tid_)); const int tid = tid_, wid = __builtin_amdgcn_readfirstlane(tid >> 6), lane = tid & 63, wr = wid >> 2, wc = wid & 3, fr = lane & 15, fq = lane >> 4;
    const int K = g.K, nt = K / BK;
    unsigned voffA[2], voffB[2];
#pragma unroll
    for (int i = 0; i < 2; ++i) { int R, C; stage_rc(tid * 16 + i * 8192, R, C); const int Rb = Epi::PERM ? ((R & ~31) + perm32(R & 31)) : R;
        voffA[i] = (unsigned)(R * K + C) * 2u; voffB[i] = (unsigned)(Rb * K + C) * 2u; }
    const size_t kstep = (size_t)(BK * 2);
    const size_t hstep = (size_t)HALF * K * 2;
    const size_t tstep = 2 * hstep;
    const unsigned ldsw = (unsigned)wid * 1024u;
    const int aoff = lds_byte(wr * 64 + fr, fq * 8), boff = lds_byte(wc * 32 + fr, fq * 8);
#define PG8_SA(b, h) (((b) * 2 + (h)) * HTB)
#define PG8_SB(b, h) ((4 + (b) * 2 + (h)) * HTB)
#define PG8_STAGE(bufoff, gbase, voff) do { _Pragma("unroll") for (int _i = 0; _i < 2; ++_i) \
        __builtin_amdgcn_global_load_lds((const unsigned*)((const char*)(gbase) + (voff)[_i]), (PG8_LAS unsigned*)(lds + (bufoff) + ldsw + _i * 8192), 16, 0, 0); } while (0)
#define PG8_LDA(dst, b, h) do { _Pragma("unroll") for (int m = 0; m < 4; ++m) _Pragma("unroll") for (int k = 0; k < 2; ++k) dst[m][k] = *(const PG8_LAS bf16x8*)(lds + PG8_SA(b, h) + aoff + m * 2048 + k * 1024); } while (0)
#define PG8_LDB(dst, b, h) do { _Pragma("unroll") for (int n = 0; n < 2; ++n) _Pragma("unroll") for (int k = 0; k < 2; ++k) dst[n][k] = *(const PG8_LAS bf16x8*)(lds + PG8_SB(b, h) + boff + n * 2048 + k * 1024); } while (0)
#define PG8_MMA(ai, bj, At, Bt) do { __builtin_amdgcn_s_setprio(1); _Pragma("unroll") for (int m = 0; m < 4; ++m) _Pragma("unroll") for (int n = 0; n < 2; ++n) _Pragma("unroll") for (int k = 0; k < 2; ++k) \
        acc[ai][bj][m][n] = __builtin_amdgcn_mfma_f32_16x16x32_bf16(Bt[n][k], At[m][k], acc[ai][bj][m][n], 0, 0, 0); __builtin_amdgcn_s_setprio(0); } while (0)
#define PG8_WAIT_V(n) asm volatile("s_waitcnt vmcnt(" #n ")" ::: "memory")
#define PG8_WAIT_L(n) asm volatile("s_waitcnt lgkmcnt(" #n ")" ::: "memory")
#define PG8_BAR __builtin_amdgcn_s_barrier()
#define PG8_SCHED __builtin_amdgcn_sched_barrier(0)
    Unit cur, nxt; int ui = 0;
    if (!S.next(0, cur)) return;
    f32x4 acc[2][2][4][2];
#pragma unroll
    for (int a = 0; a < 2; ++a)
#pragma unroll
        for (int b = 0; b < 2; ++b)
#pragma unroll
            for (int m = 0; m < 4; ++m)
#pragma unroll
                for (int n = 0; n < 2; ++n) acc[a][b][m][n] = (f32x4){0.f, 0.f, 0.f, 0.f};
    bf16x8 At[4][2], B0[2][2], B1[2][2];
    const char* cA = (const char*)g.A + (size_t)cur.pm * tstep; const char* cB = (const char*)g.Bt + (size_t)cur.pn * tstep;
    S.a_ready(cur);
    if constexpr (SP2) {
        PG8_STAGE(PG8_SB(0, 0), cB, voffB); PG8_STAGE(PG8_SB(0, 1), cB + hstep, voffB); PG8_STAGE(PG8_SA(0, 0), cA, voffA); PG8_STAGE(PG8_SA(0, 1), cA + hstep, voffA);
        if (wr == 1) PG8_BAR;
        PG8_WAIT_V(2); PG8_BAR;
        PG8_STAGE(PG8_SB(1, 0), cB + kstep, voffB); PG8_STAGE(PG8_SA(1, 0), cA + kstep, voffA); PG8_STAGE(PG8_SB(1, 1), cB + hstep + kstep, voffB);
        PG8_WAIT_V(6); PG8_BAR;
    } else {
        PG8_STAGE(PG8_SB(0, 0), cB, voffB); PG8_STAGE(PG8_SA(0, 0), cA, voffA); PG8_STAGE(PG8_SB(0, 1), cB + hstep, voffB); PG8_STAGE(PG8_SA(0, 1), cA + hstep, voffA);
        if (wr == 1) PG8_BAR;
        PG8_WAIT_V(4); PG8_BAR;
        PG8_STAGE(PG8_SB(1, 0), cB + kstep, voffB); PG8_STAGE(PG8_SA(1, 0), cA + kstep, voffA); PG8_STAGE(PG8_SB(1, 1), cB + hstep + kstep, voffB);
        PG8_WAIT_V(6); PG8_BAR;
    }
    for (;;) {
        const bool has_next = S.next(ui + 1, nxt);
        const char* nA = has_next ? (const char*)g.A + (size_t)nxt.pm * tstep : cA; const char* nB = has_next ? (const char*)g.Bt + (size_t)nxt.pn * tstep : cB;
        for (int t = 0; t < nt; t += 2) {
            const bool last = (t == nt - 2);
            const char* a1 = cA + (size_t)(t + 1) * kstep;
            const char* a2 = last ? nA : cA + (size_t)(t + 2) * kstep; const char* b2 = last ? nB : cB + (size_t)(t + 2) * kstep;
            const char* a3 = a2 + kstep; const char* b3 = b2 + kstep;
            if (last && has_next) S.a_ready(nxt);
            if constexpr (SP2) {
            PG8_LDB(B0, 0, 0); PG8_LDB(B1, 0, 1); PG8_SCHED; PG8_LDA(At, 0, 0); PG8_STAGE(PG8_SA(1, 1), a1 + hstep, voffA);
            PG8_WAIT_V(8); PG8_WAIT_L(0); PG8_BAR; PG8_MMA(0, 0, At, B0); PG8_MMA(0, 1, At, B1); PG8_BAR; PG8_SCHED;
            PG8_LDA(At, 0, 1); PG8_STAGE(PG8_SB(0, 0), b2, voffB); PG8_STAGE(PG8_SB(0, 1), b2 + hstep, voffB); PG8_STAGE(PG8_SA(0, 0), a2, voffA);
            PG8_WAIT_V(8); PG8_WAIT_L(0); PG8_BAR; PG8_MMA(1, 0, At, B0); PG8_MMA(1, 1, At, B1); PG8_BAR; PG8_SCHED;
            PG8_LDB(B0, 1, 0); PG8_LDB(B1, 1, 1); PG8_SCHED; PG8_LDA(At, 1, 0); PG8_STAGE(PG8_SA(0, 1), a2 + hstep, voffA);
            PG8_WAIT_V(8); PG8_WAIT_L(0); PG8_BAR; PG8_MMA(0, 0, At, B0); PG8_MMA(0, 1, At, B1); PG8_BAR; PG8_SCHED;
            PG8_LDA(At, 1, 1); PG8_STAGE(PG8_SB(1, 0), b3, voffB); PG8_STAGE(PG8_SB(1, 1), b3 + hstep, voffB); PG8_STAGE(PG8_SA(1, 0), a3, voffA);
            PG8_WAIT_V(8); PG8_WAIT_L(0); PG8_BAR; PG8_MMA(1, 0, At, B0); PG8_MMA(1, 1, At, B1); PG8_BAR; PG8_SCHED;
            } else {
            PG8_LDB(B0, 0, 0); PG8_SCHED; PG8_LDA(At, 0, 0); PG8_STAGE(PG8_SA(1, 1), a1 + hstep, voffA);
            PG8_WAIT_L(8); PG8_BAR; PG8_WAIT_L(0); PG8_MMA(0, 0, At, B0); PG8_BAR; PG8_SCHED;
            PG8_LDB(B1, 0, 1); PG8_STAGE(PG8_SB(0, 0), b2, voffB);
            PG8_BAR; PG8_WAIT_L(0); PG8_MMA(0, 1, At, B1); PG8_BAR;
            PG8_LDA(At, 0, 1); PG8_STAGE(PG8_SA(0, 0), a2, voffA);
            PG8_BAR; PG8_WAIT_L(0); PG8_MMA(1, 0, At, B0); PG8_BAR; PG8_SCHED;
            PG8_STAGE(PG8_SB(0, 1), b2 + hstep, voffB);
            PG8_WAIT_V(6); PG8_BAR; PG8_MMA(1, 1, At, B1); PG8_BAR;
            PG8_LDB(B0, 1, 0); PG8_SCHED; PG8_LDA(At, 1, 0); PG8_STAGE(PG8_SA(0, 1), a2 + hstep, voffA);
            PG8_WAIT_L(8); PG8_BAR; PG8_WAIT_L(0); PG8_MMA(0, 0, At, B0); PG8_BAR; PG8_SCHED;
            PG8_LDB(B1, 1, 1); PG8_STAGE(PG8_SB(1, 0), b3, voffB);
            PG8_BAR; PG8_WAIT_L(0); PG8_MMA(0, 1, At, B1); PG8_BAR;
            PG8_LDA(At, 1, 1); PG8_STAGE(PG8_SA(1, 0), a3, voffA);
            PG8_BAR; PG8_WAIT_L(0); PG8_MMA(1, 0, At, B0); PG8_BAR; PG8_SCHED;
            PG8_STAGE(PG8_SB(1, 1), b3 + hstep, voffB);
            PG8_WAIT_V(6); PG8_BAR; PG8_MMA(1, 1, At, B1); PG8_BAR;
            }
        }
        if constexpr (ALIGN_EPI) { if (wr == 0) PG8_BAR; }
        if constexpr (!Epi::AFTER_DRAIN) { E(acc, cur, wr, wc, fr, fq); S.done(cur); }
        if (!has_next) break;
#pragma unroll
        for (int a = 0; a < 2; ++a)
#pragma unroll
            for (int b = 0; b < 2; ++b)
#pragma unroll
                for (int m = 0; m < 4; ++m)
#pragma unroll
                    for (int n = 0; n < 2; ++n) acc[a][b][m][n] = (f32x4){0.f, 0.f, 0.f, 0.f};
        cur = nxt; cA = nA; cB = nB; ++ui;
        if constexpr (ALIGN_EPI) { if (wr == 1) PG8_BAR; }
    }
    PG8_WAIT_V(0);
    if constexpr (!ALIGN_EPI) { if (wr == 0) PG8_BAR; }
    PG8_BAR;
    if constexpr (Epi::AFTER_DRAIN) { E.fused(acc, cur, wr, wc, fr, fq, lds, wid, lane); S.done(cur); }
#undef PG8_SA
#undef PG8_SB
#undef PG8_STAGE
#undef PG8_LDA
#undef PG8_LDB
#undef PG8_MMA
#undef PG8_WAIT_V
#undef PG8_WAIT_L
#undef PG8_BAR
#undef PG8_SCHED
}
}
namespace att {
using bf16 = __hip_bfloat16;
constexpr int   D = 128, NW = 8, QBLK = 32, KVBLK = 64;
constexpr float SCALE = 0.088388347648318440f;
constexpr float THR = 8.f;
constexpr int SDEPTH = 2;
constexpr int LDQ = 1024, LDK = 1024, LDO = 1024;
constexpr size_t SHM_V = KVBLK * D * 2, SHM_K = KVBLK * D * 2, SHM_ATTN = 2 * SHM_V + 2 * SHM_K + NW * 64 * 4;
__device__ __forceinline__ unsigned short f2bf_rne(float f) { unsigned u = __float_as_uint(f); return (unsigned short)((u + 0x7fffu + ((u >> 16) & 1u)) >> 16); }
using bf16x8 = __attribute__((ext_vector_type(8))) short;
using s16x4  = __attribute__((ext_vector_type(4))) short;
using f32x16 = __attribute__((ext_vector_type(16))) float;
using f32x8  = __attribute__((ext_vector_type(8))) float;
using u32x4  = __attribute__((ext_vector_type(4))) unsigned;
#define KSWZ(row, colB) ((row) * 256 + ((colB) ^ (((row) & 7) << 4)))
#define SBAR() __builtin_amdgcn_sched_barrier(0)
__device__ __forceinline__ int crow(int r, int hi) { return (r & 3) + 8 * (r >> 2) + 4 * hi; }
__device__ __forceinline__ unsigned cvtpk(float lo, float hi) {
  unsigned r; asm volatile("v_cvt_pk_bf16_f32 %0, %1, %2" : "=v"(r) : "v"(lo), "v"(hi)); return r;
}
template <typename TIn> struct Stage;
template <> struct Stage<bf16>  { using T = bf16x8;
  __device__ static __forceinline__ T ld8(const bf16* p) { return *reinterpret_cast<const bf16x8*>(p); }
  __device__ static __forceinline__ bf16x8 tobf(T x) { return x; } };
template <> struct Stage<float> { using T = f32x8;
  __device__ static __forceinline__ T ld8(const float* p) { return *reinterpret_cast<const f32x8*>(p); }
  __device__ static __forceinline__ bf16x8 tobf(T x) {
    u32x4 w = {cvtpk(x[0], x[1]), cvtpk(x[2], x[3]), cvtpk(x[4], x[5]), cvtpk(x[6], x[7])}; return *reinterpret_cast<bf16x8*>(&w); } };

__device__ __forceinline__ void partialSM(f32x16& p0, f32x16& p1, float& m_reg, float& mn, float& alpha) {
  constexpr float C = SCALE * 1.4426950408889634f;
  float pmax = p0[0]; _Pragma("unroll") for (int r = 1; r < 16; ++r) pmax = fmaxf(pmax, p0[r]); _Pragma("unroll") for (int r = 0; r < 16; ++r) pmax = fmaxf(pmax, p1[r]);
  { auto rr = __builtin_amdgcn_permlane32_swap(__float_as_uint(pmax), __float_as_uint(pmax), false, false);
    pmax = fmaxf(__uint_as_float(rr[0]), __uint_as_float(rr[1])); }
  if (__builtin_expect(__all(pmax - m_reg <= THR / SCALE), 1)) { mn = m_reg; alpha = 1.f; }
  else { mn = fmaxf(m_reg, pmax); alpha = __builtin_amdgcn_exp2f((m_reg - mn) * C); m_reg = mn; }
  float mnC = -mn * C;
  _Pragma("unroll") for (int r = 0; r < 16; ++r) p0[r] = fmaf(p0[r], C, mnC); _Pragma("unroll") for (int r = 0; r < 16; ++r) p1[r] = fmaf(p1[r], C, mnC);
  _Pragma("unroll") for (int r = 0; r < 16; ++r) p0[r] = __builtin_amdgcn_exp2f(p0[r]);
}
__device__ __forceinline__ void finishSM(f32x16& p0, f32x16& p1, float alpha, float& l_reg, bf16x8& pa0, bf16x8& pa1, bf16x8& pa2, bf16x8& pa3) {
  _Pragma("unroll") for (int r = 0; r < 16; ++r) p1[r] = __builtin_amdgcn_exp2f(p1[r]);
  float ps = 0; _Pragma("unroll") for (int r = 0; r < 16; ++r) ps += p0[r]; _Pragma("unroll") for (int r = 0; r < 16; ++r) ps += p1[r];
  { auto rr = __builtin_amdgcn_permlane32_swap(__float_as_uint(ps), __float_as_uint(ps), false, false);
    ps = __uint_as_float(rr[0]) + __uint_as_float(rr[1]); }
  l_reg = l_reg * alpha + ps;
#define PK4(P, BASE, OUT) do { unsigned a0 = cvtpk(P[BASE + 0], P[BASE + 1]), a1 = cvtpk(P[BASE + 2], P[BASE + 3]);   \
    unsigned b0 = cvtpk(P[BASE + 4], P[BASE + 5]), b1 = cvtpk(P[BASE + 6], P[BASE + 7]);                              \
    auto r0 = __builtin_amdgcn_permlane32_swap(a0, b0, false, false); auto r1 = __builtin_amdgcn_permlane32_swap(a1, b1, false, false); \
    u32x4 w = {r0[0], r1[0], r0[1], r1[1]}; OUT = *reinterpret_cast<bf16x8*>(&w); } while (0)
  PK4(p0, 0, pa0); PK4(p0, 8, pa1); PK4(p1, 0, pa2); PK4(p1, 8, pa3);
#undef PK4
}
__device__ __forceinline__ void qkt(f32x16& p0, f32x16& p1, const bf16* Ks, const bf16x8* qr, int r32, int hi) {
  p0 = f32x16{}; p1 = f32x16{};
  _Pragma("unroll") for (int d0 = 0; d0 < 8; ++d0) { int cb = (d0 * 16 + hi * 8) * 2;
    bf16x8 b0 = *reinterpret_cast<const bf16x8*>((const char*)Ks + KSWZ(r32, cb));
    bf16x8 b1 = *reinterpret_cast<const bf16x8*>((const char*)Ks + KSWZ(32 + r32, cb));
    p0 = __builtin_amdgcn_mfma_f32_32x32x16_bf16(b0, qr[d0], p0, 0, 0, 0);
    p1 = __builtin_amdgcn_mfma_f32_32x32x16_bf16(b1, qr[d0], p1, 0, 0, 0); }
}
__device__ __forceinline__ int v_st(int k, int c) { const int kk = (k & ~0xC) | ((k & 4) << 1) | ((k & 8) >> 1); return ((kk >> 3) * 4 + (c >> 5)) * 512 + ((kk & 7) * 32 + (c & 31)) * 2; }
__device__ __forceinline__ int v_rd_base(int lane) { return ((lane & 3) << 3) | (((lane >> 2) & 3) << 6) | (((lane >> 4) & 1) << 5) | (((lane >> 5) & 1) << 8); }
constexpr int v_rd_off(int d0, int ks, int half) { return d0 * 512 + ks * 4096 + half * 2048; }
template <int OFF> __device__ __forceinline__ s16x4 tr_read(int vb) {
  s16x4 r; asm volatile("ds_read_b64_tr_b16 %0, %1 offset:%2" : "=&v"(r) : "v"(vb), "i"(OFF) : "memory"); return r;
}
template <int D0> __device__ __forceinline__ void pv_one(f32x16& od, int vb, bf16x8 pa0, bf16x8 pa1, bf16x8 pa2, bf16x8 pa3) {
  const s16x4 l0 = tr_read<v_rd_off(D0, 0, 0)>(vb), h0 = tr_read<v_rd_off(D0, 0, 1)>(vb), l1 = tr_read<v_rd_off(D0, 1, 0)>(vb), h1 = tr_read<v_rd_off(D0, 1, 1)>(vb);
  const s16x4 l2 = tr_read<v_rd_off(D0, 2, 0)>(vb), h2 = tr_read<v_rd_off(D0, 2, 1)>(vb), l3 = tr_read<v_rd_off(D0, 3, 0)>(vb), h3 = tr_read<v_rd_off(D0, 3, 1)>(vb);
  asm volatile("s_waitcnt lgkmcnt(0)" ::: "memory"); SBAR();
#define PK(L, H) (bf16x8){L[0], L[1], L[2], L[3], H[0], H[1], H[2], H[3]}
  od = __builtin_amdgcn_mfma_f32_32x32x16_bf16(pa0, PK(l0, h0), od, 0, 0, 0);
  od = __builtin_amdgcn_mfma_f32_32x32x16_bf16(pa1, PK(l1, h1), od, 0, 0, 0);
  od = __builtin_amdgcn_mfma_f32_32x32x16_bf16(pa2, PK(l2, h2), od, 0, 0, 0);
  od = __builtin_amdgcn_mfma_f32_32x32x16_bf16(pa3, PK(l3, h3), od, 0, 0, 0);
#undef PK
}
__device__ __forceinline__ void pv_d0(f32x16* o, int vb, bf16x8 pa0, bf16x8 pa1, bf16x8 pa2, bf16x8 pa3) {
  pv_one<0>(o[0], vb, pa0, pa1, pa2, pa3); pv_one<1>(o[1], vb, pa0, pa1, pa2, pa3); pv_one<2>(o[2], vb, pa0, pa1, pa2, pa3); pv_one<3>(o[3], vb, pa0, pa1, pa2, pa3);
}
__device__ __forceinline__ void attn_dense_body(const bf16* __restrict__ Qb, const bf16* __restrict__ Kh, const bf16* __restrict__ Vh,
                                                float* O1b, unsigned short* O2b, const int pass, const float lam, int seq, char* lds) {
  using St = Stage<bf16>; using SQ = Stage<bf16>;
  int tid_ = threadIdx.x; asm volatile("" : "+v"(tid_));
  const int tid = tid_, wid = tid >> 6, lane = tid & 63, r32 = lane & 31, hi = lane >> 5;
  bf16* V_lds = (bf16*)lds; bf16* K_lds = (bf16*)(lds + 2 * SHM_V);
  float* ws = (float*)(lds + 2 * SHM_V + 2 * SHM_K) + wid * 64; float* li_l = ws; float* al_l = ws + 32;
  float m_reg = -1e30f, l_reg = 0; f32x16 o[4] = {}; bf16x8 qr[8];
  const bf16* Qw = Qb + (long)(wid * QBLK + r32) * LDQ + hi * 8;
  _Pragma("unroll") for (int d0 = 0; d0 < 8; ++d0) qr[d0] = SQ::tobf(SQ::ld8(Qw + d0 * 16));
  const int sr = tid >> 4, sc = (tid & 15) * 8, vst0 = v_st(sr, sc), vst1 = v_st(32 + sr, sc);
  const int vb0 = (int)(uintptr_t)V_lds + v_rd_base(lane);
  struct { typename St::T vs0, vs1, ks0, ks1; } sr_[SDEPTH];
#define SLOAD(i, k0) do { sr_[i].vs0 = St::ld8(&Vh[(long)((k0) + sr) * LDK + sc]); sr_[i].vs1 = St::ld8(&Vh[(long)((k0) + 32 + sr) * LDK + sc]); \
    sr_[i].ks0 = St::ld8(&Kh[(long)((k0) + sr) * LDK + sc]); sr_[i].ks1 = St::ld8(&Kh[(long)((k0) + 32 + sr) * LDK + sc]); } while (0)
#define SWRITE(b, i) do { *(bf16x8*)((char*)V_lds + (b) * SHM_V + vst0) = St::tobf(sr_[i].vs0);          \
    *(bf16x8*)((char*)V_lds + (b) * SHM_V + vst1) = St::tobf(sr_[i].vs1); int kc = sc * 2;               \
    *(bf16x8*)((char*)K_lds + (b) * SHM_K + KSWZ(sr, kc)) = St::tobf(sr_[i].ks0);                       \
    *(bf16x8*)((char*)K_lds + (b) * SHM_K + KSWZ(32 + sr, kc)) = St::tobf(sr_[i].ks1); } while (0)
#define SWAIT() do { if constexpr (SDEPTH == 2) asm volatile("s_waitcnt vmcnt(4)" ::: "memory"); else asm volatile("s_waitcnt vmcnt(0)" ::: "memory"); } while (0)
#define RESC(a) do { if (__any((a) < 1.f)) { if (hi == 0) al_l[r32] = (a); asm volatile("s_waitcnt lgkmcnt(0)" ::: "memory"); \
    _Pragma("unroll") for (int d = 0; d < 4; ++d) _Pragma("unroll") for (int r = 0; r < 16; ++r) o[d][r] *= al_l[crow(r, hi)]; } } while (0)
  f32x16 pA0, pA1, pB0, pB1; float mnA, mnB, alA, alB; bf16x8 pa0, pa1, pa2, pa3; const int NT = seq / KVBLK;
  constexpr int SE = 0, SO = SDEPTH - 1;
  SLOAD(SE, 0); asm volatile("s_waitcnt vmcnt(0)" ::: "memory"); SWRITE(0, SE); __syncthreads();
  qkt(pA0, pA1, K_lds, qr, r32, hi); partialSM(pA0, pA1, m_reg, mnA, alA);
  SLOAD(SO, KVBLK); if constexpr (SDEPTH == 2) { if (2 < NT) SLOAD(SE, 2 * KVBLK); }
  SWAIT(); SWRITE(1, SO); __syncthreads();
  for (int j = 1; j + 1 < NT; j += 2) {
    SBAR(); qkt(pB0, pB1, (bf16*)((char*)K_lds + SHM_K), qr, r32, hi);
    finishSM(pA0, pA1, alA, l_reg, pa0, pa1, pa2, pa3); SBAR();
    SLOAD(SO, (j + SDEPTH) * KVBLK); SBAR();
    pv_d0(o, vb0, pa0, pa1, pa2, pa3); partialSM(pB0, pB1, m_reg, mnB, alB);
    __syncthreads(); SWAIT(); SWRITE(0, SE);
    RESC(alB); __syncthreads();
    SBAR(); qkt(pA0, pA1, K_lds, qr, r32, hi);
    finishSM(pB0, pB1, alB, l_reg, pa0, pa1, pa2, pa3); SBAR();
    if (SDEPTH == 1 || j + 3 < NT) SLOAD(SE, (j + 1 + SDEPTH) * KVBLK); SBAR();
    pv_d0(o, vb0 + (int)SHM_V, pa0, pa1, pa2, pa3); partialSM(pA0, pA1, m_reg, mnA, alA);
    __syncthreads(); SWAIT(); SWRITE(1, SO);
    RESC(alA); __syncthreads();
  }
  SBAR(); qkt(pB0, pB1, (bf16*)((char*)K_lds + SHM_K), qr, r32, hi);
  finishSM(pA0, pA1, alA, l_reg, pa0, pa1, pa2, pa3); SBAR();
  pv_d0(o, vb0, pa0, pa1, pa2, pa3); partialSM(pB0, pB1, m_reg, mnB, alB);
  __syncthreads(); RESC(alB);
  finishSM(pB0, pB1, alB, l_reg, pa0, pa1, pa2, pa3); SBAR();
  pv_d0(o, vb0 + (int)SHM_V, pa0, pa1, pa2, pa3);
  if (hi == 0) li_l[r32] = l_reg; asm volatile("s_waitcnt lgkmcnt(0)" ::: "memory");
  float rli[16];
  _Pragma("unroll") for (int r = 0; r < 16; ++r) rli[r] = __builtin_amdgcn_rcpf(li_l[crow(r, hi)]);
  float* Ow = O1b + (long)(wid * QBLK) * LDO; unsigned short* Cw = O2b + (long)(wid * QBLK) * LDO;
  _Pragma("unroll") for (int r = 0; r < 16; ++r) { int orow = crow(r, hi);
    _Pragma("unroll") for (int d0 = 0; d0 < 4; ++d0) { const long idx = (long)orow * LDO + d0 * 32 + r32; const float val = o[d0][r] * rli[r];
      if (pass == 0) Ow[idx] = val; else Cw[idx] = f2bf_rne(Ow[idx] - lam * val); } }
#undef SLOAD
#undef SWRITE
#undef SWAIT
#undef RESC
}
}
namespace att2 {
using namespace att;
constexpr int KBUF = 16384, VBUF = 32768, L_K = 0, L_V = 3 * KBUF, L_WS = 3 * KBUF + 3 * VBUF;
__device__ __forceinline__ void glds16(const void* gsrc, unsigned lds_dst) { unsigned keep;
  asm volatile("s_mov_b32 %0, m0\n\ts_mov_b32 m0, %2\n\ts_nop 0\n\tglobal_load_lds_dwordx4 %1, off\n\ts_mov_b32 m0, %0" : "=&s"(keep) : "v"(gsrc), "s"(lds_dst) : "memory"); }
constexpr int v_rd_off8(int d0, int ks, int half) { return d0 * 512 + ks * 8192 + half * 4096; }
template <int D0> __device__ __forceinline__ void pv_one8(f32x16& od, int vb, bf16x8 pa0, bf16x8 pa1, bf16x8 pa2, bf16x8 pa3) {
  const s16x4 l0 = tr_read<v_rd_off8(D0, 0, 0)>(vb), h0 = tr_read<v_rd_off8(D0, 0, 1)>(vb), l1 = tr_read<v_rd_off8(D0, 1, 0)>(vb), h1 = tr_read<v_rd_off8(D0, 1, 1)>(vb);
  const s16x4 l2 = tr_read<v_rd_off8(D0, 2, 0)>(vb), h2 = tr_read<v_rd_off8(D0, 2, 1)>(vb), l3 = tr_read<v_rd_off8(D0, 3, 0)>(vb), h3 = tr_read<v_rd_off8(D0, 3, 1)>(vb);
  asm volatile("s_waitcnt lgkmcnt(0)" ::: "memory"); SBAR();
#define PK(L, H) (bf16x8){L[0], L[1], L[2], L[3], H[0], H[1], H[2], H[3]}
  od = __builtin_amdgcn_mfma_f32_32x32x16_bf16(pa0, PK(l0, h0), od, 0, 0, 0);
  od = __builtin_amdgcn_mfma_f32_32x32x16_bf16(pa1, PK(l1, h1), od, 0, 0, 0);
  od = __builtin_amdgcn_mfma_f32_32x32x16_bf16(pa2, PK(l2, h2), od, 0, 0, 0);
  od = __builtin_amdgcn_mfma_f32_32x32x16_bf16(pa3, PK(l3, h3), od, 0, 0, 0);
#undef PK
}
__device__ __forceinline__ void attn256_body(const bf16* __restrict__ Qb, const bf16* __restrict__ Kh, const bf16* __restrict__ Vh, float* O1b, unsigned short* O2b,
                                             const int pass, const float lam, int seq, char* lds) {
  int tid_ = threadIdx.x; asm volatile("" : "+v"(tid_));
  const int tid = tid_, lane = tid & 63, r32 = lane & 31, hi = lane >> 5; const int wid = __builtin_amdgcn_readfirstlane(tid >> 6);
  const unsigned lds0 = (unsigned)(uintptr_t)lds;
  float* ws = (float*)(lds + L_WS) + wid * 64; float* li_l = ws; float* al_l = ws + 32;
  float m_reg = -1e30f, l_reg = 0; f32x16 o[8] = {}; bf16x8 qr[8];
  const bf16* Qw = Qb + (long)(wid * QBLK + r32) * LDQ + hi * 8;
  _Pragma("unroll") for (int d0 = 0; d0 < 8; ++d0) qr[d0] = *reinterpret_cast<const bf16x8*>(Qw + d0 * 16);
  long ksrc[2], vsrc[4];
  _Pragma("unroll") for (int p = 0; p < 2; ++p) { const int q = wid * 2 + p, row = 4 * q + (lane >> 4), c = (lane & 15) ^ (row & 7); ksrc[p] = (long)row * LDK + c * 8; }
  _Pragma("unroll") for (int p = 0; p < 4; ++p) { const int q = wid * 4 + p, s = 2 * q + (lane >> 5), kgrp = s >> 3, cb = s & 7, rowin = (lane & 31) >> 2, chunk = lane & 3;
    const int kk = kgrp * 8 + rowin, key = (kk & ~0xC) | ((kk & 4) << 1) | ((kk & 8) >> 1); vsrc[p] = (long)key * LDK + cb * 32 + chunk * 8; }
#define DMA_TILE(t, kb, vo) do { const bf16* kt_ = Kh + (long)(t) * KVBLK * LDK; const bf16* vt_ = Vh + (long)(t) * KVBLK * LDK; \
    _Pragma("unroll") for (int p = 0; p < 2; ++p) glds16(kt_ + ksrc[p], (unsigned)__builtin_amdgcn_readfirstlane(lds0 + L_K + (kb) * KBUF + (wid * 2 + p) * 1024)); \
    _Pragma("unroll") for (int p = 0; p < 4; ++p) glds16(vt_ + vsrc[p], (unsigned)__builtin_amdgcn_readfirstlane(lds0 + L_V + (vo) + (wid * 4 + p) * 1024)); } while (0)
#define PV_RD(S, D0) do { S##l0 = tr_read<v_rd_off8(D0, 0, 0)>(vb); S##h0 = tr_read<v_rd_off8(D0, 0, 1)>(vb); S##l1 = tr_read<v_rd_off8(D0, 1, 0)>(vb); S##h1 = tr_read<v_rd_off8(D0, 1, 1)>(vb); \
    S##l2 = tr_read<v_rd_off8(D0, 2, 0)>(vb); S##h2 = tr_read<v_rd_off8(D0, 2, 1)>(vb); S##l3 = tr_read<v_rd_off8(D0, 3, 0)>(vb); S##h3 = tr_read<v_rd_off8(D0, 3, 1)>(vb); } while (0)
#define PV_PK(L, H) (bf16x8){L[0], L[1], L[2], L[3], H[0], H[1], H[2], H[3]}
#define PV_MM(S, D0) do { o[D0] = __builtin_amdgcn_mfma_f32_32x32x16_bf16(pa0, PV_PK(S##l0, S##h0), o[D0], 0, 0, 0); o[D0] = __builtin_amdgcn_mfma_f32_32x32x16_bf16(pa1, PV_PK(S##l1, S##h1), o[D0], 0, 0, 0); \
    o[D0] = __builtin_amdgcn_mfma_f32_32x32x16_bf16(pa2, PV_PK(S##l2, S##h2), o[D0], 0, 0, 0); o[D0] = __builtin_amdgcn_mfma_f32_32x32x16_bf16(pa3, PV_PK(S##l3, S##h3), o[D0], 0, 0, 0); } while (0)
#define PV_W8() do { asm volatile("s_waitcnt lgkmcnt(8)" ::: "memory"); SBAR(); } while (0)
#define PV_W0() do { asm volatile("s_waitcnt lgkmcnt(0)" ::: "memory"); SBAR(); } while (0)
#define PV8(vb_) do { const int vb = (vb_); s16x4 Al0, Ah0, Al1, Ah1, Al2, Ah2, Al3, Ah3, Bl0, Bh0, Bl1, Bh1, Bl2, Bh2, Bl3, Bh3; \
    PV_RD(A, 0); PV_RD(B, 1); PV_W8(); PV_MM(A, 0); SBAR(); PV_RD(A, 2); PV_W8(); PV_MM(B, 1); SBAR(); PV_RD(B, 3); PV_W8(); PV_MM(A, 2); SBAR(); PV_RD(A, 4); PV_W8(); PV_MM(B, 3); SBAR(); \
    PV_RD(B, 5); PV_W8(); PV_MM(A, 4); SBAR(); PV_RD(A, 6); PV_W8(); PV_MM(B, 5); SBAR(); PV_RD(B, 7); PV_W8(); PV_MM(A, 6); SBAR(); PV_W0(); PV_MM(B, 7); } while (0)
  const int vb0 = (int)lds0 + L_V + v_rd_base(lane);
  const int NT = seq / KVBLK;
  bf16x8 pa0, pa1, pa2, pa3;
  DMA_TILE(0, 0, 0); if (NT > 1) DMA_TILE(1, 1, VBUF);
  int scur = 0, snext2 = 2;
  for (int j = 0; j < NT; ++j) {
    if (j + 1 < NT) asm volatile("s_waitcnt vmcnt(6) lgkmcnt(0)\n\ts_barrier" ::: "memory");
    else            asm volatile("s_waitcnt vmcnt(0) lgkmcnt(0)\n\ts_barrier" ::: "memory");
    if (j + 2 < NT) DMA_TILE(j + 2, snext2, snext2 * VBUF);
    f32x16 p0, p1; float mn, alpha;
    qkt(p0, p1, (const bf16*)(lds + L_K + scur * KBUF), qr, r32, hi);
    partialSM(p0, p1, m_reg, mn, alpha);
    if (__any(alpha < 1.f)) { if (hi == 0) al_l[r32] = alpha; asm volatile("s_waitcnt lgkmcnt(0)" ::: "memory");
      _Pragma("unroll") for (int d = 0; d < 8; ++d) _Pragma("unroll") for (int r = 0; r < 16; ++r) o[d][r] *= al_l[crow(r, hi)]; }
    finishSM(p0, p1, alpha, l_reg, pa0, pa1, pa2, pa3); SBAR();
    PV8(vb0 + scur * VBUF);
    scur = (scur == 2) ? 0 : scur + 1; snext2 = (snext2 == 2) ? 0 : snext2 + 1;
  }
#undef PV8
#undef PV_RD
#undef PV_PK
#undef PV_MM
#undef PV_W8
#undef PV_W0
#undef DMA_TILE
  if (hi == 0) li_l[r32] = l_reg; asm volatile("s_waitcnt lgkmcnt(0)" ::: "memory");
  float rli[16];
  _Pragma("unroll") for (int r = 0; r < 16; ++r) rli[r] = __builtin_amdgcn_rcpf(li_l[crow(r, hi)]);
  float* Ow = O1b + (long)(wid * QBLK) * LDO; unsigned short* Cw = O2b + (long)(wid * QBLK) * LDO;
  if (pass == 0) {
    _Pragma("unroll") for (int r = 0; r < 16; ++r) { const int orow = crow(r, hi);
      _Pragma("unroll") for (int d0 = 0; d0 < 8; ++d0) Ow[(long)orow * LDO + d0 * 32 + r32] = o[d0][r] * rli[r]; }
  } else {
    _Pragma("unroll") for (int r = 0; r < 16; r += 4) { float o1[4][8];
      _Pragma("unroll") for (int k = 0; k < 4; ++k) _Pragma("unroll") for (int d0 = 0; d0 < 8; ++d0) o1[k][d0] = Ow[(long)crow(r + k, hi) * LDO + d0 * 32 + r32];
      _Pragma("unroll") for (int k = 0; k < 4; ++k) _Pragma("unroll") for (int d0 = 0; d0 < 8; ++d0) Cw[(long)crow(r + k, hi) * LDO + d0 * 32 + r32] = f2bf_rne(o1[k][d0] - lam * (o[d0][r + k] * rli[r + k])); }
  }
  asm volatile("s_waitcnt lgkmcnt(0)\n\ts_barrier" ::: "memory");
}
}
typedef unsigned short bf16_t;
typedef float f32x4 __attribute__((ext_vector_type(4)));
typedef unsigned u32x4 __attribute__((ext_vector_type(4)));
typedef unsigned u32x2 __attribute__((ext_vector_type(2)));
constexpr int DM = 1024, SEQ = 4096, NBATCH = 16, NTOK = NBATCH * SEQ;
constexpr int NGRP = 2, GB = NBATCH / NGRP, TG = GB * SEQ;
constexpr int INW = 8224, NIN = 8448;
constexpr int FFH = 2816, NFI = 2 * FFH;
constexpr float EPS = 1e-6f, SUBLN_EPS = 1e-5f, LAMBDA_INIT = 0.2f;
constexpr size_t MiB = 1u << 20;
constexpr size_t WS_CTL = 0;
constexpr size_t WS_SS1 = 4096, WS_SS2 = 4096 + 262144;
constexpr size_t WS_BAR = 768 * 1024, WS_BAR_BYTES = 16384;
constexpr size_t WS_ROPE = 1 * MiB;
constexpr size_t WS_WIN = 4 * MiB;
constexpr size_t WS_WOUT = 21 * MiB;
constexpr size_t WS_WFI = 23 * MiB;
constexpr size_t WS_WFO = 34 * MiB;
constexpr size_t WS_MERGED = 40 * MiB;
constexpr size_t WS_U = 168 * MiB;
constexpr size_t WS_GQ = 296 * MiB, WS_GK = 328 * MiB, WS_GV = 360 * MiB, WS_GR = 424 * MiB, WS_DQ = 488 * MiB, WS_DK = 552 * MiB, WS_DV = 616 * MiB,
                 WS_GA = 680 * MiB, WS_GB = 744 * MiB, WS_GLR = 808 * MiB;
constexpr size_t WS_OF = 812 * MiB, WS_OB = 876 * MiB, WS_O2C = 940 * MiB, WS_DEC = 1004 * MiB, WS_END = 1006 * MiB;
constexpr size_t OUT_QT = 128 * MiB, OUT_KST = 192 * MiB;
constexpr size_t WS_H1B = 296 * MiB, WS_ACT = 424 * MiB;
static_assert(WS_ACT + (size_t)NTOK * FFH * 2 <= WS_GLR, "tail overlay");
constexpr int LDS_BYTES = 151552;
constexpr int NPHASE = 13;

__device__ __forceinline__ float bf2f(unsigned short b) { return __uint_as_float((unsigned)b << 16); }
__device__ __forceinline__ unsigned short f2bf(float f) { return (unsigned short)pg8::cvt_pk_bf16(f, f); }
__device__ __forceinline__ unsigned pk2(float lo, float hi) { return pg8::cvt_pk_bf16(lo, hi); }
__device__ __forceinline__ float wave_sum(float v) {
#pragma unroll
    for (int o = 1; o < 64; o <<= 1) v += __shfl_xor(v, o);
    return v;
}
__device__ __forceinline__ float sigmoidf_(float x) { return __builtin_amdgcn_rcpf(1.f + __expf(-x)); }

struct EpiIn {
    static constexpr bool PERM = true, AFTER_DRAIN = false;
    bf16_t *GQ, *GK, *GV, *GR, *DQ, *DK, *DV, *GA, *GB; float* GLR; const float* rope;
    __device__ __forceinline__ void operator()(const pg8::f32x4 (&acc)[2][2][4][2], const pg8::Unit& u, int wr, int wc, int fr, int fq) const {
        const int pn = u.pn; const int row0 = u.pm * 256 + wr * 64 + fr;
        if (pn == 32) {
            if (wc == 0) {
#pragma unroll
                for (int ai = 0; ai < 2; ++ai)
#pragma unroll
                    for (int m = 0; m < 4; ++m) { float* p = GLR + (size_t)(row0 + ai * 128 + m * 16) * 32 + 8 * fq;
                        *(f32x4*)p = acc[ai][0][m][0]; *(f32x4*)(p + 4) = acc[ai][0][m][1]; }
            }
            return;
        }
        if (pn >= 12 && pn < 20) {
            bf16_t* base = (pn < 16) ? DQ : DK; const int colt = ((pn - 12) & 3) * 256 + (wc >> 1) * 128; const int i0 = (wc & 1) * 32 + 8 * fq;
#pragma unroll
            for (int ai = 0; ai < 2; ++ai) {
                f32x4 tb[4][4];
#pragma unroll
                for (int m = 0; m < 4; ++m) { const int pos = (row0 + ai * 128 + m * 16) & (SEQ - 1); const f32x4* cs = (const f32x4*)(rope + ((size_t)pos * 64 + i0) * 2);
                    tb[m][0] = cs[0]; tb[m][1] = cs[1]; tb[m][2] = cs[2]; tb[m][3] = cs[3]; }
#pragma unroll
                for (int m = 0; m < 4; ++m) { const int row = row0 + ai * 128 + m * 16;
                    const f32x4 t0 = tb[m][0], t1 = tb[m][1], t2 = tb[m][2], t3 = tb[m][3];
                    const f32x4 xa = acc[ai][0][m][0], xb = acc[ai][0][m][1], ya = acc[ai][1][m][0], yb = acc[ai][1][m][1];
                    u32x4 w1, w2;
                    w1.x = pg8::cvt_pk_bf16(xa[0] * t0[0] - ya[0] * t0[1], xa[1] * t0[2] - ya[1] * t0[3]);
                    w1.y = pg8::cvt_pk_bf16(xa[2] * t1[0] - ya[2] * t1[1], xa[3] * t1[2] - ya[3] * t1[3]);
                    w1.z = pg8::cvt_pk_bf16(xb[0] * t2[0] - yb[0] * t2[1], xb[1] * t2[2] - yb[1] * t2[3]);
                    w1.w = pg8::cvt_pk_bf16(xb[2] * t3[0] - yb[2] * t3[1], xb[3] * t3[2] - yb[3] * t3[3]);
                    w2.x = pg8::cvt_pk_bf16(ya[0] * t0[0] + xa[0] * t0[1], ya[1] * t0[2] + xa[1] * t0[3]);
                    w2.y = pg8::cvt_pk_bf16(ya[2] * t1[0] + xa[2] * t1[1], ya[3] * t1[2] + xa[3] * t1[3]);
                    w2.z = pg8::cvt_pk_bf16(yb[0] * t2[0] + xb[0] * t2[1], yb[1] * t2[2] + xb[1] * t2[3]);
                    w2.w = pg8::cvt_pk_bf16(yb[2] * t3[0] + xb[2] * t3[1], yb[3] * t3[2] + xb[3] * t3[3]);
                    bf16_t* rp = base + (size_t)row * 1024 + colt + i0;
                    *(u32x4*)rp = w1; *(u32x4*)(rp + 64) = w2; } }
            return;
        }
        bf16_t* base; int ld, colt;
        if (pn < 2) { base = GQ; ld = 512; colt = pn * 256; }
        else if (pn < 4) { base = GK; ld = 512; colt = (pn - 2) * 256; }
        else if (pn < 8) { base = GV; ld = 1024; colt = (pn - 4) * 256; }
        else if (pn < 12) { base = GR; ld = 1024; colt = (pn - 8) * 256; }
        else if (pn < 24) { base = DV; ld = 1024; colt = (pn - 20) * 256; }
        else if (pn < 28) { base = GA; ld = 1024; colt = (pn - 24) * 256; }
        else { base = GB; ld = 1024; colt = (pn - 28) * 256; }
        const int col0 = colt + wc * 32 + 8 * fq;
#pragma unroll
        for (int ai = 0; ai < 2; ++ai)
#pragma unroll
            for (int m = 0; m < 4; ++m) { bf16_t* rowp = base + (size_t)(row0 + ai * 128 + m * 16) * ld + col0;
#pragma unroll
                for (int bj = 0; bj < 2; ++bj) { const f32x4 v0 = acc[ai][bj][m][0], v1 = acc[ai][bj][m][1]; u32x4 w;
                    w.x = pg8::cvt_pk_bf16(v0[0], v0[1]); w.y = pg8::cvt_pk_bf16(v0[2], v0[3]); w.z = pg8::cvt_pk_bf16(v1[0], v1[1]); w.w = pg8::cvt_pk_bf16(v1[2], v1[3]);
                    *(u32x4*)(rowp + bj * 128) = w; } }
    }
};
struct EpiOutProj {
    static constexpr bool PERM = true, AFTER_DRAIN = false;
    const float* base; bf16_t* hb; float* ss;
    __device__ __forceinline__ void operator()(const pg8::f32x4 (&acc)[2][2][4][2], const pg8::Unit& u, int wr, int wc, int fr, int fq) const {
        const int row0 = u.pm * 256 + wr * 64 + fr; const int col0 = u.pn * 256 + wc * 32 + 8 * fq;
#pragma unroll
        for (int ai = 0; ai < 2; ++ai) {
            f32x4 xb[4][2][2];
#pragma unroll
            for (int m = 0; m < 4; ++m) { const size_t off = (size_t)(row0 + ai * 128 + m * 16) * 1024 + col0;
#pragma unroll
                for (int bj = 0; bj < 2; ++bj) { xb[m][bj][0] = *(const f32x4*)(base + off + bj * 128); xb[m][bj][1] = *(const f32x4*)(base + off + bj * 128 + 4); } }
#pragma unroll
            for (int m = 0; m < 4; ++m) { const int row = row0 + ai * 128 + m * 16; const size_t off = (size_t)row * 1024 + col0; float s = 0.f;
#pragma unroll
                for (int bj = 0; bj < 2; ++bj) {
                    const f32x4 b0 = xb[m][bj][0], b1 = xb[m][bj][1];
                    const f32x4 h0 = b0 + acc[ai][bj][m][0], h1 = b1 + acc[ai][bj][m][1];
                    s += (h0[0] * h0[0] + h0[1] * h0[1]) + (h0[2] * h0[2] + h0[3] * h0[3]) + (h1[0] * h1[0] + h1[1] * h1[1]) + (h1[2] * h1[2] + h1[3] * h1[3]);
                    u32x4 w; w.x = pg8::cvt_pk_bf16(h0[0], h0[1]); w.y = pg8::cvt_pk_bf16(h0[2], h0[3]); w.z = pg8::cvt_pk_bf16(h1[0], h1[1]); w.w = pg8::cvt_pk_bf16(h1[2], h1[3]);
                    *(u32x4*)(hb + off + bj * 128) = w;
                }
                s += __shfl_xor(s, 16); s += __shfl_xor(s, 32);
                if (fq == 0) atomicAdd(ss + row, s); } }
    }
};
struct EpiFfnOut {
    static constexpr bool PERM = true, AFTER_DRAIN = false;
    const bf16_t* hb; bf16_t* out; float* ss;
    __device__ __forceinline__ void operator()(const pg8::f32x4 (&acc)[2][2][4][2], const pg8::Unit& u, int wr, int wc, int fr, int fq) const {
        const int row0 = u.pm * 256 + wr * 64 + fr; const int col0 = u.pn * 256 + wc * 32 + 8 * fq;
#pragma unroll
        for (int ai = 0; ai < 2; ++ai) {
            u32x4 hq[4][2];
#pragma unroll
            for (int m = 0; m < 4; ++m) { const size_t off = (size_t)(row0 + ai * 128 + m * 16) * 1024 + col0; hq[m][0] = *(const u32x4*)(hb + off); hq[m][1] = *(const u32x4*)(hb + off + 128); }
#pragma unroll
            for (int m = 0; m < 4; ++m) { const int row = row0 + ai * 128 + m * 16; const size_t off = (size_t)row * 1024 + col0; float s = 0.f;
#pragma unroll
                for (int bj = 0; bj < 2; ++bj) {
                    const u32x4 hw = hq[m][bj];
                    f32x4 h0, h1;
                    h0[0] = __uint_as_float(hw.x << 16) + acc[ai][bj][m][0][0]; h0[1] = __uint_as_float(hw.x & 0xffff0000u) + acc[ai][bj][m][0][1];
                    h0[2] = __uint_as_float(hw.y << 16) + acc[ai][bj][m][0][2]; h0[3] = __uint_as_float(hw.y & 0xffff0000u) + acc[ai][bj][m][0][3];
                    h1[0] = __uint_as_float(hw.z << 16) + acc[ai][bj][m][1][0]; h1[1] = __uint_as_float(hw.z & 0xffff0000u) + acc[ai][bj][m][1][1];
                    h1[2] = __uint_as_float(hw.w << 16) + acc[ai][bj][m][1][2]; h1[3] = __uint_as_float(hw.w & 0xffff0000u) + acc[ai][bj][m][1][3];
                    { u32x4 w; w.x = pg8::cvt_pk_bf16(h0[0], h0[1]); w.y = pg8::cvt_pk_bf16(h0[2], h0[3]); w.z = pg8::cvt_pk_bf16(h1[0], h1[1]); w.w = pg8::cvt_pk_bf16(h1[2], h1[3]); *(u32x4*)(out + off + bj * 128) = w; }
                    s += (h0[0] * h0[0] + h0[1] * h0[1]) + (h0[2] * h0[2] + h0[3] * h0[3]) + (h1[0] * h1[0] + h1[1] * h1[1]) + (h1[2] * h1[2] + h1[3] * h1[3]);
                }
                s += __shfl_xor(s, 16); s += __shfl_xor(s, 32);
                if (fq == 0) atomicAdd(ss + row, s); } }
    }
};
struct EpiFfnIn {
    static constexpr bool PERM = true, AFTER_DRAIN = false;
    const float* ss; bf16_t* act;
    __device__ __forceinline__ void operator()(const pg8::f32x4 (&acc)[2][2][4][2], const pg8::Unit& u, int wr, int wc, int fr, int fq) const {
        const int row0 = u.pm * 256 + wr * 64 + fr; const int col0 = u.pn * 128 + wc * 32 + 8 * fq;
        float rsv[2][4];
#pragma unroll
        for (int ai = 0; ai < 2; ++ai)
#pragma unroll
            for (int m = 0; m < 4; ++m) rsv[ai][m] = ss[row0 + ai * 128 + m * 16];
#pragma unroll
        for (int ai = 0; ai < 2; ++ai)
#pragma unroll
            for (int m = 0; m < 4; ++m) { const int row = row0 + ai * 128 + m * 16; const float rstd = rsqrtf(rsv[ai][m] * (1.f / 1024.f) + EPS);
                float o[8];
#pragma unroll
                for (int n = 0; n < 2; ++n)
#pragma unroll
                    for (int e = 0; e < 4; ++e) { const float g = acc[ai][0][m][n][e] * rstd, up = acc[ai][1][m][n][e] * rstd; o[n * 4 + e] = g * sigmoidf_(g) * up; }
                u32x4 w; w.x = pg8::cvt_pk_bf16(o[0], o[1]); w.y = pg8::cvt_pk_bf16(o[2], o[3]); w.z = pg8::cvt_pk_bf16(o[4], o[5]); w.w = pg8::cvt_pk_bf16(o[6], o[7]);
                *(u32x4*)(act + (size_t)row * FFH + col0) = w; }
    }
};

namespace gla {
#define LBAR() do { asm volatile("s_waitcnt lgkmcnt(0)" ::: "memory"); __builtin_amdgcn_s_barrier(); asm volatile("" ::: "memory"); } while (0)
using att::bf16x8; using att::f32x16;
constexpr int LQ = 136, LV = 72;
__device__ __forceinline__ int crow(int r, int hi) { return (r & 3) + 8 * (r >> 2) + 4 * hi; }
constexpr int P_QT = 0, P_KT = 17408, P_GLR = 34816, P_SEG = 38912;
struct Raw { unsigned qv[8], kv[8]; f32x4 gl; };
struct Wd { float wa[16], wb[16]; float ba, bb; };
#define PREP_LOAD(R, item) do { const int dir_ = (item) & 1, h_ = ((item) >> 1) & 3, c_ = ((item) >> 3) & 63, bl_ = (item) >> 9; \
        const long rowb_ = (long)bl_ * SEQ; const int sgn_ = dir_ ? -1 : 1; const int t0_ = dir_ ? (SEQ - 1 - c_ * 64) : c_ * 64; \
        _Pragma("unroll") for (int ii = 0; ii < 8; ++ii) { const long row = rowb_ + t0_ + sgn_ * (seg * 8 + ii); R.qv[ii] = *(const unsigned*)(GQ + row * 512 + h_ * 128 + 2 * d); R.kv[ii] = *(const unsigned*)(GK + row * 512 + h_ * 128 + 2 * d); } \
        if (tid < 256) { const int i = tid >> 2, r4 = tid & 3; R.gl = *(const f32x4*)(GLR + (rowb_ + t0_ + sgn_ * i) * 32 + dir_ * 16 + r4 * 4); } \
        } while (0)
#define PREP_LOADW(W, item) do { const int dir_ = (item) & 1, h_ = ((item) >> 1) & 3; \
        _Pragma("unroll") for (int r = 0; r < 16; ++r) { W.wa[r] = w2g[(dir_ * 16 + r) * 512 + h_ * 128 + 2 * d]; W.wb[r] = w2g[(dir_ * 16 + r) * 512 + h_ * 128 + 2 * d + 1]; } \
        W.ba = bg[dir_ * 512 + h_ * 128 + 2 * d]; W.bb = bg[dir_ * 512 + h_ * 128 + 2 * d + 1]; } while (0)
__device__ __forceinline__ void prep_compute(const Raw& R, const Wd& W, const int it, bf16_t* QT, bf16_t* KST, float* DEC, bf16_t* AM, char* lds,
                                             const int tid, const int lane, const int wid, const int r32, const int hi, const int d, const int seg) {
    bf16_t* Qt = (bf16_t*)(lds + P_QT); bf16_t* Kt = (bf16_t*)(lds + P_KT);
    float* glr_s = (float*)(lds + P_GLR); float* segsum = (float*)(lds + P_SEG);
    typedef float f32x2_ __attribute__((ext_vector_type(2)));
        const int dir = it & 1, h = (it >> 1) & 3, c = (it >> 3) & 63, bl = it >> 9;
        const long rowb = (long)bl * SEQ;
        const size_t cidx = (((size_t)dir * GB + bl) * 4 + h) * 64 + c;
        if (tid < 256) *(f32x4*)(glr_s + (tid >> 2) * 16 + (tid & 3) * 4) = R.gl;
        LBAR();
        float csa[8], csb[8]; float runa = 0.f, runb = 0.f;
#pragma unroll
        for (int ii = 0; ii < 8; ++ii) { const f32x4* gp = (const f32x4*)(glr_s + (seg * 8 + ii) * 16); float la = W.ba, lb = W.bb;
#pragma unroll
            for (int r4 = 0; r4 < 4; ++r4) { const f32x4 gv = gp[r4];
                la += gv[0] * W.wa[4 * r4] + gv[1] * W.wa[4 * r4 + 1] + gv[2] * W.wa[4 * r4 + 2] + gv[3] * W.wa[4 * r4 + 3];
                lb += gv[0] * W.wb[4 * r4] + gv[1] * W.wb[4 * r4 + 1] + gv[2] * W.wb[4 * r4 + 2] + gv[3] * W.wb[4 * r4 + 3]; }
            const float sa = fminf(la, 0.f) - __logf(1.f + __expf(-fabsf(la))), sb = fminf(lb, 0.f) - __logf(1.f + __expf(-fabsf(lb)));
            runa += sa * (1.f / 16.f); runb += sb * (1.f / 16.f); csa[ii] = runa; csb[ii] = runb; }
        *(f32x2_*)(segsum + seg * 128 + 2 * d) = (f32x2_){runa, runb};
        LBAR();
        float prea = 0.f, preb = 0.f, tota = 0.f, totb = 0.f;
#pragma unroll
        for (int s = 0; s < 8; ++s) { const f32x2_ x = *(const f32x2_*)(segsum + s * 128 + 2 * d); tota += x[0]; totb += x[1]; if (s < seg) { prea += x[0]; preb += x[1]; } }
        const float etota = __expf(tota), etotb = __expf(totb);
        bf16_t* qtg = QT + ((size_t)dir * TG + rowb + c * 64 + seg * 8) * 512 + h * 128 + 2 * d;
        float ksa[8], ksb[8];
#pragma unroll
        for (int ii = 0; ii < 8; ++ii) {
            const float ba = csa[ii] + prea, bb = csb[ii] + preb; const float ea = __expf(ba), eb = __expf(bb); const float ia = __builtin_amdgcn_rcpf(ea), ib_ = __builtin_amdgcn_rcpf(eb);
            const float qa = __uint_as_float(R.qv[ii] << 16), qb = __uint_as_float(R.qv[ii] & 0xffff0000u), ka = __uint_as_float(R.kv[ii] << 16), kb = __uint_as_float(R.kv[ii] & 0xffff0000u);
            const unsigned qw = pg8::cvt_pk_bf16(qa * 0.08838834764831845f * ea, qb * 0.08838834764831845f * eb);
            const unsigned kw = pg8::cvt_pk_bf16(ka * ia, kb * ib_);
            ksa[ii] = ka * etota * ia; ksb[ii] = kb * etotb * ib_;
            const int i = seg * 8 + ii;
            *(unsigned*)(Qt + i * LQ + 2 * d) = qw; *(unsigned*)(Kt + i * LQ + 2 * d) = kw;
            *(unsigned*)(qtg + (size_t)ii * 512) = qw; }
        { bf16_t* kp = KST + cidx * 8192 + (2 * d) * 64 + seg * 8;
          *(u32x4*)kp = (u32x4){pg8::cvt_pk_bf16(ksa[0], ksa[1]), pg8::cvt_pk_bf16(ksa[2], ksa[3]), pg8::cvt_pk_bf16(ksa[4], ksa[5]), pg8::cvt_pk_bf16(ksa[6], ksa[7])};
          *(u32x4*)(kp + 64) = (u32x4){pg8::cvt_pk_bf16(ksb[0], ksb[1]), pg8::cvt_pk_bf16(ksb[2], ksb[3]), pg8::cvt_pk_bf16(ksb[4], ksb[5]), pg8::cvt_pk_bf16(ksb[6], ksb[7])}; }
        if (seg == 0) *(f32x2_*)(DEC + cidx * 128 + 2 * d) = (f32x2_){etota, etotb};
        LBAR();
        if (wid < 3) {
            const int ib = wid > 0 ? 1 : 0, jb = wid == 2 ? 1 : 0; f32x16 a = {};
#pragma unroll
            for (int k0 = 0; k0 < 128; k0 += 16) { const bf16x8 A = *(const bf16x8*)(Qt + (ib * 32 + r32) * LQ + k0 + hi * 8); const bf16x8 B = *(const bf16x8*)(Kt + (jb * 32 + r32) * LQ + k0 + hi * 8);
                a = __builtin_amdgcn_mfma_f32_32x32x16_bf16(A, B, a, 0, 0, 0); }
            bf16_t* ap = AM + cidx * 4096;
#pragma unroll
            for (int r = 0; r < 16; ++r) { const int i = ib * 32 + crow(r, hi), j = jb * 32 + r32; ap[i * 64 + j] = f2bf(j <= i ? a[r] : 0.f); }
        } else if (wid == 3) {
            bf16_t* ap = AM + cidx * 4096;
#pragma unroll
            for (int r = 0; r < 16; ++r) ap[crow(r, hi) * 64 + 32 + r32] = 0;
        }
        LBAR();
}
__device__ __forceinline__ void prep_phase(int vcu, int G, int nitems, const bf16_t* GQ, const bf16_t* GK, const float* GLR, const float* w2g, const float* bg,
                                           bf16_t* QT, bf16_t* KST, float* DEC, bf16_t* AM, char* lds) {
    int tid_ = threadIdx.x; asm volatile("" : "+v"(tid_)); const int tid = tid_, lane = tid & 63, wid = tid >> 6, r32 = lane & 31, hi = lane >> 5;
    const int d = tid & 63, seg = tid >> 6;
    int it = vcu; if (it >= nitems) return;
    Raw RA, RB; RA.gl = (f32x4){0.f, 0.f, 0.f, 0.f}; RB.gl = RA.gl;
    PREP_LOAD(RA, it);
    Wd W; int whd = it & 7; PREP_LOADW(W, it);
    for (;;) {
        { const int nx = it + G; if (nx < nitems) PREP_LOAD(RB, nx); prep_compute(RA, W, it, QT, KST, DEC, AM, lds, tid, lane, wid, r32, hi, d, seg); it = nx; if (it >= nitems) break; if ((it & 7) != whd) { whd = it & 7; PREP_LOADW(W, it); } }
        { const int nx = it + G; if (nx < nitems) PREP_LOAD(RA, nx); prep_compute(RB, W, it, QT, KST, DEC, AM, lds, tid, lane, wid, r32, hi, d, seg); it = nx; if (it >= nitems) break; if ((it & 7) != whd) { whd = it & 7; PREP_LOADW(W, it); } }
    }
    LBAR();
}
#undef PREP_LOAD
#undef PREP_LOADW
constexpr int S_ST = 0, S_QT = 17408, S_KST = 34816, S_AM = 53248, S_VT = 62464, S_DC = 71680;
struct Pre { u32x4 q0, q1, k0, k1, am, vr; float dcv; };
__device__ __forceinline__ void scan_item(int item, const bf16_t* GV, const bf16_t* QT, const bf16_t* KST, const float* DEC, const bf16_t* AM, bf16_t* OF, bf16_t* OB, char* lds) {
    int tid_ = threadIdx.x; asm volatile("" : "+v"(tid_)); const int tid = tid_, lane = tid & 63, wid = tid >> 6, r32 = lane & 31, hi = lane >> 5;
    const int vs = item & 3, dir = (item >> 2) & 1, h = (item >> 3) & 3, bl = item >> 5;
    bf16_t* St = (bf16_t*)(lds + S_ST); bf16_t* Qs = (bf16_t*)(lds + S_QT); bf16_t* Ks = (bf16_t*)(lds + S_KST); bf16_t* As = (bf16_t*)(lds + S_AM);
    bf16_t* Vt = (bf16_t*)(lds + S_VT); float* dcs = (float*)(lds + S_DC);
    for (int i = tid; i < 64 * LQ / 2; i += 512) ((unsigned*)St)[i] = 0u;
    f32x16 Sacc = {};
    const int db = wid >> 1, vb = wid & 1, ib = (wid >> 1) & 1, ov = wid & 1;
    bf16_t* Oout = (dir ? OB : OF) + h * 256 + vs * 64 + ov * 32 + r32;
    const long rowb = (long)bl * SEQ; const int sgn = dir ? -1 : 1;
    const int vj = tid & 63, vg = tid >> 6;
    const size_t bh = (((size_t)dir * GB + bl) * 4 + h) * 64;
    const bf16_t* qsrc = QT + ((size_t)dir * TG + rowb + (tid >> 3)) * 512 + h * 128 + (tid & 7) * 16;
    const bf16_t* ksrc = KST + bh * 8192 + (tid >> 2) * 64 + (tid & 3) * 16;
    const bf16_t* asrc = AM + bh * 4096 + (tid >> 3) * 64 + (tid & 7) * 8;
    const float* decb = DEC + bh * 128 + (tid & 127);
    const bf16_t* gvb = GV + h * 256 + vs * 64 + vg * 8;
    bf16_t* qdst = Qs + (tid >> 3) * LQ + (tid & 7) * 16; bf16_t* kdst = Ks + (tid >> 2) * LV + (tid & 3) * 16; bf16_t* adst = As + (tid >> 3) * LV + (tid & 7) * 8;
#define GLA_LOAD(P, c) do { const int t0_ = dir ? (SEQ - 1 - (c) * 64) : (c) * 64; \
        P.q0 = *(const u32x4*)(qsrc + (size_t)(c) * 64 * 512); P.q1 = *(const u32x4*)(qsrc + (size_t)(c) * 64 * 512 + 8); \
        P.k0 = *(const u32x4*)(ksrc + (size_t)(c) * 8192); P.k1 = *(const u32x4*)(ksrc + (size_t)(c) * 8192 + 8); \
        P.am = *(const u32x4*)(asrc + (size_t)(c) * 4096); \
        if (tid < 128) P.dcv = decb[(size_t)(c) * 128]; \
        P.vr = *(const u32x4*)(gvb + (rowb + t0_ + sgn * vj) * 1024); } while (0)
#define GLA_STEP(P, c) do { const int t0_ = dir ? (SEQ - 1 - (c) * 64) : (c) * 64; \
        *(u32x4*)qdst = P.q0; *(u32x4*)(qdst + 8) = P.q1; *(u32x4*)kdst = P.k0; *(u32x4*)(kdst + 8) = P.k1; *(u32x4*)adst = P.am; \
        _Pragma("unroll") for (int e = 0; e < 8; ++e) Vt[(vg * 8 + e) * LV + vj] = (unsigned short)(P.vr[e >> 1] >> ((e & 1) * 16)); \
        if (tid < 128) dcs[tid] = P.dcv; \
        LBAR(); \
        if (wid < 4) { f32x16 o = {}, o2 = {}; \
            _Pragma("unroll") for (int t = 0; t < 8; ++t) { const bf16x8 A = *(const bf16x8*)(Qs + (ib * 32 + r32) * LQ + 16 * t + hi * 8); const bf16x8 B = *(const bf16x8*)(St + (ov * 32 + r32) * LQ + 16 * t + hi * 8); \
                o = __builtin_amdgcn_mfma_f32_32x32x16_bf16(A, B, o, 0, 0, 0); } \
            _Pragma("unroll") for (int t = 0; t < 4; ++t) { const bf16x8 A = *(const bf16x8*)(As + (ib * 32 + r32) * LV + 16 * t + hi * 8); const bf16x8 B = *(const bf16x8*)(Vt + (ov * 32 + r32) * LV + 16 * t + hi * 8); \
                o2 = __builtin_amdgcn_mfma_f32_32x32x16_bf16(A, B, o2, 0, 0, 0); } \
            _Pragma("unroll") for (int r = 0; r < 16; ++r) Oout[(rowb + t0_ + sgn * (ib * 32 + crow(r, hi))) * 1024] = f2bf(o[r] + o2[r]); } \
        _Pragma("unroll") for (int g = 0; g < 4; ++g) { const f32x4 dc = *(const f32x4*)(dcs + db * 32 + 8 * g + 4 * hi); \
            Sacc[4 * g] *= dc[0]; Sacc[4 * g + 1] *= dc[1]; Sacc[4 * g + 2] *= dc[2]; Sacc[4 * g + 3] *= dc[3]; } \
        _Pragma("unroll") for (int t = 0; t < 4; ++t) { const bf16x8 A = *(const bf16x8*)(Ks + (db * 32 + r32) * LV + 16 * t + hi * 8); const bf16x8 B = *(const bf16x8*)(Vt + (vb * 32 + r32) * LV + 16 * t + hi * 8); \
            Sacc = __builtin_amdgcn_mfma_f32_32x32x16_bf16(A, B, Sacc, 0, 0, 0); } \
        LBAR(); \
        _Pragma("unroll") for (int g = 0; g < 4; ++g) { u32x2 w; w.x = pk2(Sacc[4 * g], Sacc[4 * g + 1]); w.y = pk2(Sacc[4 * g + 2], Sacc[4 * g + 3]); \
            *(u32x2*)(St + (vb * 32 + r32) * LQ + db * 32 + 8 * g + 4 * hi) = w; } } while (0)
    Pre P0, P1, P2, P3; P0.dcv = 0.f; P1.dcv = 0.f; P2.dcv = 0.f; P3.dcv = 0.f;
    GLA_LOAD(P0, 0); GLA_LOAD(P1, 1); GLA_LOAD(P2, 2); GLA_LOAD(P3, 3);
    LBAR();
    for (int c = 0; c < 64; c += 4) {
        GLA_STEP(P0, c);     if (c + 4 < 64) GLA_LOAD(P0, c + 4);
        GLA_STEP(P1, c + 1); if (c + 5 < 64) GLA_LOAD(P1, c + 5);
        GLA_STEP(P2, c + 2); if (c + 6 < 64) GLA_LOAD(P2, c + 6);
        GLA_STEP(P3, c + 3); if (c + 7 < 64) GLA_LOAD(P3, c + 7);
    }
    LBAR();
#undef GLA_LOAD
#undef GLA_STEP
}
}

#define LASF __attribute__((address_space(3)))
__device__ __forceinline__ void tr_item(const float* W, int K, int N, bf16_t* WT, int n0, int c0, int k0, const float* kscale, float* scr, int lane) {
    float tv[32];
#pragma unroll
    for (int i = 0; i < 32; ++i) { const int kk = 2 * i + (lane >> 5); tv[i] = (c0 >= 0) ? W[(size_t)(k0 + kk) * N + c0 + (lane & 31)] : 0.f; }
#pragma unroll
    for (int i = 0; i < 32; ++i) { const int kk = 2 * i + (lane >> 5); float v = tv[i]; if (kscale) v *= kscale[k0 + kk]; scr[kk * 33 + (lane & 31)] = v; }
    asm volatile("s_waitcnt lgkmcnt(0)" ::: "memory");
    const int c = lane & 7;
#pragma unroll
    for (int j = 0; j < 4; ++j) { const int n = (lane >> 3) + 8 * j; const float* s = scr + (8 * c) * 33 + n;
        u32x4 o; o.x = pk2(s[0 * 33], s[1 * 33]); o.y = pk2(s[2 * 33], s[3 * 33]); o.z = pk2(s[4 * 33], s[5 * 33]); o.w = pk2(s[6 * 33], s[7 * 33]);
        *(u32x4*)(WT + (size_t)(n0 + n) * K + k0 + 8 * c) = o; }
    asm volatile("s_waitcnt lgkmcnt(0)" ::: "memory");
}
__device__ __forceinline__ int win_src(int n0) {
    if (n0 < 3072) return n0;
    if (n0 < 5120) { const int t = n0 & ~255, p = n0 & 255; const int bj = p >> 7, blk = (p >> 6) & 1, i = p & 63; return t + 32 + blk * 128 + bj * 64 + i; }
    if (n0 < 8192) return n0 + 32;
    if (n0 == 8192) return 3072;
    return -1;
}
__device__ __forceinline__ int wfi_src(int n0) { const int pn = n0 >> 8, p = n0 & 255, bj = p >> 7, j = p & 127; return bj * FFH + pn * 128 + j; }

struct KArgs { const float* in[16]; float* out; unsigned char* ws; int ph_lo, ph_hi; };

__device__ __forceinline__ void phase_prologue(const KArgs& a, char* lds, int vcu, int G) {
    int tid_ = threadIdx.x; asm volatile("" : "+v"(tid_)); const int tid = tid_, lane = tid & 63, wid = tid >> 6;
    unsigned char* ws = a.ws;
    float* scr = (float*)(lds + wid * 8704);
    const int gw = vcu * 8 + wid, NGW = G * 8;
    constexpr int I_IN = (NIN / 32) * 16, I_OUT = 32 * 16, I_FI = (NFI / 32) * 16, I_FO = 32 * 44;
    for (int it = gw; it < I_IN + I_OUT + I_FI + I_FO; it += NGW) {
        int r = it;
        if (r < I_IN) { const int nb = r >> 4, kb = r & 15; tr_item(a.in[2], DM, INW, (bf16_t*)(ws + WS_WIN), nb * 32, win_src(nb * 32), kb * 64, nullptr, scr, lane); continue; } r -= I_IN;
        if (r < I_OUT) { const int nb = r >> 4, kb = r & 15; tr_item(a.in[11], DM, DM, (bf16_t*)(ws + WS_WOUT), nb * 32, nb * 32, kb * 64, nullptr, scr, lane); continue; } r -= I_OUT;
        if (r < I_FI) { const int nb = r >> 4, kb = r & 15; tr_item(a.in[13], DM, NFI, (bf16_t*)(ws + WS_WFI), nb * 32, wfi_src(nb * 32), kb * 64, a.in[12], scr, lane); continue; } r -= I_FI;
        { const int nb = r / 44, kb = r % 44; tr_item(a.in[14], FFH, DM, (bf16_t*)(ws + WS_WFO), nb * 32, nb * 32, kb * 64, nullptr, scr, lane); }
    }
    { const float* nw = a.in[1]; bf16_t* U = (bf16_t*)(ws + WS_U);
      f32x4 wv[4];
#pragma unroll
      for (int j = 0; j < 4; ++j) wv[j] = *((const f32x4*)nw + lane + 64 * j);
      for (int m0 = gw; m0 < NTOK; m0 += 4 * NGW) {
        f32x4 v[4][4]; float s[4];
#pragma unroll
        for (int k = 0; k < 4; ++k) { const int m = m0 + k * NGW; s[k] = 0.f; if (m < NTOK) { const f32x4* __restrict__ xr = (const f32x4*)(a.in[0] + (size_t)m * DM) + lane;
#pragma unroll
            for (int j = 0; j < 4; ++j) v[k][j] = xr[64 * j]; } else {
#pragma unroll
            for (int j = 0; j < 4; ++j) v[k][j] = (f32x4){0.f, 0.f, 0.f, 0.f}; } }
#pragma unroll
        for (int k = 0; k < 4; ++k) {
#pragma unroll
            for (int j = 0; j < 4; ++j) s[k] += (v[k][j][0] * v[k][j][0] + v[k][j][1] * v[k][j][1]) + (v[k][j][2] * v[k][j][2] + v[k][j][3] * v[k][j][3]); }
#pragma unroll
        for (int k = 0; k < 4; ++k) { const int m = m0 + k * NGW; if (m < NTOK) { const float rstd = rsqrtf(wave_sum(s[k]) * (1.f / DM) + EPS);
            u32x2* __restrict__ o8 = (u32x2*)(U + (size_t)m * DM) + lane;
#pragma unroll
            for (int j = 0; j < 4; ++j) { u32x2 w; w.x = pk2(v[k][j][0] * rstd * wv[j][0], v[k][j][1] * rstd * wv[j][1]); w.y = pk2(v[k][j][2] * rstd * wv[j][2], v[k][j][3] * rstd * wv[j][3]); o8[64 * j] = w; } } }
      } }
    { float* rope = (float*)(ws + WS_ROPE);
      for (int idx = vcu * 512 + tid; idx < SEQ * 64; idx += G * 512) { const int pos = idx >> 6, i = idx & 63;
          const double inv = exp(-9.210340371976184 * (double)i / 64.0); const double ang = (double)pos * inv;
          rope[2 * idx] = (float)cos(ang); rope[2 * idx + 1] = (float)sin(ang); } }
    { float* ss = (float*)(ws + WS_SS1);
      for (int idx = vcu * 512 + tid; idx < 2 * NTOK; idx += G * 512) ss[idx] = 0.f; }
    if (vcu == 0 && wid == 0) {
        const float s1 = wave_sum(a.in[6][lane] * a.in[7][lane] + a.in[6][lane + 64] * a.in[7][lane + 64]);
        const float s2 = wave_sum(a.in[8][lane] * a.in[9][lane] + a.in[8][lane + 64] * a.in[9][lane + 64]);
        if (lane == 0) *(float*)(ws + WS_CTL) = expf(s1) - expf(s2) + LAMBDA_INIT;
    }
}

__device__ __forceinline__ void phase_merge(const KArgs& a, int g, int vcu, int G) {
    int tid_ = threadIdx.x; asm volatile("" : "+v"(tid_)); const int tid = tid_, lane = tid & 63, wid = tid >> 6;
    unsigned char* ws = a.ws;
    const bf16_t* __restrict__ OF = (const bf16_t*)(ws + WS_OF); const bf16_t* __restrict__ OB = (const bf16_t*)(ws + WS_OB); const bf16_t* __restrict__ GR = (const bf16_t*)(ws + WS_GR);
    const bf16_t* __restrict__ O2 = (const bf16_t*)(ws + WS_O2C); const bf16_t* __restrict__ GA = (const bf16_t*)(ws + WS_GA); const bf16_t* __restrict__ GBb = (const bf16_t*)(ws + WS_GB);
    bf16_t* __restrict__ MG = (bf16_t*)(ws + WS_MERGED) + (size_t)g * TG * DM;
    const int e0 = lane * 16, c0 = e0 & 255;
    float gw_[16], sw_[16];
#pragma unroll
    for (int e = 0; e < 16; ++e) { gw_[e] = a.in[5][c0 + e]; sw_[e] = a.in[10][c0 + e] * (1.f - LAMBDA_INIT); }
#pragma unroll 2
    for (int m = vcu * 8 + wid; m < TG; m += G * 8) {
        const size_t off = (size_t)m * DM + e0;
        u32x4 vf[2], vb[2], vr[2], v2[2], va[2], vg[2];
#pragma unroll
        for (int q = 0; q < 2; ++q) { vf[q] = *(const u32x4*)(OF + off + 8 * q); vb[q] = *(const u32x4*)(OB + off + 8 * q); vr[q] = *(const u32x4*)(GR + off + 8 * q);
            v2[q] = *(const u32x4*)(O2 + off + 8 * q); va[q] = *(const u32x4*)(GA + off + 8 * q); vg[q] = *(const u32x4*)(GBb + off + 8 * q); }
        float oa[16], o2[16]; float sa = 0.f, sb = 0.f;
#pragma unroll
        for (int e = 0; e < 16; ++e) { const int q = e >> 3, w = (e >> 1) & 3, sh = (e & 1) * 16;
            const float f = bf2f((unsigned short)(vf[q][w] >> sh)) + bf2f((unsigned short)(vb[q][w] >> sh)); const float t = bf2f((unsigned short)(v2[q][w] >> sh));
            oa[e] = f; o2[e] = t; sa += f * f; sb += t * t; }
#pragma unroll
        for (int o = 1; o < 16; o <<= 1) { sa += __shfl_xor(sa, o); sb += __shfl_xor(sb, o); }
        const float ra = rsqrtf(sa * (1.f / 256.f) + EPS), rb = rsqrtf(sb * (1.f / 256.f) + SUBLN_EPS);
        float mo[16];
#pragma unroll
        for (int e = 0; e < 16; ++e) { const int q = e >> 3, w = (e >> 1) & 3, sh = (e & 1) * 16;
            const float gr = bf2f((unsigned short)(vr[q][w] >> sh)), ga = bf2f((unsigned short)(va[q][w] >> sh)), gb = bf2f((unsigned short)(vg[q][w] >> sh));
            const float ya = oa[e] * ra * gw_[e] * (gr * sigmoidf_(gr)); const float yb = o2[e] * rb * sw_[e];
            mo[e] = sigmoidf_(ga) * ya + sigmoidf_(gb) * yb; }
        u32x4 w0, w1;
        w0.x = pk2(mo[0], mo[1]); w0.y = pk2(mo[2], mo[3]); w0.z = pk2(mo[4], mo[5]); w0.w = pk2(mo[6], mo[7]);
        w1.x = pk2(mo[8], mo[9]); w1.y = pk2(mo[10], mo[11]); w1.z = pk2(mo[12], mo[13]); w1.w = pk2(mo[14], mo[15]);
        *(u32x4*)(MG + off) = w0; *(u32x4*)(MG + off + 8) = w1;
    }
}

__device__ __forceinline__ void glr_panels(const bf16_t* U, const bf16_t* WT, float* GLR, int vcu, int G) {
    int tid_ = threadIdx.x; asm volatile("" : "+v"(tid_)); const int lane = tid_ & 63, wid = tid_ >> 6, r32 = lane & 31, hi = lane >> 5;
    const bf16_t* bp = WT + (size_t)r32 * DM + hi * 8;
    for (int p = vcu * 8 + wid; p < TG / 32; p += G * 8) {
        const bf16_t* ap = U + (size_t)(p * 32 + r32) * DM + hi * 8;
        att::f32x16 acc = {};
        att::bf16x8 fa[8], fb[8], ga[8], gb[8];
#define GLR_LD(A_, B_, t0_) do { _Pragma("unroll") for (int t = 0; t < 8; ++t) { A_[t] = *(const att::bf16x8*)(ap + 16 * ((t0_) + t)); B_[t] = *(const att::bf16x8*)(bp + 16 * ((t0_) + t)); } } while (0)
#define GLR_MM(A_, B_) do { _Pragma("unroll") for (int t = 0; t < 8; ++t) acc = __builtin_amdgcn_mfma_f32_32x32x16_bf16(A_[t], B_[t], acc, 0, 0, 0); } while (0)
        GLR_LD(fa, fb, 0);
#pragma unroll 1
        for (int t0 = 0; t0 < 64; t0 += 16) { GLR_LD(ga, gb, t0 + 8); GLR_MM(fa, fb); if (t0 + 16 < 64) GLR_LD(fa, fb, t0 + 16); GLR_MM(ga, gb); }
#undef GLR_LD
#undef GLR_MM
#pragma unroll
        for (int r = 0; r < 16; ++r) GLR[(size_t)(p * 32 + gla::crow(r, hi)) * 32 + r32] = acc[r];
    }
}
#define LAS __attribute__((address_space(3)))
#define XB_TMO      128
#define XB_XCNT(j)  (256  + 64 * (j))
#define XB_XSUB(j)  (1280 + 64 * (j))
#define XB_XGEN(j)  (2304 + 64 * (j))
#define XB_TOP      3328
#define XB_TOPGEN   3392
#define XCD_BAR_WORDS 3456
#define XB_SPIN_CAP (1u << 18)

__device__ __forceinline__ unsigned xb_ld(unsigned* p)              { return __hip_atomic_load(p, __ATOMIC_RELAXED, __HIP_MEMORY_SCOPE_AGENT); }
__device__ __forceinline__ unsigned xb_add(unsigned* p, unsigned v) { return __hip_atomic_fetch_add(p, v, __ATOMIC_RELAXED, __HIP_MEMORY_SCOPE_AGENT); }
__device__ __forceinline__ unsigned xb_xcc_id() { return (unsigned)__builtin_amdgcn_s_getreg((3 << 11) | 20) & 0xFu; }
#define XB_SPIN(cond, bar) do { unsigned _sp = 0; while (cond) { __builtin_amdgcn_s_sleep(1); \
    if ((++_sp & 255u) == 0u) { if (xb_ld(&(bar)[XB_TMO])) break; if (_sp > XB_SPIN_CAP) { atomicAdd(&(bar)[XB_TMO], 1u); break; } } } } while (0)

struct XcdBarrier {
    unsigned* bar; unsigned x;
    volatile LAS unsigned* st;
};

__device__ __forceinline__ XcdBarrier xcd_barrier_post(unsigned* bar, volatile LAS unsigned* st) {
    XcdBarrier b; b.bar = bar; b.x = xb_xcc_id(); b.st = st;
    if (threadIdx.x == 0) st[2] = xb_add(&bar[XB_XCNT(b.x)], 1u);
    return b;
}
__device__ __forceinline__ void xcd_barrier_complete(unsigned* bar, unsigned x, unsigned& nloc, unsigned& nx) {
    const unsigned G = gridDim.x * gridDim.y * gridDim.z;
    unsigned sum, cnt, mine, sp = 0u;
    for (;;) {
        sum = 0u; cnt = 0u; mine = 0u;
#pragma unroll
        for (unsigned j = 0; j < 16; ++j) { const unsigned c = xb_ld(&bar[XB_XCNT(j)]); sum += c; cnt += (c > 0u) ? 1u : 0u; mine = (j == x) ? c : mine; }
        if (sum == G) break;
        __builtin_amdgcn_s_sleep(1);
        if ((++sp & 255u) == 0u) { if (xb_ld(&bar[XB_TMO])) break; if (sp > XB_SPIN_CAP) { atomicAdd(&bar[XB_TMO], 1u); break; } }
    }
    nloc = mine > 0u ? mine : 1u; nx = cnt > 0u ? cnt : 1u;
}

__device__ __forceinline__ void xcd_barrier(const XcdBarrier& b) {
    asm volatile("s_waitcnt vmcnt(0)" ::: "memory");
    __syncthreads();
    if (threadIdx.x == 0) {
        unsigned* bar = b.bar;
        __builtin_amdgcn_s_waitcnt(0);
        unsigned nloc = b.st[0], nx = b.st[1];
        if (nloc == 0u) { xcd_barrier_complete(bar, b.x, nloc, nx); b.st[0] = nloc; b.st[1] = nx; }
        const unsigned old = xb_add(&bar[XB_XSUB(b.x)], 1u);
        const unsigned gen = old / nloc;
        if (old + 1u == (gen + 1u) * nloc) {
            __builtin_amdgcn_fence(__ATOMIC_RELEASE, "agent");
            asm volatile("s_waitcnt vmcnt(0)" ::: "memory");
            const unsigned og = xb_add(&bar[XB_TOP], 1u);
            const unsigned tg = og / nx;
            if (og + 1u == (tg + 1u) * nx) xb_add(&bar[XB_TOPGEN], 1u);
            else XB_SPIN(xb_ld(&bar[XB_TOPGEN]) == tg, bar);
            __builtin_amdgcn_fence(__ATOMIC_ACQUIRE, "agent");
            xb_add(&bar[XB_XGEN(b.x)], 1u);
            asm volatile("s_waitcnt vmcnt(0)" ::: "memory");
        } else {
            XB_SPIN(xb_ld(&bar[XB_XGEN(b.x)]) == gen, bar);
            __builtin_amdgcn_fence(__ATOMIC_ACQUIRE, "agent");
            asm volatile("s_waitcnt vmcnt(0)" ::: "memory");
        }
    }
    __syncthreads();
}

__global__ void __launch_bounds__(512) hybrid_fwd(KArgs a) {
    extern __shared__ __attribute__((aligned(16))) unsigned char lds[];
    cg::grid_group grid = cg::this_grid();
    const int G = gridDim.x, bx = blockIdx.x;
    int vcu = (G % 8 == 0) ? (bx % 8) * (G / 8) + bx / 8 : bx;
    int cg_ = bx;
#define IN(k) (lo <= (k) && (k) < hi)
#define SEAM(k) do { if (IN(k) && IN((k) + 1)) xcd_barrier(xbar); } while (0)
#define WSP unsigned char* ws = a.ws
    const int lo = a.ph_lo, hi = a.ph_hi;
    if (lo > NPHASE) grid.sync();
    volatile LAS unsigned* xst = (volatile LAS unsigned*)((LAS unsigned char*)lds + 150528);
    if (threadIdx.x < 4) xst[threadIdx.x] = 0u;
    __syncthreads();
    XcdBarrier xbar; xbar.bar = (unsigned*)(a.ws + WS_BAR); xbar.x = 0; xbar.st = xst;
    if (hi - lo > 2) xbar = xcd_barrier_post((unsigned*)(a.ws + WS_BAR), xst);
    if (IN(0)) {
#ifndef DIS_PRO
        phase_prologue(a, (char*)lds, vcu, G);
#endif
    }
    SEAM(0);
    if (IN(0) && IN(1) && G % 8 == 0) {
        if (threadIdx.x == 0) { bool ok = xbar.x < 8u; for (unsigned j = 0; j < 16; ++j) { const unsigned c = xb_ld(&xbar.bar[XB_XCNT(j)]); ok = ok && (c == (j < 8u ? (unsigned)G / 8u : 0u)); }
            xst[3] = ok ? 1u : 0u; }
        __syncthreads();
        if (xst[3]) { const int rk = (int)xst[2], xc = (int)xbar.x; vcu = xc * (G / 8) + rk; cg_ = rk * 8 + xc; }
    }
    { constexpr int g = 0;
      if (IN(1)) { WSP;
                glr_panels((const bf16_t*)(ws + WS_U) + (size_t)g * TG * DM, (const bf16_t*)(ws + WS_WIN) + (size_t)8192 * DM, (float*)(ws + WS_GLR), vcu, G);
                pg8::Gemm gm{(const bf16_t*)(ws + WS_U) + (size_t)g * TG * DM, (const bf16_t*)(ws + WS_WIN), TG, 8192, DM};
                pg8::StaticOrder S; S.init(TG, 8192, G, cg_);
                EpiIn E{(bf16_t*)(ws + WS_GQ), (bf16_t*)(ws + WS_GK), (bf16_t*)(ws + WS_GV), (bf16_t*)(ws + WS_GR), (bf16_t*)(ws + WS_DQ), (bf16_t*)(ws + WS_DK), (bf16_t*)(ws + WS_DV),
                        (bf16_t*)(ws + WS_GA), (bf16_t*)(ws + WS_GB), (float*)(ws + WS_GLR), (const float*)(ws + WS_ROPE)};
#ifndef DIS_G1
                pg8::gemm_phase<EpiIn, pg8::StaticOrder, true, true>((PG8_LAS unsigned char*)lds, gm, S, E);
#endif
      }
      SEAM(1);
            if (IN(2)) { WSP;
#ifndef DIS_GLA
                gla::prep_phase(vcu, G, GB * 512, (const bf16_t*)(ws + WS_GQ), (const bf16_t*)(ws + WS_GK), (const float*)(ws + WS_GLR), a.in[3], a.in[4],
                                (bf16_t*)((unsigned char*)a.out + OUT_QT), (bf16_t*)((unsigned char*)a.out + OUT_KST), (float*)(ws + WS_DEC), (bf16_t*)(ws + WS_MERGED + 64 * MiB), (char*)lds);
#endif
      }
      SEAM(2);
      if (IN(3)) { WSP;
#ifndef DIS_GLA
                for (int it = vcu; it < GB * 32; it += G)
                    gla::scan_item(it, (const bf16_t*)(ws + WS_GV), (const bf16_t*)((unsigned char*)a.out + OUT_QT), (const bf16_t*)((unsigned char*)a.out + OUT_KST), (const float*)(ws + WS_DEC), (const bf16_t*)(ws + WS_MERGED + 64 * MiB),
                                   (bf16_t*)(ws + WS_OF), (bf16_t*)(ws + WS_OB), (char*)lds);
#endif
#ifndef DIS_ATT
                const float lam = *(const float*)(ws + WS_CTL);
                for (int un = vcu; un < GB * 64; un += G) {
                    const int qb = un & 15, h = (un >> 4) & 3, bl = un >> 6;
                    const size_t r0 = (size_t)bl * SEQ * 1024;
                    const att::bf16* Q = (const att::bf16*)(ws + WS_DQ) + r0 + (size_t)qb * 256 * 1024 + h * 256;
                    const att::bf16* Kp = (const att::bf16*)(ws + WS_DK) + r0 + h * 256;
                    const att::bf16* Vp = (const att::bf16*)(ws + WS_DV) + r0 + h * 256;
                    float* O1 = a.out + r0 + (size_t)qb * 256 * 1024 + h * 256;
                    bf16_t* O2 = (bf16_t*)(ws + WS_O2C) + r0 + (size_t)qb * 256 * 1024 + h * 256;
#pragma unroll 1
                    for (int p = 0; p < 2; ++p) att2::attn256_body(Q + 128 * p, Kp + 128 * p, Vp, O1, O2, p, lam, SEQ, (char*)lds);
                }
#endif
      }
      SEAM(3);
      if (IN(4)) {
#ifndef DIS_MRG
                phase_merge(a, g, vcu, G);
#endif
      }
      SEAM(4);
    }
    { constexpr int g = 1;
      if (IN(5)) { WSP;
                glr_panels((const bf16_t*)(ws + WS_U) + (size_t)g * TG * DM, (const bf16_t*)(ws + WS_WIN) + (size_t)8192 * DM, (float*)(ws + WS_GLR), vcu, G);
                pg8::Gemm gm{(const bf16_t*)(ws + WS_U) + (size_t)g * TG * DM, (const bf16_t*)(ws + WS_WIN), TG, 8192, DM};
                pg8::StaticOrder S; S.init(TG, 8192, G, cg_);
                EpiIn E{(bf16_t*)(ws + WS_GQ), (bf16_t*)(ws + WS_GK), (bf16_t*)(ws + WS_GV), (bf16_t*)(ws + WS_GR), (bf16_t*)(ws + WS_DQ), (bf16_t*)(ws + WS_DK), (bf16_t*)(ws + WS_DV),
                        (bf16_t*)(ws + WS_GA), (bf16_t*)(ws + WS_GB), (float*)(ws + WS_GLR), (const float*)(ws + WS_ROPE)};
#ifndef DIS_G1
                pg8::gemm_phase<EpiIn, pg8::StaticOrder, true, true>((PG8_LAS unsigned char*)lds, gm, S, E);
#endif
      }
      SEAM(5);
            if (IN(6)) { WSP;
#ifndef DIS_GLA
                gla::prep_phase(vcu, G, GB * 512, (const bf16_t*)(ws + WS_GQ), (const bf16_t*)(ws + WS_GK), (const float*)(ws + WS_GLR), a.in[3], a.in[4],
                                (bf16_t*)((unsigned char*)a.out + OUT_QT), (bf16_t*)((unsigned char*)a.out + OUT_KST), (float*)(ws + WS_DEC), (bf16_t*)(ws + WS_MERGED + 64 * MiB), (char*)lds);
#endif
      }
      SEAM(6);
      if (IN(7)) { WSP;
#ifndef DIS_GLA
                for (int it = vcu; it < GB * 32; it += G)
                    gla::scan_item(it, (const bf16_t*)(ws + WS_GV), (const bf16_t*)((unsigned char*)a.out + OUT_QT), (const bf16_t*)((unsigned char*)a.out + OUT_KST), (const float*)(ws + WS_DEC), (const bf16_t*)(ws + WS_MERGED + 64 * MiB),
                                   (bf16_t*)(ws + WS_OF), (bf16_t*)(ws + WS_OB), (char*)lds);
#endif
#ifndef DIS_ATT
                const float lam = *(const float*)(ws + WS_CTL);
                for (int un = vcu; un < GB * 64; un += G) {
                    const int qb = un & 15, h = (un >> 4) & 3, bl = un >> 6;
                    const size_t r0 = (size_t)bl * SEQ * 1024;
                    const att::bf16* Q = (const att::bf16*)(ws + WS_DQ) + r0 + (size_t)qb * 256 * 1024 + h * 256;
                    const att::bf16* Kp = (const att::bf16*)(ws + WS_DK) + r0 + h * 256;
                    const att::bf16* Vp = (const att::bf16*)(ws + WS_DV) + r0 + h * 256;
                    float* O1 = a.out + r0 + (size_t)qb * 256 * 1024 + h * 256;
                    bf16_t* O2 = (bf16_t*)(ws + WS_O2C) + r0 + (size_t)qb * 256 * 1024 + h * 256;
#pragma unroll 1
                    for (int p = 0; p < 2; ++p) att2::attn256_body(Q + 128 * p, Kp + 128 * p, Vp, O1, O2, p, lam, SEQ, (char*)lds);
                }
#endif
      }
      SEAM(7);
      if (IN(8)) {
#ifndef DIS_MRG
                phase_merge(a, g, vcu, G);
#endif
      }
      SEAM(8);
    }
    if (IN(9)) { WSP;
            pg8::Gemm gm{(const bf16_t*)(ws + WS_MERGED), (const bf16_t*)(ws + WS_WOUT), NTOK, DM, DM};
            pg8::StaticOrder S; S.init(NTOK, DM, G, cg_);
            EpiOutProj E{a.in[0], (bf16_t*)(ws + WS_H1B), (float*)(ws + WS_SS1)};
#ifndef DIS_G2
            pg8::gemm_phase<EpiOutProj, pg8::StaticOrder, true, true>((PG8_LAS unsigned char*)lds, gm, S, E);
#endif
    }
    SEAM(9);
    if (IN(10)) { WSP;
            pg8::Gemm gm{(const bf16_t*)(ws + WS_H1B), (const bf16_t*)(ws + WS_WFI), NTOK, NFI, DM};
            pg8::StaticOrder S; S.init(NTOK, NFI, G, cg_);
            EpiFfnIn E{(const float*)(ws + WS_SS1), (bf16_t*)(ws + WS_ACT)};
#ifndef DIS_G3
            pg8::gemm_phase<EpiFfnIn, pg8::StaticOrder, true, true>((PG8_LAS unsigned char*)lds, gm, S, E);
#endif
    }
    SEAM(10);
    if (IN(11)) { WSP;
            pg8::Gemm gm{(const bf16_t*)(ws + WS_ACT), (const bf16_t*)(ws + WS_WFO), NTOK, DM, FFH};
            pg8::StaticOrder S; S.init(NTOK, DM, G, cg_);
            EpiFfnOut E{(const bf16_t*)(ws + WS_H1B), (bf16_t*)(ws + WS_MERGED), (float*)(ws + WS_SS2)};
#ifndef DIS_G4
            pg8::gemm_phase<EpiFfnOut, pg8::StaticOrder, true, true>((PG8_LAS unsigned char*)lds, gm, S, E);
#endif
    }
    SEAM(11);
    if (IN(12)) { WSP;
            const float* ss = (const float*)(ws + WS_SS2); const f32x4* wf = (const f32x4*)a.in[15]; f32x4* o4 = (f32x4*)a.out; const u32x2* h2 = (const u32x2*)(ws + WS_MERGED);
            {
                const size_t stride = (size_t)G * 512, total = (size_t)NTOK * 256; size_t idx = (size_t)vcu * 512 + threadIdx.x; const f32x4 wv = wf[idx & 255];
                for (; idx + 3 * stride < total; idx += 4 * stride) { u32x2 hw[4]; float sv[4];
#pragma unroll
                    for (int k = 0; k < 4; ++k) { hw[k] = h2[idx + k * stride]; sv[k] = ss[(idx + k * stride) >> 8]; }
#pragma unroll
                    for (int k = 0; k < 4; ++k) { const float rstd = rsqrtf(sv[k] * (1.f / 1024.f) + EPS); f32x4 h; h[0] = __uint_as_float(hw[k].x << 16); h[1] = __uint_as_float(hw[k].x & 0xffff0000u); h[2] = __uint_as_float(hw[k].y << 16); h[3] = __uint_as_float(hw[k].y & 0xffff0000u);
                        o4[idx + k * stride] = h * rstd * wv; } }
                for (; idx < total; idx += stride) { const float rstd = rsqrtf(ss[idx >> 8] * (1.f / 1024.f) + EPS); const u32x2 hw = h2[idx]; f32x4 h; h[0] = __uint_as_float(hw.x << 16); h[1] = __uint_as_float(hw.x & 0xffff0000u); h[2] = __uint_as_float(hw.y << 16); h[3] = __uint_as_float(hw.y & 0xffff0000u);
                    o4[idx] = h * rstd * wv; } }
    }
#undef IN
#undef SEAM
#undef WSP
}

extern "C" void kernel_launch(void* const* d_in, const int* in_sizes, int n_in, void* d_out, int out_size, void* d_ws, size_t ws_size, hipStream_t stream) {
    static int grid = 0;
    if (grid == 0) {
        if (n_in != 16 || in_sizes[0] != NTOK * DM || out_size != NTOK * DM || ws_size < WS_END) {
            fprintf(stderr, "kernel_launch: shape/workspace mismatch (n_in %d, in0 %d, out %d, ws %zu, need %zu)\n", n_in, n_in > 0 ? in_sizes[0] : -1, out_size, ws_size, (size_t)WS_END); grid = -1; return; }
        int dev = 0, cus = 0, per_cu = 0;
        hipGetDevice(&dev); hipDeviceGetAttribute(&cus, hipDeviceAttributeMultiprocessorCount, dev);
        if (hipFuncSetAttribute((const void*)hybrid_fwd, hipFuncAttributeMaxDynamicSharedMemorySize, LDS_BYTES) != hipSuccess) { fprintf(stderr, "kernel_launch: hipFuncSetAttribute failed\n"); grid = -1; return; }
        if (hipOccupancyMaxActiveBlocksPerMultiprocessor(&per_cu, (const void*)hybrid_fwd, 512, LDS_BYTES) != hipSuccess || per_cu < 1) { fprintf(stderr, "kernel_launch: occupancy query gave %d\n", per_cu); per_cu = 1; }
        (void)hipGetLastError();
        grid = cus * 1;
        if (grid <= 0) grid = 256;
    }
    if (grid < 0) return;
    if (hipMemsetAsync((char*)d_ws + WS_BAR, 0, WS_BAR_BYTES, stream) != hipSuccess) { fprintf(stderr, "kernel_launch: hipMemsetAsync of the barrier words failed\n"); return; }
    KArgs a{};
    for (int i = 0; i < 16; ++i) a.in[i] = (const float*)d_in[i];
    a.out = (float*)d_out; a.ws = (unsigned char*)d_ws;
#if N_LAUNCH_MODE == 1
    a.ph_lo = 0; a.ph_hi = NPHASE;
    { void* args[] = {&a};
      hipError_t e = hipLaunchCooperativeKernel((const void*)hybrid_fwd, dim3(grid), dim3(512), args, LDS_BYTES, stream);
      if (e != hipSuccess) fprintf(stderr, "cooperative launch failed: %s (grid %d)\n", hipGetErrorString(e), grid); }
#else
    for (int ph = 0; ph < NPHASE; ++ph) {
        a.ph_lo = ph; a.ph_hi = ph + 1; void* args[] = {&a};
        hipError_t e = hipLaunchCooperativeKernel((const void*)hybrid_fwd, dim3(grid), dim3(512), args, LDS_BYTES, stream);
        if (e != hipSuccess) { fprintf(stderr, "cooperative launch %d failed: %s (grid %d)\n", ph, hipGetErrorString(e), grid); break; }
    }
#endif
}
```

```cpp
#include <hip/hip_runtime.h>
#include <hip/hip_bf16.h>
#include <hip/hip_cooperative_groups.h>
#include <cstdio>
#include <cstdint>
namespace cg = cooperative_groups;
#ifndef N_LAUNCH_MODE
#define N_LAUNCH_MODE 1
#endif
namespace pg8 {
#define PG8_LAS __attribute__((address_space(3)))
typedef unsigned short bf16_t;
typedef short bf16x8 __attribute__((ext_vector_type(8)));
typedef float f32x4 __attribute__((ext_vector_type(4)));
typedef unsigned u32x4 __attribute__((ext_vector_type(4)));
constexpr int BM = 256, BK = 64, HALF = 128, HTB = HALF * BK * 2  , STAGE_BYTES = 8 * HTB, NXCD = 8, WGM = 8;

__host__ __device__ __forceinline__ int lds_byte(int r, int c) { const int st = (r >> 4) * 2 + (c >> 5), rr = r & 15, cc = c & 31, ob = rr * 64 + cc * 2; return st * 1024 + (ob ^ (((ob >> 9) & 1) << 5)); }
__host__ __device__ __forceinline__ void stage_rc(int b, int& R, int& C) { const int st = b / 1024, sb = b % 1024, swz = sb ^ (((sb >> 9) & 1) << 5); R = (st >> 1) * 16 + swz / 64; C = (st & 1) * 32 + (swz % 64) / 2; }
__host__ __device__ __forceinline__ int perm32(int rho) { const int n = rho >> 4, i = rho & 15; return 8 * (i >> 2) + 4 * n + (i & 3); }

struct Unit { int pm, pn; };
struct Gemm { const bf16_t* A; const bf16_t* Bt; int M, N, K; };

struct StaticOrder {
    int nM, nN, nwg, G, c;
    __host__ __device__ void init(int M, int N, int G_, int c_) { nM = M / BM; nN = N / BM; nwg = nM * nN; G = G_; c = c_; }
    __host__ __device__ bool next(int i, Unit& u) const {
        const long L = (long)i * G + c; if (L >= nwg) return false;
        int wgid = (int)L; { const int q = nwg / NXCD, r = nwg % NXCD, xcd = wgid % NXCD, off = wgid / NXCD; wgid = (xcd < r ? xcd * (q + 1) : r * (q + 1) + (xcd - r) * q) + off; }
        const int nig = WGM * nN, gid = wgid / nig, fm = gid * WGM, gsz = (nM - fm) < WGM ? (nM - fm) : WGM;
        u.pm = fm + ((wgid % nig) % gsz); u.pn = (wgid % nig) / gsz; return true;
    }
    __device__ __forceinline__ void a_ready(const Unit&) const {}
    __device__ __forceinline__ void done(const Unit&) const {}
};

typedef float cvt_f32x2_t __attribute__((ext_vector_type(2))); typedef __bf16 cvt_bf16x2_t __attribute__((ext_vector_type(2)));
__device__ __forceinline__ unsigned cvt_pk_bf16(float lo, float hi) { cvt_f32x2_t v = {lo, hi}; cvt_bf16x2_t b = __builtin_convertvector(v, cvt_bf16x2_t); return __builtin_bit_cast(unsigned, b); }
typedef float f32x2 __attribute__((ext_vector_type(2)));
template <class Epi, class Sched, bool ALIGN_EPI = false, bool SP2 = false>
__device__ __forceinline__ void gemm_phase(PG8_LAS unsigned char* lds, const Gemm g, const Sched& S, const Epi& E) {
    int tid_ = threadIdx.x; asm volatile("" : "+v"(tid_)); const int tid = tid_, wid = __builtin_amdgcn_readfirstlane(tid >> 6), lane = tid & 63, wr = wid >> 2, wc = wid & 3, fr = lane & 15, fq = lane >> 4;
    const int K = g.K, nt = K / BK;
    unsigned voffA[2], voffB[2];
#pragma unroll
    for (int i = 0; i < 2; ++i) { int R, C; stage_rc(tid * 16 + i * 8192, R, C); const int Rb = Epi::PERM ? ((R & ~31) + perm32(R & 31)) : R;
        voffA[i] = (unsigned)(R * K + C) * 2u; voffB[i] = (unsigned)(Rb * K + C) * 2u; }
    const size_t kstep = (size_t)(BK * 2);
    const size_t hstep = (size_t)HALF * K * 2;
    const size_t tstep = 2 * hstep;
    const unsigned ldsw = (unsigned)wid * 1024u;
    const int aoff = lds_byte(wr * 64 + fr, fq * 8), boff = lds_byte(wc * 32 + fr, fq * 8);
#define PG8_SA(b, h) (((b) * 2 + (h)) * HTB)
#define PG8_SB(b, h) ((4 + (b) * 2 + (h)) * HTB)
#define PG8_STAGE(bufoff, gbase, voff) do { _Pragma("unroll") for (int _i = 0; _i < 2; ++_i) \
        __builtin_amdgcn_global_load_lds((const unsigned*)((const char*)(gbase) + (voff)[_i]), (PG8_LAS unsigned*)(lds + (bufoff) + ldsw + _i * 8192), 16, 0, 0); } while (0)
#define PG8_LDA(dst, b, h) do { _Pragma("unroll") for (int m = 0; m < 4; ++m) _Pragma("unroll") for (int k = 0; k < 2; ++k) dst[m][k] = *(const PG8_LAS bf16x8*)(lds + PG8_SA(b, h) + aoff + m * 2048 + k * 1024); } while (0)
#define PG8_LDB(dst, b, h) do { _Pragma("unroll") for (int n = 0; n < 2; ++n) _Pragma("unroll") for (int k = 0; k < 2; ++k) dst[n][k] = *(const PG8_LAS bf16x8*)(lds + PG8_SB(b, h) + boff + n * 2048 + k * 1024); } while (0)
#define PG8_MMA(ai, bj, At, Bt) do { __builtin_amdgcn_s_setprio(1); _Pragma("unroll") for (int m = 0; m < 4; ++m) _Pragma("unroll") for (int n = 0; n < 2; ++n) _Pragma("unroll") for (int k = 0; k < 2; ++k) \
        acc[ai][bj][m][n] = __builtin_amdgcn_mfma_f32_16x16x32_bf16(Bt[n][k], At[m][k], acc[ai][bj][m][n], 0, 0, 0); __builtin_amdgcn_s_setprio(0); } while (0)
#define PG8_WAIT_V(n) asm volatile("s_waitcnt vmcnt(" #n ")" ::: "memory")
#define PG8_WAIT_L(n) asm volatile("s_waitcnt lgkmcnt(" #n ")" ::: "memory")
#define PG8_BAR __builtin_amdgcn_s_barrier()
#define PG8_SCHED __builtin_amdgcn_sched_barrier(0)
    Unit cur, nxt; int ui = 0;
    if (!S.next(0, cur)) return;
    f32x4 acc[2][2][4][2];
#pragma unroll
    for (int a = 0; a < 2; ++a)
#pragma unroll
        for (int b = 0; b < 2; ++b)
#pragma unroll
            for (int m = 0; m < 4; ++m)
#pragma unroll
                for (int n = 0; n < 2; ++n) acc[a][b][m][n] = (f32x4){0.f, 0.f, 0.f, 0.f};
    bf16x8 At[4][2], B0[2][2], B1[2][2];
    const char* cA = (const char*)g.A + (size_t)cur.pm * tstep; const char* cB = (const char*)g.Bt + (size_t)cur.pn * tstep;
    S.a_ready(cur);
    if constexpr (SP2) {
        PG8_STAGE(PG8_SB(0, 0), cB, voffB); PG8_STAGE(PG8_SB(0, 1), cB + hstep, voffB); PG8_STAGE(PG8_SA(0, 0), cA, voffA); PG8_STAGE(PG8_SA(0, 1), cA + hstep, voffA);
        if (wr == 1) PG8_BAR;
        PG8_WAIT_V(2); PG8_BAR;
        PG8_STAGE(PG8_SB(1, 0), cB + kstep, voffB); PG8_STAGE(PG8_SA(1, 0), cA + kstep, voffA); PG8_STAGE(PG8_SB(1, 1), cB + hstep + kstep, voffB);
        PG8_WAIT_V(6); PG8_BAR;
    } else {
        PG8_STAGE(PG8_SB(0, 0), cB, voffB); PG8_STAGE(PG8_SA(0, 0), cA, voffA); PG8_STAGE(PG8_SB(0, 1), cB + hstep, voffB); PG8_STAGE(PG8_SA(0, 1), cA + hstep, voffA);
        if (wr == 1) PG8_BAR;
        PG8_WAIT_V(4); PG8_BAR;
        PG8_STAGE(PG8_SB(1, 0), cB + kstep, voffB); PG8_STAGE(PG8_SA(1, 0), cA + kstep, voffA); PG8_STAGE(PG8_SB(1, 1), cB + hstep + kstep, voffB);
        PG8_WAIT_V(6); PG8_BAR;
    }
    for (;;) {
        const bool has_next = S.next(ui + 1, nxt);
        const char* nA = has_next ? (const char*)g.A + (size_t)nxt.pm * tstep : cA; const char* nB = has_next ? (const char*)g.Bt + (size_t)nxt.pn * tstep : cB;
        for (int t = 0; t < nt; t += 2) {
            const bool last = (t == nt - 2);
            const char* a1 = cA + (size_t)(t + 1) * kstep;
            const char* a2 = last ? nA : cA + (size_t)(t + 2) * kstep; const char* b2 = last ? nB : cB + (size_t)(t + 2) * kstep;
            const char* a3 = a2 + kstep; const char* b3 = b2 + kstep;
            if (last && has_next) S.a_ready(nxt);
            if constexpr (SP2) {
            PG8_LDB(B0, 0, 0); PG8_LDB(B1, 0, 1); PG8_SCHED; PG8_LDA(At, 0, 0); PG8_STAGE(PG8_SA(1, 1), a1 + hstep, voffA);
            PG8_WAIT_V(8); PG8_WAIT_L(0); PG8_BAR; PG8_MMA(0, 0, At, B0); PG8_MMA(0, 1, At, B1); PG8_BAR; PG8_SCHED;
            PG8_LDA(At, 0, 1); PG8_STAGE(PG8_SB(0, 0), b2, voffB); PG8_STAGE(PG8_SB(0, 1), b2 + hstep, voffB); PG8_STAGE(PG8_SA(0, 0), a2, voffA);
            PG8_WAIT_V(8); PG8_WAIT_L(0); PG8_BAR; PG8_MMA(1, 0, At, B0); PG8_MMA(1, 1, At, B1); PG8_BAR; PG8_SCHED;
            PG8_LDB(B0, 1, 0); PG8_LDB(B1, 1, 1); PG8_SCHED; PG8_LDA(At, 1, 0); PG8_STAGE(PG8_SA(0, 1), a2 + hstep, voffA);
            PG8_WAIT_V(8); PG8_WAIT_L(0); PG8_BAR; PG8_MMA(0, 0, At, B0); PG8_MMA(0, 1, At, B1); PG8_BAR; PG8_SCHED;
            PG8_LDA(At, 1, 1); PG8_STAGE(PG8_SB(1, 0), b3, voffB); PG8_STAGE(PG8_SB(1, 1), b3 + hstep, voffB); PG8_STAGE(PG8_SA(1, 0), a3, voffA);
            PG8_WAIT_V(8); PG8_WAIT_L(0); PG8_BAR; PG8_MMA(1, 0, At, B0); PG8_MMA(1, 1, At, B1); PG8_BAR; PG8_SCHED;
            } else {
            PG8_LDB(B0, 0, 0); PG8_SCHED; PG8_LDA(At, 0, 0); PG8_STAGE(PG8_SA(1, 1), a1 + hstep, voffA);
            PG8_WAIT_L(8); PG8_BAR; PG8_WAIT_L(0); PG8_MMA(0, 0, At, B0); PG8_BAR; PG8_SCHED;
            PG8_LDB(B1, 0, 1); PG8_STAGE(PG8_SB(0, 0), b2, voffB);
            PG8_BAR; PG8_WAIT_L(0); PG8_MMA(0, 1, At, B1); PG8_BAR;
            PG8_LDA(At, 0, 1); PG8_STAGE(PG8_SA(0, 0), a2, voffA);
            PG8_BAR; PG8_WAIT_L(0); PG8_MMA(1, 0, At, B0); PG8_BAR; PG8_SCHED;
            PG8_STAGE(PG8_SB(0, 1), b2 + hstep, voffB);
            PG8_WAIT_V(6); PG8_BAR; PG8_MMA(1, 1, At, B1); PG8_BAR;
            PG8_LDB(B0, 1, 0); PG8_SCHED; PG8_LDA(At, 1, 0); PG8_STAGE(PG8_SA(0, 1), a2 + hstep, voffA);
            PG8_WAIT_L(8); PG8_BAR; PG8_WAIT_L(0); PG8_MMA(0, 0, At, B0); PG8_BAR; PG8_SCHED;
            PG8_LDB(B1, 1, 1); PG8_STAGE(PG8_SB(1, 0), b3, voffB);
            PG8_BAR; PG8_WAIT_L(0); PG8_MMA(0, 1, At, B1); PG8_BAR;
            PG8_LDA(At, 1, 1); PG8_STAGE(PG8_SA(1, 0), a3, voffA);
            PG8_BAR; PG8_WAIT_L(0); PG8_MMA(1, 0, At, B0); PG8_BAR; PG8_SCHED;
            PG8_STAGE(PG8_SB(1, 1), b3 + hstep, voffB);
            PG8_WAIT_V(6); PG8_BAR; PG8_MMA(1, 1, At, B1); PG8_BAR;
            }
        }
        if constexpr (ALIGN_EPI) { if (wr == 0) PG8_BAR; }
        if constexpr (!Epi::AFTER_DRAIN) { E(acc, cur, wr, wc, fr, fq); S.done(cur); }
        if (!has_next) break;
#pragma unroll
        for (int a = 0; a < 2; ++a)
#pragma unroll
            for (int b = 0; b < 2; ++b)
#pragma unroll
                for (int m = 0; m < 4; ++m)
#pragma unroll
                    for (int n = 0; n < 2; ++n) acc[a][b][m][n] = (f32x4){0.f, 0.f, 0.f, 0.f};
        cur = nxt; cA = nA; cB = nB; ++ui;
        if constexpr (ALIGN_EPI) { if (wr == 1) PG8_BAR; }
    }
    PG8_WAIT_V(0);
    if constexpr (!ALIGN_EPI) { if (wr == 0) PG8_BAR; }
    PG8_BAR;
    if constexpr (Epi::AFTER_DRAIN) { E.fused(acc, cur, wr, wc, fr, fq, lds, wid, lane); S.done(cur); }
#undef PG8_SA
#undef PG8_SB
#undef PG8_STAGE
#undef PG8_LDA
#undef PG8_LDB
#undef PG8_MMA
#undef PG8_WAIT_V
#undef PG8_WAIT_L
#undef PG8_BAR
#undef PG8_SCHED
}
}
namespace att {
using bf16 = __hip_bfloat16;
constexpr int   D = 128, NW = 8, QBLK = 32, KVBLK = 64;
constexpr float SCALE = 0.088388347648318440f;
constexpr float THR = 8.f;
constexpr int SDEPTH = 2;
constexpr int LDQ = 1024, LDK = 1024, LDO = 1024;
constexpr size_t SHM_V = KVBLK * D * 2, SHM_K = KVBLK * D * 2, SHM_ATTN = 2 * SHM_V + 2 * SHM_K + NW * 64 * 4;
__device__ __forceinline__ unsigned short f2bf_rne(float f) { unsigned u = __float_as_uint(f); return (unsigned short)((u + 0x7fffu + ((u >> 16) & 1u)) >> 16); }
using bf16x8 = __attribute__((ext_vector_type(8))) short;
using s16x4  = __attribute__((ext_vector_type(4))) short;
using f32x16 = __attribute__((ext_vector_type(16))) float;
using f32x8  = __attribute__((ext_vector_type(8))) float;
using u32x4  = __attribute__((ext_vector_type(4))) unsigned;
#define KSWZ(row, colB) ((row) * 256 + ((colB) ^ (((row) & 7) << 4)))
#define SBAR() __builtin_amdgcn_sched_barrier(0)
__device__ __forceinline__ int crow(int r, int hi) { return (r & 3) + 8 * (r >> 2) + 4 * hi; }
__device__ __forceinline__ unsigned cvtpk(float lo, float hi) {
  unsigned r; asm volatile("v_cvt_pk_bf16_f32 %0, %1, %2" : "=v"(r) : "v"(lo), "v"(hi)); return r;
}
template <typename TIn> struct Stage;
template <> struct Stage<bf16>  { using T = bf16x8;
  __device__ static __forceinline__ T ld8(const bf16* p) { return *reinterpret_cast<const bf16x8*>(p); }
  __device__ static __forceinline__ bf16x8 tobf(T x) { return x; } };
template <> struct Stage<float> { using T = f32x8;
  __device__ static __forceinline__ T ld8(const float* p) { return *reinterpret_cast<const f32x8*>(p); }
  __device__ static __forceinline__ bf16x8 tobf(T x) {
    u32x4 w = {cvtpk(x[0], x[1]), cvtpk(x[2], x[3]), cvtpk(x[4], x[5]), cvtpk(x[6], x[7])}; return *reinterpret_cast<bf16x8*>(&w); } };

__device__ __forceinline__ void partialSM(f32x16& p0, f32x16& p1, float& m_reg, float& mn, float& alpha) {
  constexpr float C = SCALE * 1.4426950408889634f;
  float pmax = p0[0]; _Pragma("unroll") for (int r = 1; r < 16; ++r) pmax = fmaxf(pmax, p0[r]); _Pragma("unroll") for (int r = 0; r < 16; ++r) pmax = fmaxf(pmax, p1[r]);
  { auto rr = __builtin_amdgcn_permlane32_swap(__float_as_uint(pmax), __float_as_uint(pmax), false, false);
    pmax = fmaxf(__uint_as_float(rr[0]), __uint_as_float(rr[1])); }
  if (__builtin_expect(__all(pmax - m_reg <= THR / SCALE), 1)) { mn = m_reg; alpha = 1.f; }
  else { mn = fmaxf(m_reg, pmax); alpha = __builtin_amdgcn_exp2f((m_reg - mn) * C); m_reg = mn; }
  float mnC = -mn * C;
  _Pragma("unroll") for (int r = 0; r < 16; ++r) p0[r] = fmaf(p0[r], C, mnC); _Pragma("unroll") for (int r = 0; r < 16; ++r) p1[r] = fmaf(p1[r], C, mnC);
  _Pragma("unroll") for (int r = 0; r < 16; ++r) p0[r] = __builtin_amdgcn_exp2f(p0[r]);
}
__device__ __forceinline__ void finishSM(f32x16& p0, f32x16& p1, float alpha, float& l_reg, bf16x8& pa0, bf16x8& pa1, bf16x8& pa2, bf16x8& pa3) {
  _Pragma("unroll") for (int r = 0; r < 16; ++r) p1[r] = __builtin_amdgcn_exp2f(p1[r]);
  float ps = 0; _Pragma("unroll") for (int r = 0; r < 16; ++r) ps += p0[r]; _Pragma("unroll") for (int r = 0; r < 16; ++r) ps += p1[r];
  { auto rr = __builtin_amdgcn_permlane32_swap(__float_as_uint(ps), __float_as_uint(ps), false, false);
    ps = __uint_as_float(rr[0]) + __uint_as_float(rr[1]); }
  l_reg = l_reg * alpha + ps;
#define PK4(P, BASE, OUT) do { unsigned a0 = cvtpk(P[BASE + 0], P[BASE + 1]), a1 = cvtpk(P[BASE + 2], P[BASE + 3]);   \
    unsigned b0 = cvtpk(P[BASE + 4], P[BASE + 5]), b1 = cvtpk(P[BASE + 6], P[BASE + 7]);                              \
    auto r0 = __builtin_amdgcn_permlane32_swap(a0, b0, false, false); auto r1 = __builtin_amdgcn_permlane32_swap(a1, b1, false, false); \
    u32x4 w = {r0[0], r1[0], r0[1], r1[1]}; OUT = *reinterpret_cast<bf16x8*>(&w); } while (0)
  PK4(p0, 0, pa0); PK4(p0, 8, pa1); PK4(p1, 0, pa2); PK4(p1, 8, pa3);
#undef PK4
}
__device__ __forceinline__ void qkt(f32x16& p0, f32x16& p1, const bf16* Ks, const bf16x8* qr, int r32, int hi) {
  p0 = f32x16{}; p1 = f32x16{};
  _Pragma("unroll") for (int d0 = 0; d0 < 8; ++d0) { int cb = (d0 * 16 + hi * 8) * 2;
    bf16x8 b0 = *reinterpret_cast<const bf16x8*>((const char*)Ks + KSWZ(r32, cb));
    bf16x8 b1 = *reinterpret_cast<const bf16x8*>((const char*)Ks + KSWZ(32 + r32, cb));
    p0 = __builtin_amdgcn_mfma_f32_32x32x16_bf16(b0, qr[d0], p0, 0, 0, 0);
    p1 = __builtin_amdgcn_mfma_f32_32x32x16_bf16(b1, qr[d0], p1, 0, 0, 0); }
}
__device__ __forceinline__ int v_st(int k, int c) { const int kk = (k & ~0xC) | ((k & 4) << 1) | ((k & 8) >> 1); return ((kk >> 3) * 4 + (c >> 5)) * 512 + ((kk & 7) * 32 + (c & 31)) * 2; }
__device__ __forceinline__ int v_rd_base(int lane) { return ((lane & 3) << 3) | (((lane >> 2) & 3) << 6) | (((lane >> 4) & 1) << 5) | (((lane >> 5) & 1) << 8); }
constexpr int v_rd_off(int d0, int ks, int half) { return d0 * 512 + ks * 4096 + half * 2048; }
template <int OFF> __device__ __forceinline__ s16x4 tr_read(int vb) {
  s16x4 r; asm volatile("ds_read_b64_tr_b16 %0, %1 offset:%2" : "=&v"(r) : "v"(vb), "i"(OFF) : "memory"); return r;
}
template <int D0> __device__ __forceinline__ void pv_one(f32x16& od, int vb, bf16x8 pa0, bf16x8 pa1, bf16x8 pa2, bf16x8 pa3) {
  const s16x4 l0 = tr_read<v_rd_off(D0, 0, 0)>(vb), h0 = tr_read<v_rd_off(D0, 0, 1)>(vb), l1 = tr_read<v_rd_off(D0, 1, 0)>(vb), h1 = tr_read<v_rd_off(D0, 1, 1)>(vb);
  const s16x4 l2 = tr_read<v_rd_off(D0, 2, 0)>(vb), h2 = tr_read<v_rd_off(D0, 2, 1)>(vb), l3 = tr_read<v_rd_off(D0, 3, 0)>(vb), h3 = tr_read<v_rd_off(D0, 3, 1)>(vb);
  asm volatile("s_waitcnt lgkmcnt(0)" ::: "memory"); SBAR();
#define PK(L, H) (bf16x8){L[0], L[1], L[2], L[3], H[0], H[1], H[2], H[3]}
  od = __builtin_amdgcn_mfma_f32_32x32x16_bf16(pa0, PK(l0, h0), od, 0, 0, 0);
  od = __builtin_amdgcn_mfma_f32_32x32x16_bf16(pa1, PK(l1, h1), od, 0, 0, 0);
  od = __builtin_amdgcn_mfma_f32_32x32x16_bf16(pa2, PK(l2, h2), od, 0, 0, 0);
  od = __builtin_amdgcn_mfma_f32_32x32x16_bf16(pa3, PK(l3, h3), od, 0, 0, 0);
#undef PK
}
__device__ __forceinline__ void pv_d0(f32x16* o, int vb, bf16x8 pa0, bf16x8 pa1, bf16x8 pa2, bf16x8 pa3) {
  pv_one<0>(o[0], vb, pa0, pa1, pa2, pa3); pv_one<1>(o[1], vb, pa0, pa1, pa2, pa3); pv_one<2>(o[2], vb, pa0, pa1, pa2, pa3); pv_one<3>(o[3], vb, pa0, pa1, pa2, pa3);
}
__device__ __forceinline__ void attn_dense_body(const bf16* __restrict__ Qb, const bf16* __restrict__ Kh, const bf16* __restrict__ Vh,
                                                float* O1b, unsigned short* O2b, const int pass, const float lam, int seq, char* lds) {
  using St = Stage<bf16>; using SQ = Stage<bf16>;
  int tid_ = threadIdx.x; asm volatile("" : "+v"(tid_));
  const int tid = tid_, wid = tid >> 6, lane = tid & 63, r32 = lane & 31, hi = lane >> 5;
  bf16* V_lds = (bf16*)lds; bf16* K_lds = (bf16*)(lds + 2 * SHM_V);
  float* ws = (float*)(lds + 2 * SHM_V + 2 * SHM_K) + wid * 64; float* li_l = ws; float* al_l = ws + 32;
  float m_reg = -1e30f, l_reg = 0; f32x16 o[4] = {}; bf16x8 qr[8];
  const bf16* Qw = Qb + (long)(wid * QBLK + r32) * LDQ + hi * 8;
  _Pragma("unroll") for (int d0 = 0; d0 < 8; ++d0) qr[d0] = SQ::tobf(SQ::ld8(Qw + d0 * 16));
  const int sr = tid >> 4, sc = (tid & 15) * 8, vst0 = v_st(sr, sc), vst1 = v_st(32 + sr, sc);
  const int vb0 = (int)(uintptr_t)V_lds + v_rd_base(lane);
  struct { typename St::T vs0, vs1, ks0, ks1; } sr_[SDEPTH];
#define SLOAD(i, k0) do { sr_[i].vs0 = St::ld8(&Vh[(long)((k0) + sr) * LDK + sc]); sr_[i].vs1 = St::ld8(&Vh[(long)((k0) + 32 + sr) * LDK + sc]); \
    sr_[i].ks0 = St::ld8(&Kh[(long)((k0) + sr) * LDK + sc]); sr_[i].ks1 = St::ld8(&Kh[(long)((k0) + 32 + sr) * LDK + sc]); } while (0)
#define SWRITE(b, i) do { *(bf16x8*)((char*)V_lds + (b) * SHM_V + vst0) = St::tobf(sr_[i].vs0);          \
    *(bf16x8*)((char*)V_lds + (b) * SHM_V + vst1) = St::tobf(sr_[i].vs1); int kc = sc * 2;               \
    *(bf16x8*)((char*)K_lds + (b) * SHM_K + KSWZ(sr, kc)) = St::tobf(sr_[i].ks0);                       \
    *(bf16x8*)((char*)K_lds + (b) * SHM_K + KSWZ(32 + sr, kc)) = St::tobf(sr_[i].ks1); } while (0)
#define SWAIT() do { if constexpr (SDEPTH == 2) asm volatile("s_waitcnt vmcnt(4)" ::: "memory"); else asm volatile("s_waitcnt vmcnt(0)" ::: "memory"); } while (0)
#define RESC(a) do { if (__any((a) < 1.f)) { if (hi == 0) al_l[r32] = (a); asm volatile("s_waitcnt lgkmcnt(0)" ::: "memory"); \
    _Pragma("unroll") for (int d = 0; d < 4; ++d) _Pragma("unroll") for (int r = 0; r < 16; ++r) o[d][r] *= al_l[crow(r, hi)]; } } while (0)
  f32x16 pA0, pA1, pB0, pB1; float mnA, mnB, alA, alB; bf16x8 pa0, pa1, pa2, pa3; const int NT = seq / KVBLK;
  constexpr int SE = 0, SO = SDEPTH - 1;
  SLOAD(SE, 0); asm volatile("s_waitcnt vmcnt(0)" ::: "memory"); SWRITE(0, SE); __syncthreads();
  qkt(pA0, pA1, K_lds, qr, r32, hi); partialSM(pA0, pA1, m_reg, mnA, alA);
  SLOAD(SO, KVBLK); if constexpr (SDEPTH == 2) { if (2 < NT) SLOAD(SE, 2 * KVBLK); }
  SWAIT(); SWRITE(1, SO); __syncthreads();
  for (int j = 1; j + 1 < NT; j += 2) {
    SBAR(); qkt(pB0, pB1, (bf16*)((char*)K_lds + SHM_K), qr, r32, hi);
    finishSM(pA0, pA1, alA, l_reg, pa0, pa1, pa2, pa3); SBAR();
    SLOAD(SO, (j + SDEPTH) * KVBLK); SBAR();
    pv_d0(o, vb0, pa0, pa1, pa2, pa3); partialSM(pB0, pB1, m_reg, mnB, alB);
    __syncthreads(); SWAIT(); SWRITE(0, SE);
    RESC(alB); __syncthreads();
    SBAR(); qkt(pA0, pA1, K_lds, qr, r32, hi);
    finishSM(pB0, pB1, alB, l_reg, pa0, pa1, pa2, pa3); SBAR();
    if (SDEPTH == 1 || j + 3 < NT) SLOAD(SE, (j + 1 + SDEPTH) * KVBLK); SBAR();
    pv_d0(o, vb0 + (int)SHM_V, pa0, pa1, pa2, pa3); partialSM(pA0, pA1, m_reg, mnA, alA);
    __syncthreads(); SWAIT(); SWRITE(1, SO);
    RESC(alA); __syncthreads();
  }
  SBAR(); qkt(pB0, pB1, (bf16*)((char*)K_lds + SHM_K), qr, r32, hi);
  finishSM(pA0, pA1, alA, l_reg, pa0, pa1, pa2, pa3); SBAR();
  pv_d0(o, vb0, pa0, pa1, pa2, pa3); partialSM(pB0, pB1, m_reg, mnB, alB);
  __syncthreads(); RESC(alB);
  finishSM(pB0, pB1, alB, l_reg, pa0, pa1, pa2, pa3); SBAR();
  pv_d0(o, vb0 + (int)SHM_V, pa0, pa1, pa2, pa3);
  if (hi == 0) li_l[r32] = l_reg; asm volatile("s_waitcnt lgkmcnt(0)" ::: "memory");
  float rli[16];
  _Pragma("unroll") for (int r = 0; r < 16; ++r) rli[r] = __builtin_amdgcn_rcpf(li_l[crow(r, hi)]);
  float* Ow = O1b + (long)(wid * QBLK) * LDO; unsigned short* Cw = O2b + (long)(wid * QBLK) * LDO;
  _Pragma("unroll") for (int r = 0; r < 16; ++r) { int orow = crow(r, hi);
    _Pragma("unroll") for (int d0 = 0; d0 < 4; ++d0) { const long idx = (long)orow * LDO + d0 * 32 + r32; const float val = o[d0][r] * rli[r];
      if (pass == 0) Ow[idx] = val; else Cw[idx] = f2bf_rne(Ow[idx] - lam * val); } }
#undef SLOAD
#undef SWRITE
#undef SWAIT
#undef RESC
}
}
namespace att2 {
using namespace att;
constexpr int KBUF = 16384, VBUF = 32768, L_K = 0, L_V = 3 * KBUF, L_WS = 3 * KBUF + 3 * VBUF;
__device__ __forceinline__ void glds16(const void* gsrc, unsigned lds_dst) { unsigned keep;
  asm volatile("s_mov_b32 %0, m0\n\ts_mov_b32 m0, %2\n\ts_nop 0\n\tglobal_load_lds_dwordx4 %1, off\n\ts_mov_b32 m0, %0" : "=&s"(keep) : "v"(gsrc), "s"(lds_dst) : "memory"); }
constexpr int v_rd_off8(int d0, int ks, int half) { return d0 * 512 + ks * 8192 + half * 4096; }
template <int D0> __device__ __forceinline__ void pv_one8(f32x16& od, int vb, bf16x8 pa0, bf16x8 pa1, bf16x8 pa2, bf16x8 pa3) {
  const s16x4 l0 = tr_read<v_rd_off8(D0, 0, 0)>(vb), h0 = tr_read<v_rd_off8(D0, 0, 1)>(vb), l1 = tr_read<v_rd_off8(D0, 1, 0)>(vb), h1 = tr_read<v_rd_off8(D0, 1, 1)>(vb);
  const s16x4 l2 = tr_read<v_rd_off8(D0, 2, 0)>(vb), h2 = tr_read<v_rd_off8(D0, 2, 1)>(vb), l3 = tr_read<v_rd_off8(D0, 3, 0)>(vb), h3 = tr_read<v_rd_off8(D0, 3, 1)>(vb);
  asm volatile("s_waitcnt lgkmcnt(0)" ::: "memory"); SBAR();
#define PK(L, H) (bf16x8){L[0], L[1], L[2], L[3], H[0], H[1], H[2], H[3]}
  od = __builtin_amdgcn_mfma_f32_32x32x16_bf16(pa0, PK(l0, h0), od, 0, 0, 0);
  od = __builtin_amdgcn_mfma_f32_32x32x16_bf16(pa1, PK(l1, h1), od, 0, 0, 0);
  od = __builtin_amdgcn_mfma_f32_32x32x16_bf16(pa2, PK(l2, h2), od, 0, 0, 0);
  od = __builtin_amdgcn_mfma_f32_32x32x16_bf16(pa3, PK(l3, h3), od, 0, 0, 0);
#undef PK
}
__device__ __forceinline__ void attn256_body(const bf16* __restrict__ Qb, const bf16* __restrict__ Kh, const bf16* __restrict__ Vh, float* O1b, unsigned short* O2b,
                                             const int pass, const float lam, int seq, char* lds) {
  int tid_ = threadIdx.x; asm volatile("" : "+v"(tid_));
  const int tid = tid_, lane = tid & 63, r32 = lane & 31, hi = lane >> 5; const int wid = __builtin_amdgcn_readfirstlane(tid >> 6);
  const unsigned lds0 = (unsigned)(uintptr_t)lds;
  float* ws = (float*)(lds + L_WS) + wid * 64; float* li_l = ws; float* al_l = ws + 32;
  float m_reg = -1e30f, l_reg = 0; f32x16 o[8] = {}; bf16x8 qr[8];
  const bf16* Qw = Qb + (long)(wid * QBLK + r32) * LDQ + hi * 8;
  _Pragma("unroll") for (int d0 = 0; d0 < 8; ++d0) qr[d0] = *reinterpret_cast<const bf16x8*>(Qw + d0 * 16);
  long ksrc[2], vsrc[4];
  _Pragma("unroll") for (int p = 0; p < 2; ++p) { const int q = wid * 2 + p, row = 4 * q + (lane >> 4), c = (lane & 15) ^ (row & 7); ksrc[p] = (long)row * LDK + c * 8; }
  _Pragma("unroll") for (int p = 0; p < 4; ++p) { const int q = wid * 4 + p, s = 2 * q + (lane >> 5), kgrp = s >> 3, cb = s & 7, rowin = (lane & 31) >> 2, chunk = lane & 3;
    const int kk = kgrp * 8 + rowin, key = (kk & ~0xC) | ((kk & 4) << 1) | ((kk & 8) >> 1); vsrc[p] = (long)key * LDK + cb * 32 + chunk * 8; }
#define DMA_TILE(t, kb, vo) do { const bf16* kt_ = Kh + (long)(t) * KVBLK * LDK; const bf16* vt_ = Vh + (long)(t) * KVBLK * LDK; \
    _Pragma("unroll") for (int p = 0; p < 2; ++p) glds16(kt_ + ksrc[p], (unsigned)__builtin_amdgcn_readfirstlane(lds0 + L_K + (kb) * KBUF + (wid * 2 + p) * 1024)); \
    _Pragma("unroll") for (int p = 0; p < 4; ++p) glds16(vt_ + vsrc[p], (unsigned)__builtin_amdgcn_readfirstlane(lds0 + L_V + (vo) + (wid * 4 + p) * 1024)); } while (0)
#define PV_RD(S, D0) do { S##l0 = tr_read<v_rd_off8(D0, 0, 0)>(vb); S##h0 = tr_read<v_rd_off8(D0, 0, 1)>(vb); S##l1 = tr_read<v_rd_off8(D0, 1, 0)>(vb); S##h1 = tr_read<v_rd_off8(D0, 1, 1)>(vb); \
    S##l2 = tr_read<v_rd_off8(D0, 2, 0)>(vb); S##h2 = tr_read<v_rd_off8(D0, 2, 1)>(vb); S##l3 = tr_read<v_rd_off8(D0, 3, 0)>(vb); S##h3 = tr_read<v_rd_off8(D0, 3, 1)>(vb); } while (0)
#define PV_PK(L, H) (bf16x8){L[0], L[1], L[2], L[3], H[0], H[1], H[2], H[3]}
#define PV_MM(S, D0) do { o[D0] = __builtin_amdgcn_mfma_f32_32x32x16_bf16(pa0, PV_PK(S##l0, S##h0), o[D0], 0, 0, 0); o[D0] = __builtin_amdgcn_mfma_f32_32x32x16_bf16(pa1, PV_PK(S##l1, S##h1), o[D0], 0, 0, 0); \
    o[D0] = __builtin_amdgcn_mfma_f32_32x32x16_bf16(pa2, PV_PK(S##l2, S##h2), o[D0], 0, 0, 0); o[D0] = __builtin_amdgcn_mfma_f32_32x32x16_bf16(pa3, PV_PK(S##l3, S##h3), o[D0], 0, 0, 0); } while (0)
#define PV_W8() do { asm volatile("s_waitcnt lgkmcnt(8)" ::: "memory"); SBAR(); } while (0)
#define PV_W0() do { asm volatile("s_waitcnt lgkmcnt(0)" ::: "memory"); SBAR(); } while (0)
#define PV8(vb_) do { const int vb = (vb_); s16x4 Al0, Ah0, Al1, Ah1, Al2, Ah2, Al3, Ah3, Bl0, Bh0, Bl1, Bh1, Bl2, Bh2, Bl3, Bh3; \
    PV_RD(A, 0); PV_RD(B, 1); PV_W8(); PV_MM(A, 0); SBAR(); PV_RD(A, 2); PV_W8(); PV_MM(B, 1); SBAR(); PV_RD(B, 3); PV_W8(); PV_MM(A, 2); SBAR(); PV_RD(A, 4); PV_W8(); PV_MM(B, 3); SBAR(); \
    PV_RD(B, 5); PV_W8(); PV_MM(A, 4); SBAR(); PV_RD(A, 6); PV_W8(); PV_MM(B, 5); SBAR(); PV_RD(B, 7); PV_W8(); PV_MM(A, 6); SBAR(); PV_W0(); PV_MM(B, 7); } while (0)
  const int vb0 = (int)lds0 + L_V + v_rd_base(lane);
  const int NT = seq / KVBLK;
  bf16x8 pa0, pa1, pa2, pa3;
  DMA_TILE(0, 0, 0); if (NT > 1) DMA_TILE(1, 1, VBUF);
  int scur = 0, snext2 = 2;
  for (int j = 0; j < NT; ++j) {
    if (j + 1 < NT) asm volatile("s_waitcnt vmcnt(6) lgkmcnt(0)\n\ts_barrier" ::: "memory");
    else            asm volatile("s_waitcnt vmcnt(0) lgkmcnt(0)\n\ts_barrier" ::: "memory");
    if (j + 2 < NT) DMA_TILE(j + 2, snext2, snext2 * VBUF);
    f32x16 p0, p1; float mn, alpha;
    qkt(p0, p1, (const bf16*)(lds + L_K + scur * KBUF), qr, r32, hi);
    partialSM(p0, p1, m_reg, mn, alpha);
    if (__any(alpha < 1.f)) { if (hi == 0) al_l[r32] = alpha; asm volatile("s_waitcnt lgkmcnt(0)" ::: "memory");
      _Pragma("unroll") for (int d = 0; d < 8; ++d) _Pragma("unroll") for (int r = 0; r < 16; ++r) o[d][r] *= al_l[crow(r, hi)]; }
    finishSM(p0, p1, alpha, l_reg, pa0, pa1, pa2, pa3); SBAR();
    PV8(vb0 + scur * VBUF);
    scur = (scur == 2) ? 0 : scur + 1; snext2 = (snext2 == 2) ? 0 : snext2 + 1;
  }
#undef PV8
#undef PV_RD
#undef PV_PK
#undef PV_MM
#undef PV_W8
#undef PV_W0
#undef DMA_TILE
  if (hi == 0) li_l[r32] = l_reg; asm volatile("s_waitcnt lgkmcnt(0)" ::: "memory");
  float rli[16];
  _Pragma("unroll") for (int r = 0; r < 16; ++r) rli[r] = __builtin_amdgcn_rcpf(li_l[crow(r, hi)]);
  float* Ow = O1b + (long)(wid * QBLK) * LDO; unsigned short* Cw = O2b + (long)(wid * QBLK) * LDO;
  if (pass == 0) {
    _Pragma("unroll") for (int r = 0; r < 16; ++r) { const int orow = crow(r, hi);
      _Pragma("unroll") for (int d0 = 0; d0 < 8; ++d0) Ow[(long)orow * LDO + d0 * 32 + r32] = o[d0][r] * rli[r]; }
  } else {
    _Pragma("unroll") for (int r = 0; r < 16; r += 8) { float o1[8][8];
      _Pragma("unroll") for (int k = 0; k < 8; ++k) _Pragma("unroll") for (int d0 = 0; d0 < 8; ++d0) o1[k][d0] = Ow[(long)crow(r + k, hi) * LDO + d0 * 32 + r32];
      _Pragma("unroll") for (int k = 0; k < 8; ++k) _Pragma("unroll") for (int d0 = 0; d0 < 8; ++d0) Cw[(long)crow(r + k, hi) * LDO + d0 * 32 + r32] = f2bf_rne(o1[k][d0] - lam * (o[d0][r + k] * rli[r + k])); }
  }
  asm volatile("s_waitcnt lgkmcnt(0)\n\ts_barrier" ::: "memory");
}
}
typedef unsigned short bf16_t;
typedef float f32x4 __attribute__((ext_vector_type(4)));
typedef unsigned u32x4 __attribute__((ext_vector_type(4)));
typedef unsigned u32x2 __attribute__((ext_vector_type(2)));
constexpr int DM = 1024, SEQ = 4096, NBATCH = 16, NTOK = NBATCH * SEQ;
constexpr int NGRP = 2, GB = NBATCH / NGRP, TG = GB * SEQ;
constexpr int INW = 8224, NIN = 8448;
constexpr int FFH = 2816, NFI = 2 * FFH;
constexpr float EPS = 1e-6f, SUBLN_EPS = 1e-5f, LAMBDA_INIT = 0.2f;
constexpr size_t MiB = 1u << 20;
constexpr size_t WS_CTL = 0;
constexpr size_t WS_SS1 = 4096, WS_SS2 = 4096 + 262144;
constexpr size_t WS_BAR = 768 * 1024, WS_BAR_BYTES = 16384;
constexpr size_t WS_ROPE = 1 * MiB;
constexpr size_t WS_WIN = 4 * MiB;
constexpr size_t WS_WOUT = 21 * MiB;
constexpr size_t WS_WFI = 23 * MiB;
constexpr size_t WS_WFO = 34 * MiB;
constexpr size_t WS_MERGED = 40 * MiB;
constexpr size_t WS_U = 168 * MiB;
constexpr size_t WS_GQ = 296 * MiB, WS_GK = 328 * MiB, WS_GV = 360 * MiB, WS_GR = 424 * MiB, WS_DQ = 488 * MiB, WS_DK = 552 * MiB, WS_DV = 616 * MiB,
                 WS_GA = 680 * MiB, WS_GB = 744 * MiB, WS_GLR = 808 * MiB;
constexpr size_t WS_OF = 812 * MiB, WS_OB = 876 * MiB, WS_O2C = 940 * MiB, WS_DEC = 1004 * MiB, WS_END = 1006 * MiB;
constexpr size_t OUT_QT = 128 * MiB, OUT_KST = 192 * MiB;
constexpr size_t WS_H1B = 296 * MiB, WS_ACT = 424 * MiB;
static_assert(WS_ACT + (size_t)NTOK * FFH * 2 <= WS_GLR, "tail overlay");
constexpr int LDS_BYTES = 151552;
constexpr int NPHASE = 13;

__device__ __forceinline__ float bf2f(unsigned short b) { return __uint_as_float((unsigned)b << 16); }
__device__ __forceinline__ unsigned short f2bf(float f) { return (unsigned short)pg8::cvt_pk_bf16(f, f); }
__device__ __forceinline__ unsigned pk2(float lo, float hi) { return pg8::cvt_pk_bf16(lo, hi); }
__device__ __forceinline__ float wave_sum(float v) {
#pragma unroll
    for (int o = 1; o < 64; o <<= 1) v += __shfl_xor(v, o);
    return v;
}
__device__ __forceinline__ float sigmoidf_(float x) { return __builtin_amdgcn_rcpf(1.f + __expf(-x)); }

struct EpiIn {
    static constexpr bool PERM = true, AFTER_DRAIN = false;
    bf16_t *GQ, *GK, *GV, *GR, *DQ, *DK, *DV, *GA, *GB; float* GLR; const float* rope;
    __device__ __forceinline__ void operator()(const pg8::f32x4 (&acc)[2][2][4][2], const pg8::Unit& u, int wr, int wc, int fr, int fq) const {
        const int pn = u.pn; const int row0 = u.pm * 256 + wr * 64 + fr;
        if (pn == 32) {
            if (wc == 0) {
#pragma unroll
                for (int ai = 0; ai < 2; ++ai)
#pragma unroll
                    for (int m = 0; m < 4; ++m) { float* p = GLR + (size_t)(row0 + ai * 128 + m * 16) * 32 + 8 * fq;
                        *(f32x4*)p = acc[ai][0][m][0]; *(f32x4*)(p + 4) = acc[ai][0][m][1]; }
            }
            return;
        }
        if (pn >= 12 && pn < 20) {
            bf16_t* base = (pn < 16) ? DQ : DK; const int colt = ((pn - 12) & 3) * 256 + (wc >> 1) * 128; const int i0 = (wc & 1) * 32 + 8 * fq;
#pragma unroll
            for (int ai = 0; ai < 2; ++ai) {
                f32x4 tb[4][4];
#pragma unroll
                for (int m = 0; m < 4; ++m) { const int pos = (row0 + ai * 128 + m * 16) & (SEQ - 1); const f32x4* cs = (const f32x4*)(rope + ((size_t)pos * 64 + i0) * 2);
                    tb[m][0] = cs[0]; tb[m][1] = cs[1]; tb[m][2] = cs[2]; tb[m][3] = cs[3]; }
#pragma unroll
                for (int m = 0; m < 4; ++m) { const int row = row0 + ai * 128 + m * 16;
                    const f32x4 t0 = tb[m][0], t1 = tb[m][1], t2 = tb[m][2], t3 = tb[m][3];
                    const f32x4 xa = acc[ai][0][m][0], xb = acc[ai][0][m][1], ya = acc[ai][1][m][0], yb = acc[ai][1][m][1];
                    u32x4 w1, w2;
                    w1.x = pg8::cvt_pk_bf16(xa[0] * t0[0] - ya[0] * t0[1], xa[1] * t0[2] - ya[1] * t0[3]);
                    w1.y = pg8::cvt_pk_bf16(xa[2] * t1[0] - ya[2] * t1[1], xa[3] * t1[2] - ya[3] * t1[3]);
                    w1.z = pg8::cvt_pk_bf16(xb[0] * t2[0] - yb[0] * t2[1], xb[1] * t2[2] - yb[1] * t2[3]);
                    w1.w = pg8::cvt_pk_bf16(xb[2] * t3[0] - yb[2] * t3[1], xb[3] * t3[2] - yb[3] * t3[3]);
                    w2.x = pg8::cvt_pk_bf16(ya[0] * t0[0] + xa[0] * t0[1], ya[1] * t0[2] + xa[1] * t0[3]);
                    w2.y = pg8::cvt_pk_bf16(ya[2] * t1[0] + xa[2] * t1[1], ya[3] * t1[2] + xa[3] * t1[3]);
                    w2.z = pg8::cvt_pk_bf16(yb[0] * t2[0] + xb[0] * t2[1], yb[1] * t2[2] + xb[1] * t2[3]);
                    w2.w = pg8::cvt_pk_bf16(yb[2] * t3[0] + xb[2] * t3[1], yb[3] * t3[2] + xb[3] * t3[3]);
                    bf16_t* rp = base + (size_t)row * 1024 + colt + i0;
                    *(u32x4*)rp = w1; *(u32x4*)(rp + 64) = w2; } }
            return;
        }
        bf16_t* base; int ld, colt;
        if (pn < 2) { base = GQ; ld = 512; colt = pn * 256; }
        else if (pn < 4) { base = GK; ld = 512; colt = (pn - 2) * 256; }
        else if (pn < 8) { base = GV; ld = 1024; colt = (pn - 4) * 256; }
        else if (pn < 12) { base = GR; ld = 1024; colt = (pn - 8) * 256; }
        else if (pn < 24) { base = DV; ld = 1024; colt = (pn - 20) * 256; }
        else if (pn < 28) { base = GA; ld = 1024; colt = (pn - 24) * 256; }
        else { base = GB; ld = 1024; colt = (pn - 28) * 256; }
        const int col0 = colt + wc * 32 + 8 * fq;
#pragma unroll
        for (int ai = 0; ai < 2; ++ai)
#pragma unroll
            for (int m = 0; m < 4; ++m) { bf16_t* rowp = base + (size_t)(row0 + ai * 128 + m * 16) * ld + col0;
#pragma unroll
                for (int bj = 0; bj < 2; ++bj) { const f32x4 v0 = acc[ai][bj][m][0], v1 = acc[ai][bj][m][1]; u32x4 w;
                    w.x = pg8::cvt_pk_bf16(v0[0], v0[1]); w.y = pg8::cvt_pk_bf16(v0[2], v0[3]); w.z = pg8::cvt_pk_bf16(v1[0], v1[1]); w.w = pg8::cvt_pk_bf16(v1[2], v1[3]);
                    *(u32x4*)(rowp + bj * 128) = w; } }
    }
};
struct EpiOutProj {
    static constexpr bool PERM = true, AFTER_DRAIN = false;
    const float* base; bf16_t* hb; float* ss;
    __device__ __forceinline__ void operator()(const pg8::f32x4 (&acc)[2][2][4][2], const pg8::Unit& u, int wr, int wc, int fr, int fq) const {
        const int row0 = u.pm * 256 + wr * 64 + fr; const int col0 = u.pn * 256 + wc * 32 + 8 * fq;
#pragma unroll
        for (int ai = 0; ai < 2; ++ai) {
            f32x4 xb[4][2][2];
#pragma unroll
            for (int m = 0; m < 4; ++m) { const size_t off = (size_t)(row0 + ai * 128 + m * 16) * 1024 + col0;
#pragma unroll
                for (int bj = 0; bj < 2; ++bj) { xb[m][bj][0] = *(const f32x4*)(base + off + bj * 128); xb[m][bj][1] = *(const f32x4*)(base + off + bj * 128 + 4); } }
#pragma unroll
            for (int m = 0; m < 4; ++m) { const int row = row0 + ai * 128 + m * 16; const size_t off = (size_t)row * 1024 + col0; float s = 0.f;
#pragma unroll
                for (int bj = 0; bj < 2; ++bj) {
                    const f32x4 b0 = xb[m][bj][0], b1 = xb[m][bj][1];
                    const f32x4 h0 = b0 + acc[ai][bj][m][0], h1 = b1 + acc[ai][bj][m][1];
                    s += (h0[0] * h0[0] + h0[1] * h0[1]) + (h0[2] * h0[2] + h0[3] * h0[3]) + (h1[0] * h1[0] + h1[1] * h1[1]) + (h1[2] * h1[2] + h1[3] * h1[3]);
                    u32x4 w; w.x = pg8::cvt_pk_bf16(h0[0], h0[1]); w.y = pg8::cvt_pk_bf16(h0[2], h0[3]); w.z = pg8::cvt_pk_bf16(h1[0], h1[1]); w.w = pg8::cvt_pk_bf16(h1[2], h1[3]);
                    *(u32x4*)(hb + off + bj * 128) = w;
                }
                s += __shfl_xor(s, 16); s += __shfl_xor(s, 32);
                if (fq == 0) atomicAdd(ss + row, s); } }
    }
};
struct EpiFfnOut {
    static constexpr bool PERM = true, AFTER_DRAIN = false;
    const bf16_t* hb; bf16_t* out; float* ss;
    __device__ __forceinline__ void operator()(const pg8::f32x4 (&acc)[2][2][4][2], const pg8::Unit& u, int wr, int wc, int fr, int fq) const {
        const int row0 = u.pm * 256 + wr * 64 + fr; const int col0 = u.pn * 256 + wc * 32 + 8 * fq;
#pragma unroll
        for (int ai = 0; ai < 2; ++ai) {
            u32x4 hq[4][2];
#pragma unroll
            for (int m = 0; m < 4; ++m) { const size_t off = (size_t)(row0 + ai * 128 + m * 16) * 1024 + col0; hq[m][0] = *(const u32x4*)(hb + off); hq[m][1] = *(const u32x4*)(hb + off + 128); }
#pragma unroll
            for (int m = 0; m < 4; ++m) { const int row = row0 + ai * 128 + m * 16; const size_t off = (size_t)row * 1024 + col0; float s = 0.f;
#pragma unroll
                for (int bj = 0; bj < 2; ++bj) {
                    const u32x4 hw = hq[m][bj];
                    f32x4 h0, h1;
                    h0[0] = __uint_as_float(hw.x << 16) + acc[ai][bj][m][0][0]; h0[1] = __uint_as_float(hw.x & 0xffff0000u) + acc[ai][bj][m][0][1];
                    h0[2] = __uint_as_float(hw.y << 16) + acc[ai][bj][m][0][2]; h0[3] = __uint_as_float(hw.y & 0xffff0000u) + acc[ai][bj][m][0][3];
                    h1[0] = __uint_as_float(hw.z << 16) + acc[ai][bj][m][1][0]; h1[1] = __uint_as_float(hw.z & 0xffff0000u) + acc[ai][bj][m][1][1];
                    h1[2] = __uint_as_float(hw.w << 16) + acc[ai][bj][m][1][2]; h1[3] = __uint_as_float(hw.w & 0xffff0000u) + acc[ai][bj][m][1][3];
                    { u32x4 w; w.x = pg8::cvt_pk_bf16(h0[0], h0[1]); w.y = pg8::cvt_pk_bf16(h0[2], h0[3]); w.z = pg8::cvt_pk_bf16(h1[0], h1[1]); w.w = pg8::cvt_pk_bf16(h1[2], h1[3]); *(u32x4*)(out + off + bj * 128) = w; }
                    s += (h0[0] * h0[0] + h0[1] * h0[1]) + (h0[2] * h0[2] + h0[3] * h0[3]) + (h1[0] * h1[0] + h1[1] * h1[1]) + (h1[2] * h1[2] + h1[3] * h1[3]);
                }
                s += __shfl_xor(s, 16); s += __shfl_xor(s, 32);
                if (fq == 0) atomicAdd(ss + row, s); } }
    }
};
struct EpiFfnIn {
    static constexpr bool PERM = true, AFTER_DRAIN = false;
    const float* ss; bf16_t* act;
    __device__ __forceinline__ void operator()(const pg8::f32x4 (&acc)[2][2][4][2], const pg8::Unit& u, int wr, int wc, int fr, int fq) const {
        const int row0 = u.pm * 256 + wr * 64 + fr; const int col0 = u.pn * 128 + wc * 32 + 8 * fq;
        float rsv[2][4];
#pragma unroll
        for (int ai = 0; ai < 2; ++ai)
#pragma unroll
            for (int m = 0; m < 4; ++m) rsv[ai][m] = ss[row0 + ai * 128 + m * 16];
#pragma unroll
        for (int ai = 0; ai < 2; ++ai)
#pragma unroll
            for (int m = 0; m < 4; ++m) { const int row = row0 + ai * 128 + m * 16; const float rstd = rsqrtf(rsv[ai][m] * (1.f / 1024.f) + EPS);
                float o[8];
#pragma unroll
                for (int n = 0; n < 2; ++n)
#pragma unroll
                    for (int e = 0; e < 4; ++e) { const float g = acc[ai][0][m][n][e] * rstd, up = acc[ai][1][m][n][e] * rstd; o[n * 4 + e] = g * sigmoidf_(g) * up; }
                u32x4 w; w.x = pg8::cvt_pk_bf16(o[0], o[1]); w.y = pg8::cvt_pk_bf16(o[2], o[3]); w.z = pg8::cvt_pk_bf16(o[4], o[5]); w.w = pg8::cvt_pk_bf16(o[6], o[7]);
                *(u32x4*)(act + (size_t)row * FFH + col0) = w; }
    }
};

namespace gla {
#define LBAR() do { asm volatile("s_waitcnt lgkmcnt(0)" ::: "memory"); __builtin_amdgcn_s_barrier(); asm volatile("" ::: "memory"); } while (0)
using att::bf16x8; using att::f32x16;
constexpr int LQ = 136, LV = 72;
__device__ __forceinline__ int crow(int r, int hi) { return (r & 3) + 8 * (r >> 2) + 4 * hi; }
constexpr int P_QT = 0, P_KT = 17408, P_GLR = 34816, P_SEG = 38912;
struct Raw { unsigned qv[8], kv[8]; f32x4 gl; };
struct Wd { float wa[16], wb[16]; float ba, bb; };
#define PREP_LOAD(R, item) do { const int dir_ = (item) & 1, h_ = ((item) >> 1) & 3, c_ = ((item) >> 3) & 63, bl_ = (item) >> 9; \
        const long rowb_ = (long)bl_ * SEQ; const int sgn_ = dir_ ? -1 : 1; const int t0_ = dir_ ? (SEQ - 1 - c_ * 64) : c_ * 64; \
        _Pragma("unroll") for (int ii = 0; ii < 8; ++ii) { const long row = rowb_ + t0_ + sgn_ * (seg * 8 + ii); R.qv[ii] = *(const unsigned*)(GQ + row * 512 + h_ * 128 + 2 * d); R.kv[ii] = *(const unsigned*)(GK + row * 512 + h_ * 128 + 2 * d); } \
        if (tid < 256) { const int i = tid >> 2, r4 = tid & 3; R.gl = *(const f32x4*)(GLR + (rowb_ + t0_ + sgn_ * i) * 32 + dir_ * 16 + r4 * 4); } \
        } while (0)
#define PREP_LOADW(W, item) do { const int dir_ = (item) & 1, h_ = ((item) >> 1) & 3; \
        _Pragma("unroll") for (int r = 0; r < 16; ++r) { W.wa[r] = w2g[(dir_ * 16 + r) * 512 + h_ * 128 + 2 * d]; W.wb[r] = w2g[(dir_ * 16 + r) * 512 + h_ * 128 + 2 * d + 1]; } \
        W.ba = bg[dir_ * 512 + h_ * 128 + 2 * d]; W.bb = bg[dir_ * 512 + h_ * 128 + 2 * d + 1]; } while (0)
__device__ __forceinline__ void prep_compute(const Raw& R, const Wd& W, const int it, bf16_t* QT, bf16_t* KST, float* DEC, bf16_t* AM, char* lds,
                                             const int tid, const int lane, const int wid, const int r32, const int hi, const int d, const int seg) {
    bf16_t* Qt = (bf16_t*)(lds + P_QT); bf16_t* Kt = (bf16_t*)(lds + P_KT);
    float* glr_s = (float*)(lds + P_GLR); float* segsum = (float*)(lds + P_SEG);
    typedef float f32x2_ __attribute__((ext_vector_type(2)));
        const int dir = it & 1, h = (it >> 1) & 3, c = (it >> 3) & 63, bl = it >> 9;
        const long rowb = (long)bl * SEQ;
        const size_t cidx = (((size_t)dir * GB + bl) * 4 + h) * 64 + c;
        if (tid < 256) *(f32x4*)(glr_s + (tid >> 2) * 16 + (tid & 3) * 4) = R.gl;
        LBAR();
        float csa[8], csb[8]; float runa = 0.f, runb = 0.f;
#pragma unroll
        for (int ii = 0; ii < 8; ++ii) { const f32x4* gp = (const f32x4*)(glr_s + (seg * 8 + ii) * 16); float la = W.ba, lb = W.bb;
#pragma unroll
            for (int r4 = 0; r4 < 4; ++r4) { const f32x4 gv = gp[r4];
                la += gv[0] * W.wa[4 * r4] + gv[1] * W.wa[4 * r4 + 1] + gv[2] * W.wa[4 * r4 + 2] + gv[3] * W.wa[4 * r4 + 3];
                lb += gv[0] * W.wb[4 * r4] + gv[1] * W.wb[4 * r4 + 1] + gv[2] * W.wb[4 * r4 + 2] + gv[3] * W.wb[4 * r4 + 3]; }
            const float sa = fminf(la, 0.f) - __logf(1.f + __expf(-fabsf(la))), sb = fminf(lb, 0.f) - __logf(1.f + __expf(-fabsf(lb)));
            runa += sa * (1.f / 16.f); runb += sb * (1.f / 16.f); csa[ii] = runa; csb[ii] = runb; }
        *(f32x2_*)(segsum + seg * 128 + 2 * d) = (f32x2_){runa, runb};
        LBAR();
        float prea = 0.f, preb = 0.f, tota = 0.f, totb = 0.f;
#pragma unroll
        for (int s = 0; s < 8; ++s) { const f32x2_ x = *(const f32x2_*)(segsum + s * 128 + 2 * d); tota += x[0]; totb += x[1]; if (s < seg) { prea += x[0]; preb += x[1]; } }
        const float etota = __expf(tota), etotb = __expf(totb);
        bf16_t* qtg = QT + ((size_t)dir * TG + rowb + c * 64 + seg * 8) * 512 + h * 128 + 2 * d;
        float ksa[8], ksb[8];
#pragma unroll
        for (int ii = 0; ii < 8; ++ii) {
            const float ba = csa[ii] + prea, bb = csb[ii] + preb; const float ea = __expf(ba), eb = __expf(bb); const float ia = __builtin_amdgcn_rcpf(ea), ib_ = __builtin_amdgcn_rcpf(eb);
            const float qa = __uint_as_float(R.qv[ii] << 16), qb = __uint_as_float(R.qv[ii] & 0xffff0000u), ka = __uint_as_float(R.kv[ii] << 16), kb = __uint_as_float(R.kv[ii] & 0xffff0000u);
            const unsigned qw = pg8::cvt_pk_bf16(qa * 0.08838834764831845f * ea, qb * 0.08838834764831845f * eb);
            const unsigned kw = pg8::cvt_pk_bf16(ka * ia, kb * ib_);
            ksa[ii] = ka * etota * ia; ksb[ii] = kb * etotb * ib_;
            const int i = seg * 8 + ii;
            *(unsigned*)(Qt + i * LQ + 2 * d) = qw; *(unsigned*)(Kt + i * LQ + 2 * d) = kw;
            *(unsigned*)(qtg + (size_t)ii * 512) = qw; }
        { bf16_t* kp = KST + cidx * 8192 + (2 * d) * 64 + seg * 8;
          *(u32x4*)kp = (u32x4){pg8::cvt_pk_bf16(ksa[0], ksa[1]), pg8::cvt_pk_bf16(ksa[2], ksa[3]), pg8::cvt_pk_bf16(ksa[4], ksa[5]), pg8::cvt_pk_bf16(ksa[6], ksa[7])};
          *(u32x4*)(kp + 64) = (u32x4){pg8::cvt_pk_bf16(ksb[0], ksb[1]), pg8::cvt_pk_bf16(ksb[2], ksb[3]), pg8::cvt_pk_bf16(ksb[4], ksb[5]), pg8::cvt_pk_bf16(ksb[6], ksb[7])}; }
        if (seg == 0) *(f32x2_*)(DEC + cidx * 128 + 2 * d) = (f32x2_){etota, etotb};
        LBAR();
        if (wid < 3) {
            const int ib = wid > 0 ? 1 : 0, jb = wid == 2 ? 1 : 0; f32x16 a = {};
#pragma unroll
            for (int k0 = 0; k0 < 128; k0 += 16) { const bf16x8 A = *(const bf16x8*)(Qt + (ib * 32 + r32) * LQ + k0 + hi * 8); const bf16x8 B = *(const bf16x8*)(Kt + (jb * 32 + r32) * LQ + k0 + hi * 8);
                a = __builtin_amdgcn_mfma_f32_32x32x16_bf16(A, B, a, 0, 0, 0); }
            bf16_t* ap = AM + cidx * 4096;
#pragma unroll
            for (int r = 0; r < 16; ++r) { const int i = ib * 32 + crow(r, hi), j = jb * 32 + r32; ap[i * 64 + j] = f2bf(j <= i ? a[r] : 0.f); }
        } else if (wid == 3) {
            bf16_t* ap = AM + cidx * 4096;
#pragma unroll
            for (int r = 0; r < 16; ++r) ap[crow(r, hi) * 64 + 32 + r32] = 0;
        }
        LBAR();
}
__device__ __forceinline__ void prep_phase(int vcu, int G, int nitems, const bf16_t* GQ, const bf16_t* GK, const float* GLR, const float* w2g, const float* bg,
                                           bf16_t* QT, bf16_t* KST, float* DEC, bf16_t* AM, char* lds) {
    int tid_ = threadIdx.x; asm volatile("" : "+v"(tid_)); const int tid = tid_, lane = tid & 63, wid = tid >> 6, r32 = lane & 31, hi = lane >> 5;
    const int d = tid & 63, seg = tid >> 6;
    int it = vcu; if (it >= nitems) return;
    Raw RA, RB; RA.gl = (f32x4){0.f, 0.f, 0.f, 0.f}; RB.gl = RA.gl;
    PREP_LOAD(RA, it);
    Wd W; int whd = it & 7; PREP_LOADW(W, it);
    for (;;) {
        { const int nx = it + G; if (nx < nitems) PREP_LOAD(RB, nx); prep_compute(RA, W, it, QT, KST, DEC, AM, lds, tid, lane, wid, r32, hi, d, seg); it = nx; if (it >= nitems) break; if ((it & 7) != whd) { whd = it & 7; PREP_LOADW(W, it); } }
        { const int nx = it + G; if (nx < nitems) PREP_LOAD(RA, nx); prep_compute(RB, W, it, QT, KST, DEC, AM, lds, tid, lane, wid, r32, hi, d, seg); it = nx; if (it >= nitems) break; if ((it & 7) != whd) { whd = it & 7; PREP_LOADW(W, it); } }
    }
    LBAR();
}
#undef PREP_LOAD
#undef PREP_LOADW
constexpr int S_ST = 0, S_QT = 17408, S_KST = 34816, S_AM = 53248, S_VT = 62464, S_DC = 71680;
struct Pre { u32x4 q0, q1, k0, k1, am, vr; float dcv; };
__device__ __forceinline__ void scan_item(int item, const bf16_t* GV, const bf16_t* QT, const bf16_t* KST, const float* DEC, const bf16_t* AM, bf16_t* OF, bf16_t* OB, char* lds) {
    int tid_ = threadIdx.x; asm volatile("" : "+v"(tid_)); const int tid = tid_, lane = tid & 63, wid = tid >> 6, r32 = lane & 31, hi = lane >> 5;
    const int vs = item & 3, dir = (item >> 2) & 1, h = (item >> 3) & 3, bl = item >> 5;
    bf16_t* St = (bf16_t*)(lds + S_ST); bf16_t* Qs = (bf16_t*)(lds + S_QT); bf16_t* Ks = (bf16_t*)(lds + S_KST); bf16_t* As = (bf16_t*)(lds + S_AM);
    bf16_t* Vt = (bf16_t*)(lds + S_VT); float* dcs = (float*)(lds + S_DC);
    for (int i = tid; i < 64 * LQ / 2; i += 512) ((unsigned*)St)[i] = 0u;
    f32x16 Sacc = {};
    const int db = wid >> 1, vb = wid & 1, ib = (wid >> 1) & 1, ov = wid & 1;
    bf16_t* Oout = (dir ? OB : OF) + h * 256 + vs * 64 + ov * 32 + r32;
    const long rowb = (long)bl * SEQ; const int sgn = dir ? -1 : 1;
    const int vj = tid & 63, vg = tid >> 6;
    const size_t bh = (((size_t)dir * GB + bl) * 4 + h) * 64;
    const bf16_t* qsrc = QT + ((size_t)dir * TG + rowb + (tid >> 3)) * 512 + h * 128 + (tid & 7) * 16;
    const bf16_t* ksrc = KST + bh * 8192 + (tid >> 2) * 64 + (tid & 3) * 16;
    const bf16_t* asrc = AM + bh * 4096 + (tid >> 3) * 64 + (tid & 7) * 8;
    const float* decb = DEC + bh * 128 + (tid & 127);
    const bf16_t* gvb = GV + h * 256 + vs * 64 + vg * 8;
    bf16_t* qdst = Qs + (tid >> 3) * LQ + (tid & 7) * 16; bf16_t* kdst = Ks + (tid >> 2) * LV + (tid & 3) * 16; bf16_t* adst = As + (tid >> 3) * LV + (tid & 7) * 8;
#define GLA_LOAD(P, c) do { const int t0_ = dir ? (SEQ - 1 - (c) * 64) : (c) * 64; \
        P.q0 = *(const u32x4*)(qsrc + (size_t)(c) * 64 * 512); P.q1 = *(const u32x4*)(qsrc + (size_t)(c) * 64 * 512 + 8); \
        P.k0 = *(const u32x4*)(ksrc + (size_t)(c) * 8192); P.k1 = *(const u32x4*)(ksrc + (size_t)(c) * 8192 + 8); \
        P.am = *(const u32x4*)(asrc + (size_t)(c) * 4096); \
        if (tid < 128) P.dcv = decb[(size_t)(c) * 128]; \
        P.vr = *(const u32x4*)(gvb + (rowb + t0_ + sgn * vj) * 1024); } while (0)
#define GLA_STEP(P, c) do { const int t0_ = dir ? (SEQ - 1 - (c) * 64) : (c) * 64; \
        *(u32x4*)qdst = P.q0; *(u32x4*)(qdst + 8) = P.q1; *(u32x4*)kdst = P.k0; *(u32x4*)(kdst + 8) = P.k1; *(u32x4*)adst = P.am; \
        _Pragma("unroll") for (int e = 0; e < 8; ++e) Vt[(vg * 8 + e) * LV + vj] = (unsigned short)(P.vr[e >> 1] >> ((e & 1) * 16)); \
        if (tid < 128) dcs[tid] = P.dcv; \
        LBAR(); \
        if (wid < 4) { f32x16 o = {}, o2 = {}; \
            _Pragma("unroll") for (int t = 0; t < 8; ++t) { const bf16x8 A = *(const bf16x8*)(Qs + (ib * 32 + r32) * LQ + 16 * t + hi * 8); const bf16x8 B = *(const bf16x8*)(St + (ov * 32 + r32) * LQ + 16 * t + hi * 8); \
                o = __builtin_amdgcn_mfma_f32_32x32x16_bf16(A, B, o, 0, 0, 0); } \
            _Pragma("unroll") for (int t = 0; t < 4; ++t) { const bf16x8 A = *(const bf16x8*)(As + (ib * 32 + r32) * LV + 16 * t + hi * 8); const bf16x8 B = *(const bf16x8*)(Vt + (ov * 32 + r32) * LV + 16 * t + hi * 8); \
                o2 = __builtin_amdgcn_mfma_f32_32x32x16_bf16(A, B, o2, 0, 0, 0); } \
            _Pragma("unroll") for (int r = 0; r < 16; ++r) Oout[(rowb + t0_ + sgn * (ib * 32 + crow(r, hi))) * 1024] = f2bf(o[r] + o2[r]); } \
        _Pragma("unroll") for (int g = 0; g < 4; ++g) { const f32x4 dc = *(const f32x4*)(dcs + db * 32 + 8 * g + 4 * hi); \
            Sacc[4 * g] *= dc[0]; Sacc[4 * g + 1] *= dc[1]; Sacc[4 * g + 2] *= dc[2]; Sacc[4 * g + 3] *= dc[3]; } \
        _Pragma("unroll") for (int t = 0; t < 4; ++t) { const bf16x8 A = *(const bf16x8*)(Ks + (db * 32 + r32) * LV + 16 * t + hi * 8); const bf16x8 B = *(const bf16x8*)(Vt + (vb * 32 + r32) * LV + 16 * t + hi * 8); \
            Sacc = __builtin_amdgcn_mfma_f32_32x32x16_bf16(A, B, Sacc, 0, 0, 0); } \
        LBAR(); \
        _Pragma("unroll") for (int g = 0; g < 4; ++g) { u32x2 w; w.x = pk2(Sacc[4 * g], Sacc[4 * g + 1]); w.y = pk2(Sacc[4 * g + 2], Sacc[4 * g + 3]); \
            *(u32x2*)(St + (vb * 32 + r32) * LQ + db * 32 + 8 * g + 4 * hi) = w; } } while (0)
    Pre P0, P1, P2, P3; P0.dcv = 0.f; P1.dcv = 0.f; P2.dcv = 0.f; P3.dcv = 0.f;
    GLA_LOAD(P0, 0); GLA_LOAD(P1, 1); GLA_LOAD(P2, 2); GLA_LOAD(P3, 3);
    LBAR();
    for (int c = 0; c < 64; c += 4) {
        GLA_STEP(P0, c);     if (c + 4 < 64) GLA_LOAD(P0, c + 4);
        GLA_STEP(P1, c + 1); if (c + 5 < 64) GLA_LOAD(P1, c + 5);
        GLA_STEP(P2, c + 2); if (c + 6 < 64) GLA_LOAD(P2, c + 6);
        GLA_STEP(P3, c + 3); if (c + 7 < 64) GLA_LOAD(P3, c + 7);
    }
    LBAR();
#undef GLA_LOAD
#undef GLA_STEP
}
}

#define LASF __attribute__((address_space(3)))
__device__ __forceinline__ void tr_item(const float* W, int K, int N, bf16_t* WT, int n0, int c0, int k0, const float* kscale, float* scr, int lane) {
    float tv[32];
#pragma unroll
    for (int i = 0; i < 32; ++i) { const int kk = 2 * i + (lane >> 5); tv[i] = (c0 >= 0) ? W[(size_t)(k0 + kk) * N + c0 + (lane & 31)] : 0.f; }
#pragma unroll
    for (int i = 0; i < 32; ++i) { const int kk = 2 * i + (lane >> 5); float v = tv[i]; if (kscale) v *= kscale[k0 + kk]; scr[kk * 33 + (lane & 31)] = v; }
    asm volatile("s_waitcnt lgkmcnt(0)" ::: "memory");
    const int c = lane & 7;
#pragma unroll
    for (int j = 0; j < 4; ++j) { const int n = (lane >> 3) + 8 * j; const float* s = scr + (8 * c) * 33 + n;
        u32x4 o; o.x = pk2(s[0 * 33], s[1 * 33]); o.y = pk2(s[2 * 33], s[3 * 33]); o.z = pk2(s[4 * 33], s[5 * 33]); o.w = pk2(s[6 * 33], s[7 * 33]);
        *(u32x4*)(WT + (size_t)(n0 + n) * K + k0 + 8 * c) = o; }
    asm volatile("s_waitcnt lgkmcnt(0)" ::: "memory");
}
__device__ __forceinline__ int win_src(int n0) {
    if (n0 < 3072) return n0;
    if (n0 < 5120) { const int t = n0 & ~255, p = n0 & 255; const int bj = p >> 7, blk = (p >> 6) & 1, i = p & 63; return t + 32 + blk * 128 + bj * 64 + i; }
    if (n0 < 8192) return n0 + 32;
    if (n0 == 8192) return 3072;
    return -1;
}
__device__ __forceinline__ int wfi_src(int n0) { const int pn = n0 >> 8, p = n0 & 255, bj = p >> 7, j = p & 127; return bj * FFH + pn * 128 + j; }

struct KArgs { const float* in[16]; float* out; unsigned char* ws; int ph_lo, ph_hi; };

__device__ __forceinline__ void phase_prologue(const KArgs& a, char* lds, int vcu, int G) {
    int tid_ = threadIdx.x; asm volatile("" : "+v"(tid_)); const int tid = tid_, lane = tid & 63, wid = tid >> 6;
    unsigned char* ws = a.ws;
    float* scr = (float*)(lds + wid * 8704);
    const int gw = vcu * 8 + wid, NGW = G * 8;
    constexpr int I_IN = (NIN / 32) * 16, I_OUT = 32 * 16, I_FI = (NFI / 32) * 16, I_FO = 32 * 44;
    for (int it = gw; it < I_IN + I_OUT + I_FI + I_FO; it += NGW) {
        int r = it;
        if (r < I_IN) { const int nb = r >> 4, kb = r & 15; tr_item(a.in[2], DM, INW, (bf16_t*)(ws + WS_WIN), nb * 32, win_src(nb * 32), kb * 64, nullptr, scr, lane); continue; } r -= I_IN;
        if (r < I_OUT) { const int nb = r >> 4, kb = r & 15; tr_item(a.in[11], DM, DM, (bf16_t*)(ws + WS_WOUT), nb * 32, nb * 32, kb * 64, nullptr, scr, lane); continue; } r -= I_OUT;
        if (r < I_FI) { const int nb = r >> 4, kb = r & 15; tr_item(a.in[13], DM, NFI, (bf16_t*)(ws + WS_WFI), nb * 32, wfi_src(nb * 32), kb * 64, a.in[12], scr, lane); continue; } r -= I_FI;
        { const int nb = r / 44, kb = r % 44; tr_item(a.in[14], FFH, DM, (bf16_t*)(ws + WS_WFO), nb * 32, nb * 32, kb * 64, nullptr, scr, lane); }
    }
    { const float* nw = a.in[1]; bf16_t* U = (bf16_t*)(ws + WS_U);
      f32x4 wv[4];
#pragma unroll
      for (int j = 0; j < 4; ++j) wv[j] = *((const f32x4*)nw + lane + 64 * j);
      for (int m0 = gw; m0 < NTOK; m0 += 4 * NGW) {
        f32x4 v[4][4]; float s[4];
#pragma unroll
        for (int k = 0; k < 4; ++k) { const int m = m0 + k * NGW; s[k] = 0.f; if (m < NTOK) { const f32x4* __restrict__ xr = (const f32x4*)(a.in[0] + (size_t)m * DM) + lane;
#pragma unroll
            for (int j = 0; j < 4; ++j) v[k][j] = xr[64 * j]; } else {
#pragma unroll
            for (int j = 0; j < 4; ++j) v[k][j] = (f32x4){0.f, 0.f, 0.f, 0.f}; } }
#pragma unroll
        for (int k = 0; k < 4; ++k) {
#pragma unroll
            for (int j = 0; j < 4; ++j) s[k] += (v[k][j][0] * v[k][j][0] + v[k][j][1] * v[k][j][1]) + (v[k][j][2] * v[k][j][2] + v[k][j][3] * v[k][j][3]); }
#pragma unroll
        for (int k = 0; k < 4; ++k) { const int m = m0 + k * NGW; if (m < NTOK) { const float rstd = rsqrtf(wave_sum(s[k]) * (1.f / DM) + EPS);
            u32x2* __restrict__ o8 = (u32x2*)(U + (size_t)m * DM) + lane;
#pragma unroll
            for (int j = 0; j < 4; ++j) { u32x2 w; w.x = pk2(v[k][j][0] * rstd * wv[j][0], v[k][j][1] * rstd * wv[j][1]); w.y = pk2(v[k][j][2] * rstd * wv[j][2], v[k][j][3] * rstd * wv[j][3]); o8[64 * j] = w; } } }
      } }
    { float* rope = (float*)(ws + WS_ROPE);
      for (int idx = vcu * 512 + tid; idx < SEQ * 64; idx += G * 512) { const int pos = idx >> 6, i = idx & 63;
          const double inv = exp(-9.210340371976184 * (double)i / 64.0); const double ang = (double)pos * inv;
          rope[2 * idx] = (float)cos(ang); rope[2 * idx + 1] = (float)sin(ang); } }
    { float* ss = (float*)(ws + WS_SS1);
      for (int idx = vcu * 512 + tid; idx < 2 * NTOK; idx += G * 512) ss[idx] = 0.f; }
    if (vcu == 0 && wid == 0) {
        const float s1 = wave_sum(a.in[6][lane] * a.in[7][lane] + a.in[6][lane + 64] * a.in[7][lane + 64]);
        const float s2 = wave_sum(a.in[8][lane] * a.in[9][lane] + a.in[8][lane + 64] * a.in[9][lane + 64]);
        if (lane == 0) *(float*)(ws + WS_CTL) = expf(s1) - expf(s2) + LAMBDA_INIT;
    }
}

__device__ __forceinline__ void phase_merge(const KArgs& a, int g, int vcu, int G) {
    int tid_ = threadIdx.x; asm volatile("" : "+v"(tid_)); const int tid = tid_, lane = tid & 63, wid = tid >> 6;
    unsigned char* ws = a.ws;
    const bf16_t* __restrict__ OF = (const bf16_t*)(ws + WS_OF); const bf16_t* __restrict__ OB = (const bf16_t*)(ws + WS_OB); const bf16_t* __restrict__ GR = (const bf16_t*)(ws + WS_GR);
    const bf16_t* __restrict__ O2 = (const bf16_t*)(ws + WS_O2C); const bf16_t* __restrict__ GA = (const bf16_t*)(ws + WS_GA); const bf16_t* __restrict__ GBb = (const bf16_t*)(ws + WS_GB);
    bf16_t* __restrict__ MG = (bf16_t*)(ws + WS_MERGED) + (size_t)g * TG * DM;
    const int e0 = lane * 16, c0 = e0 & 255;
    float gw_[16], sw_[16];
#pragma unroll
    for (int e = 0; e < 16; ++e) { gw_[e] = a.in[5][c0 + e]; sw_[e] = a.in[10][c0 + e] * (1.f - LAMBDA_INIT); }
#pragma unroll 2
    for (int m = vcu * 8 + wid; m < TG; m += G * 8) {
        const size_t off = (size_t)m * DM + e0;
        u32x4 vf[2], vb[2], vr[2], v2[2], va[2], vg[2];
#pragma unroll
        for (int q = 0; q < 2; ++q) { vf[q] = *(const u32x4*)(OF + off + 8 * q); vb[q] = *(const u32x4*)(OB + off + 8 * q); vr[q] = *(const u32x4*)(GR + off + 8 * q);
            v2[q] = *(const u32x4*)(O2 + off + 8 * q); va[q] = *(const u32x4*)(GA + off + 8 * q); vg[q] = *(const u32x4*)(GBb + off + 8 * q); }
        float oa[16], o2[16]; float sa = 0.f, sb = 0.f;
#pragma unroll
        for (int e = 0; e < 16; ++e) { const int q = e >> 3, w = (e >> 1) & 3, sh = (e & 1) * 16;
            const float f = bf2f((unsigned short)(vf[q][w] >> sh)) + bf2f((unsigned short)(vb[q][w] >> sh)); const float t = bf2f((unsigned short)(v2[q][w] >> sh));
            oa[e] = f; o2[e] = t; sa += f * f; sb += t * t; }
#pragma unroll
        for (int o = 1; o < 16; o <<= 1) { sa += __shfl_xor(sa, o); sb += __shfl_xor(sb, o); }
        const float ra = rsqrtf(sa * (1.f / 256.f) + EPS), rb = rsqrtf(sb * (1.f / 256.f) + SUBLN_EPS);
        float mo[16];
#pragma unroll
        for (int e = 0; e < 16; ++e) { const int q = e >> 3, w = (e >> 1) & 3, sh = (e & 1) * 16;
            const float gr = bf2f((unsigned short)(vr[q][w] >> sh)), ga = bf2f((unsigned short)(va[q][w] >> sh)), gb = bf2f((unsigned short)(vg[q][w] >> sh));
            const float ya = oa[e] * ra * gw_[e] * (gr * sigmoidf_(gr)); const float yb = o2[e] * rb * sw_[e];
            mo[e] = sigmoidf_(ga) * ya + sigmoidf_(gb) * yb; }
        u32x4 w0, w1;
        w0.x = pk2(mo[0], mo[1]); w0.y = pk2(mo[2], mo[3]); w0.z = pk2(mo[4], mo[5]); w0.w = pk2(mo[6], mo[7]);
        w1.x = pk2(mo[8], mo[9]); w1.y = pk2(mo[10], mo[11]); w1.z = pk2(mo[12], mo[13]); w1.w = pk2(mo[14], mo[15]);
        *(u32x4*)(MG + off) = w0; *(u32x4*)(MG + off + 8) = w1;
    }
}

__device__ __forceinline__ void glr_panels(const bf16_t* U, const bf16_t* WT, float* GLR, int vcu, int G) {
    int tid_ = threadIdx.x; asm volatile("" : "+v"(tid_)); const int lane = tid_ & 63, wid = tid_ >> 6, r32 = lane & 31, hi = lane >> 5;
    const bf16_t* bp = WT + (size_t)r32 * DM + hi * 8;
    for (int p = vcu * 8 + wid; p < TG / 32; p += G * 8) {
        const bf16_t* ap = U + (size_t)(p * 32 + r32) * DM + hi * 8;
        att::f32x16 acc = {};
        att::bf16x8 fa[8], fb[8], ga[8], gb[8];
#define GLR_LD(A_, B_, t0_) do { _Pragma("unroll") for (int t = 0; t < 8; ++t) { A_[t] = *(const att::bf16x8*)(ap + 16 * ((t0_) + t)); B_[t] = *(const att::bf16x8*)(bp + 16 * ((t0_) + t)); } } while (0)
#define GLR_MM(A_, B_) do { _Pragma("unroll") for (int t = 0; t < 8; ++t) acc = __builtin_amdgcn_mfma_f32_32x32x16_bf16(A_[t], B_[t], acc, 0, 0, 0); } while (0)
        GLR_LD(fa, fb, 0);
#pragma unroll 1
        for (int t0 = 0; t0 < 64; t0 += 16) { GLR_LD(ga, gb, t0 + 8); GLR_MM(fa, fb); if (t0 + 16 < 64) GLR_LD(fa, fb, t0 + 16); GLR_MM(ga, gb); }
#undef GLR_LD
#undef GLR_MM
#pragma unroll
        for (int r = 0; r < 16; ++r) GLR[(size_t)(p * 32 + gla::crow(r, hi)) * 32 + r32] = acc[r];
    }
}
#define LAS __attribute__((address_space(3)))
#define XB_TMO      128
#define XB_XCNT(j)  (256  + 64 * (j))
#define XB_XSUB(j)  (1280 + 64 * (j))
#define XB_XGEN(j)  (2304 + 64 * (j))
#define XB_TOP      3328
#define XB_TOPGEN   3392
#define XCD_BAR_WORDS 3456
#define XB_SPIN_CAP (1u << 18)

__device__ __forceinline__ unsigned xb_ld(unsigned* p)              { return __hip_atomic_load(p, __ATOMIC_RELAXED, __HIP_MEMORY_SCOPE_AGENT); }
__device__ __forceinline__ unsigned xb_add(unsigned* p, unsigned v) { return __hip_atomic_fetch_add(p, v, __ATOMIC_RELAXED, __HIP_MEMORY_SCOPE_AGENT); }
__device__ __forceinline__ unsigned xb_xcc_id() { return (unsigned)__builtin_amdgcn_s_getreg((3 << 11) | 20) & 0xFu; }
#define XB_SPIN(cond, bar) do { unsigned _sp = 0; while (cond) { __builtin_amdgcn_s_sleep(1); \
    if ((++_sp & 255u) == 0u) { if (xb_ld(&(bar)[XB_TMO])) break; if (_sp > XB_SPIN_CAP) { atomicAdd(&(bar)[XB_TMO], 1u); break; } } } } while (0)

struct XcdBarrier {
    unsigned* bar; unsigned x;
    volatile LAS unsigned* st;
};

__device__ __forceinline__ XcdBarrier xcd_barrier_post(unsigned* bar, volatile LAS unsigned* st) {
    XcdBarrier b; b.bar = bar; b.x = xb_xcc_id(); b.st = st;
    if (threadIdx.x == 0) st[2] = xb_add(&bar[XB_XCNT(b.x)], 1u);
    return b;
}
__device__ __forceinline__ void xcd_barrier_complete(unsigned* bar, unsigned x, unsigned& nloc, unsigned& nx) {
    const unsigned G = gridDim.x * gridDim.y * gridDim.z;
    unsigned sum, cnt, mine, sp = 0u;
    for (;;) {
        sum = 0u; cnt = 0u; mine = 0u;
#pragma unroll
        for (unsigned j = 0; j < 16; ++j) { const unsigned c = xb_ld(&bar[XB_XCNT(j)]); sum += c; cnt += (c > 0u) ? 1u : 0u; mine = (j == x) ? c : mine; }
        if (sum == G) break;
        __builtin_amdgcn_s_sleep(1);
        if ((++sp & 255u) == 0u) { if (xb_ld(&bar[XB_TMO])) break; if (sp > XB_SPIN_CAP) { atomicAdd(&bar[XB_TMO], 1u); break; } }
    }
    nloc = mine > 0u ? mine : 1u; nx = cnt > 0u ? cnt : 1u;
}

__device__ __forceinline__ void xcd_barrier(const XcdBarrier& b) {
    asm volatile("s_waitcnt vmcnt(0)" ::: "memory");
    __syncthreads();
    if (threadIdx.x == 0) {
        unsigned* bar = b.bar;
        __builtin_amdgcn_s_waitcnt(0);
        unsigned nloc = b.st[0], nx = b.st[1];
        if (nloc == 0u) { xcd_barrier_complete(bar, b.x, nloc, nx); b.st[0] = nloc; b.st[1] = nx; }
        const unsigned old = xb_add(&bar[XB_XSUB(b.x)], 1u);
        const unsigned gen = old / nloc;
        if (old + 1u == (gen + 1u) * nloc) {
            __builtin_amdgcn_fence(__ATOMIC_RELEASE, "agent");
            asm volatile("s_waitcnt vmcnt(0)" ::: "memory");
            const unsigned og = xb_add(&bar[XB_TOP], 1u);
            const unsigned tg = og / nx;
            if (og + 1u == (tg + 1u) * nx) xb_add(&bar[XB_TOPGEN], 1u);
            else XB_SPIN(xb_ld(&bar[XB_TOPGEN]) == tg, bar);
            __builtin_amdgcn_fence(__ATOMIC_ACQUIRE, "agent");
            xb_add(&bar[XB_XGEN(b.x)], 1u);
            asm volatile("s_waitcnt vmcnt(0)" ::: "memory");
        } else {
            XB_SPIN(xb_ld(&bar[XB_XGEN(b.x)]) == gen, bar);
            __builtin_amdgcn_fence(__ATOMIC_ACQUIRE, "agent");
            asm volatile("s_waitcnt vmcnt(0)" ::: "memory");
        }
    }
    __syncthreads();
}

__global__ void __launch_bounds__(512) hybrid_fwd(KArgs a) {
    extern __shared__ __attribute__((aligned(16))) unsigned char lds[];
    cg::grid_group grid = cg::this_grid();
    const int G = gridDim.x, bx = blockIdx.x;
    int vcu = (G % 8 == 0) ? (bx % 8) * (G / 8) + bx / 8 : bx;
    int cg_ = bx;
#define IN(k) (lo <= (k) && (k) < hi)
#define SEAM(k) do { if (IN(k) && IN((k) + 1)) xcd_barrier(xbar); } while (0)
#define WSP unsigned char* ws = a.ws
    const int lo = a.ph_lo, hi = a.ph_hi;
    if (lo > NPHASE) grid.sync();
    volatile LAS unsigned* xst = (volatile LAS unsigned*)((LAS unsigned char*)lds + 150528);
    if (threadIdx.x < 4) xst[threadIdx.x] = 0u;
    __syncthreads();
    XcdBarrier xbar; xbar.bar = (unsigned*)(a.ws + WS_BAR); xbar.x = 0; xbar.st = xst;
    if (hi - lo > 2) xbar = xcd_barrier_post((unsigned*)(a.ws + WS_BAR), xst);
    if (IN(0)) {
#ifndef DIS_PRO
        phase_prologue(a, (char*)lds, vcu, G);
#endif
    }
    SEAM(0);
    if (IN(0) && IN(1) && G % 8 == 0) {
        if (threadIdx.x == 0) { bool ok = xbar.x < 8u; for (unsigned j = 0; j < 16; ++j) { const unsigned c = xb_ld(&xbar.bar[XB_XCNT(j)]); ok = ok && (c == (j < 8u ? (unsigned)G / 8u : 0u)); }
            xst[3] = ok ? 1u : 0u; }
        __syncthreads();
        if (xst[3]) { const int rk = (int)xst[2], xc = (int)xbar.x; vcu = xc * (G / 8) + rk; cg_ = rk * 8 + xc; }
    }
    { constexpr int g = 0;
      if (IN(1)) { WSP;
                glr_panels((const bf16_t*)(ws + WS_U) + (size_t)g * TG * DM, (const bf16_t*)(ws + WS_WIN) + (size_t)8192 * DM, (float*)(ws + WS_GLR), vcu, G);
                pg8::Gemm gm{(const bf16_t*)(ws + WS_U) + (size_t)g * TG * DM, (const bf16_t*)(ws + WS_WIN), TG, 8192, DM};
                pg8::StaticOrder S; S.init(TG, 8192, G, cg_);
                EpiIn E{(bf16_t*)(ws + WS_GQ), (bf16_t*)(ws + WS_GK), (bf16_t*)(ws + WS_GV), (bf16_t*)(ws + WS_GR), (bf16_t*)(ws + WS_DQ), (bf16_t*)(ws + WS_DK), (bf16_t*)(ws + WS_DV),
                        (bf16_t*)(ws + WS_GA), (bf16_t*)(ws + WS_GB), (float*)(ws + WS_GLR), (const float*)(ws + WS_ROPE)};
#ifndef DIS_G1
                pg8::gemm_phase<EpiIn, pg8::StaticOrder, true, true>((PG8_LAS unsigned char*)lds, gm, S, E);
#endif
      }
      SEAM(1);
            if (IN(2)) { WSP;
#ifndef DIS_GLA
                gla::prep_phase(vcu, G, GB * 512, (const bf16_t*)(ws + WS_GQ), (const bf16_t*)(ws + WS_GK), (const float*)(ws + WS_GLR), a.in[3], a.in[4],
                                (bf16_t*)((unsigned char*)a.out + OUT_QT), (bf16_t*)((unsigned char*)a.out + OUT_KST), (float*)(ws + WS_DEC), (bf16_t*)(ws + WS_MERGED + 64 * MiB), (char*)lds);
#endif
      }
      SEAM(2);
      if (IN(3)) { WSP;
#ifndef DIS_GLA
                for (int it = vcu; it < GB * 32; it += G)
                    gla::scan_item(it, (const bf16_t*)(ws + WS_GV), (const bf16_t*)((unsigned char*)a.out + OUT_QT), (const bf16_t*)((unsigned char*)a.out + OUT_KST), (const float*)(ws + WS_DEC), (const bf16_t*)(ws + WS_MERGED + 64 * MiB),
                                   (bf16_t*)(ws + WS_OF), (bf16_t*)(ws + WS_OB), (char*)lds);
#endif
#ifndef DIS_ATT
                const float lam = *(const float*)(ws + WS_CTL);
                for (int un = vcu; un < GB * 64; un += G) {
                    const int qb = un & 15, h = (un >> 4) & 3, bl = un >> 6;
                    const size_t r0 = (size_t)bl * SEQ * 1024;
                    const att::bf16* Q = (const att::bf16*)(ws + WS_DQ) + r0 + (size_t)qb * 256 * 1024 + h * 256;
                    const att::bf16* Kp = (const att::bf16*)(ws + WS_DK) + r0 + h * 256;
                    const att::bf16* Vp = (const att::bf16*)(ws + WS_DV) + r0 + h * 256;
                    float* O1 = a.out + r0 + (size_t)qb * 256 * 1024 + h * 256;
                    bf16_t* O2 = (bf16_t*)(ws + WS_O2C) + r0 + (size_t)qb * 256 * 1024 + h * 256;
#pragma unroll 1
                    for (int p = 0; p < 2; ++p) att2::attn256_body(Q + 128 * p, Kp + 128 * p, Vp, O1, O2, p, lam, SEQ, (char*)lds);
                }
#endif
      }
      SEAM(3);
      if (IN(4)) {
#ifndef DIS_MRG
                phase_merge(a, g, vcu, G);
#endif
      }
      SEAM(4);
    }
    { constexpr int g = 1;
      if (IN(5)) { WSP;
                glr_panels((const bf16_t*)(ws + WS_U) + (size_t)g * TG * DM, (const bf16_t*)(ws + WS_WIN) + (size_t)8192 * DM, (float*)(ws + WS_GLR), vcu, G);
                pg8::Gemm gm{(const bf16_t*)(ws + WS_U) + (size_t)g * TG * DM, (const bf16_t*)(ws + WS_WIN), TG, 8192, DM};
                pg8::StaticOrder S; S.init(TG, 8192, G, cg_);
                EpiIn E{(bf16_t*)(ws + WS_GQ), (bf16_t*)(ws + WS_GK), (bf16_t*)(ws + WS_GV), (bf16_t*)(ws + WS_GR), (bf16_t*)(ws + WS_DQ), (bf16_t*)(ws + WS_DK), (bf16_t*)(ws + WS_DV),
                        (bf16_t*)(ws + WS_GA), (bf16_t*)(ws + WS_GB), (float*)(ws + WS_GLR), (const float*)(ws + WS_ROPE)};
#ifndef DIS_G1
                pg8::gemm_phase<EpiIn, pg8::StaticOrder, true, true>((PG8_LAS unsigned char*)lds, gm, S, E);
#endif
      }
      SEAM(5);
            if (IN(6)) { WSP;
#ifndef DIS_GLA
                gla::prep_phase(vcu, G, GB * 512, (const bf16_t*)(ws + WS_GQ), (const bf16_t*)(ws + WS_GK), (const float*)(ws + WS_GLR), a.in[3], a.in[4],
                                (bf16_t*)((unsigned char*)a.out + OUT_QT), (bf16_t*)((unsigned char*)a.out + OUT_KST), (float*)(ws + WS_DEC), (bf16_t*)(ws + WS_MERGED + 64 * MiB), (char*)lds);
#endif
      }
      SEAM(6);
      if (IN(7)) { WSP;
#ifndef DIS_GLA
                for (int it = vcu; it < GB * 32; it += G)
                    gla::scan_item(it, (const bf16_t*)(ws + WS_GV), (const bf16_t*)((unsigned char*)a.out + OUT_QT), (const bf16_t*)((unsigned char*)a.out + OUT_KST), (const float*)(ws + WS_DEC), (const bf16_t*)(ws + WS_MERGED + 64 * MiB),
                                   (bf16_t*)(ws + WS_OF), (bf16_t*)(ws + WS_OB), (char*)lds);
#endif
#ifndef DIS_ATT
                const float lam = *(const float*)(ws + WS_CTL);
                for (int un = vcu; un < GB * 64; un += G) {
                    const int qb = un & 15, h = (un >> 4) & 3, bl = un >> 6;
                    const size_t r0 = (size_t)bl * SEQ * 1024;
                    const att::bf16* Q = (const att::bf16*)(ws + WS_DQ) + r0 + (size_t)qb * 256 * 1024 + h * 256;
                    const att::bf16* Kp = (const att::bf16*)(ws + WS_DK) + r0 + h * 256;
                    const att::bf16* Vp = (const att::bf16*)(ws + WS_DV) + r0 + h * 256;
                    float* O1 = a.out + r0 + (size_t)qb * 256 * 1024 + h * 256;
                    bf16_t* O2 = (bf16_t*)(ws + WS_O2C) + r0 + (size_t)qb * 256 * 1024 + h * 256;
#pragma unroll 1
                    for (int p = 0; p < 2; ++p) att2::attn256_body(Q + 128 * p, Kp + 128 * p, Vp, O1, O2, p, lam, SEQ, (char*)lds);
                }
#endif
      }
      SEAM(7);
      if (IN(8)) {
#ifndef DIS_MRG
                phase_merge(a, g, vcu, G);
#endif
      }
      SEAM(8);
    }
    if (IN(9)) { WSP;
            pg8::Gemm gm{(const bf16_t*)(ws + WS_MERGED), (const bf16_t*)(ws + WS_WOUT), NTOK, DM, DM};
            pg8::StaticOrder S; S.init(NTOK, DM, G, cg_);
            EpiOutProj E{a.in[0], (bf16_t*)(ws + WS_H1B), (float*)(ws + WS_SS1)};
#ifndef DIS_G2
            pg8::gemm_phase<EpiOutProj, pg8::StaticOrder, true, true>((PG8_LAS unsigned char*)lds, gm, S, E);
#endif
    }
    SEAM(9);
    if (IN(10)) { WSP;
            pg8::Gemm gm{(const bf16_t*)(ws + WS_H1B), (const bf16_t*)(ws + WS_WFI), NTOK, NFI, DM};
            pg8::StaticOrder S; S.init(NTOK, NFI, G, cg_);
            EpiFfnIn E{(const float*)(ws + WS_SS1), (bf16_t*)(ws + WS_ACT)};
#ifndef DIS_G3
            pg8::gemm_phase<EpiFfnIn, pg8::StaticOrder, true, true>((PG8_LAS unsigned char*)lds, gm, S, E);
#endif
    }
    SEAM(10);
    if (IN(11)) { WSP;
            pg8::Gemm gm{(const bf16_t*)(ws + WS_ACT), (const bf16_t*)(ws + WS_WFO), NTOK, DM, FFH};
            pg8::StaticOrder S; S.init(NTOK, DM, G, cg_);
            EpiFfnOut E{(const bf16_t*)(ws + WS_H1B), (bf16_t*)(ws + WS_MERGED), (float*)(ws + WS_SS2)};
#ifndef DIS_G4
            pg8::gemm_phase<EpiFfnOut, pg8::StaticOrder, true, true>((PG8_LAS unsigned char*)lds, gm, S, E);
#endif
    }
    SEAM(11);
    if (IN(12)) { WSP;
            const float* ss = (const float*)(ws + WS_SS2); const f32x4* wf = (const f32x4*)a.in[15]; f32x4* o4 = (f32x4*)a.out; const u32x2* h2 = (const u32x2*)(ws + WS_MERGED);
            {
                const size_t stride = (size_t)G * 512, total = (size_t)NTOK * 256; size_t idx = (size_t)vcu * 512 + threadIdx.x; const f32x4 wv = wf[idx & 255];
                for (; idx + 3 * stride < total; idx += 4 * stride) { u32x2 hw[4]; float sv[4];
#pragma unroll
                    for (int k = 0; k < 4; ++k) { hw[k] = h2[idx + k * stride]; sv[k] = ss[(idx + k * stride) >> 8]; }
#pragma unroll
                    for (int k = 0; k < 4; ++k) { const float rstd = rsqrtf(sv[k] * (1.f / 1024.f) + EPS); f32x4 h; h[0] = __uint_as_float(hw[k].x << 16); h[1] = __uint_as_float(hw[k].x & 0xffff0000u); h[2] = __uint_as_float(hw[k].y << 16); h[3] = __uint_as_float(hw[k].y & 0xffff0000u);
                        o4[idx + k * stride] = h * rstd * wv; } }
                for (; idx < total; idx += stride) { const float rstd = rsqrtf(ss[idx >> 8] * (1.f / 1024.f) + EPS); const u32x2 hw = h2[idx]; f32x4 h; h[0] = __uint_as_float(hw.x << 16); h[1] = __uint_as_float(hw.x & 0xffff0000u); h[2] = __uint_as_float(hw.y << 16); h[3] = __uint_as_float(hw.y & 0xffff0000u);
                    o4[idx] = h * rstd * wv; } }
    }
#undef IN
#undef SEAM
#undef WSP
}

extern "C" void kernel_launch(void* const* d_in, const int* in_sizes, int n_in, void* d_out, int out_size, void* d_ws, size_t ws_size, hipStream_t stream) {
    static int grid = 0;
    if (grid == 0) {
        if (n_in != 16 || in_sizes[0] != NTOK * DM || out_size != NTOK * DM || ws_size < WS_END) {
            fprintf(stderr, "kernel_launch: shape/workspace mismatch (n_in %d, in0 %d, out %d, ws %zu, need %zu)\n", n_in, n_in > 0 ? in_sizes[0] : -1, out_size, ws_size, (size_t)WS_END); grid = -1; return; }
        int dev = 0, cus = 0, per_cu = 0;
        hipGetDevice(&dev); hipDeviceGetAttribute(&cus, hipDeviceAttributeMultiprocessorCount, dev);
        if (hipFuncSetAttribute((const void*)hybrid_fwd, hipFuncAttributeMaxDynamicSharedMemorySize, LDS_BYTES) != hipSuccess) { fprintf(stderr, "kernel_launch: hipFuncSetAttribute failed\n"); grid = -1; return; }
        if (hipOccupancyMaxActiveBlocksPerMultiprocessor(&per_cu, (const void*)hybrid_fwd, 512, LDS_BYTES) != hipSuccess || per_cu < 1) { fprintf(stderr, "kernel_launch: occupancy query gave %d\n", per_cu); per_cu = 1; }
        (void)hipGetLastError();
        grid = cus * 1;
        if (grid <= 0) grid = 256;
    }
    if (grid < 0) return;
    if (hipMemsetAsync((char*)d_ws + WS_BAR, 0, WS_BAR_BYTES, stream) != hipSuccess) { fprintf(stderr, "kernel_launch: hipMemsetAsync of the barrier words failed\n"); return; }
    KArgs a{};
    for (int i = 0; i < 16; ++i) a.in[i] = (const float*)d_in[i];
    a.out = (float*)d_out; a.ws = (unsigned char*)d_ws;
#if N_LAUNCH_MODE == 1
    a.ph_lo = 0; a.ph_hi = NPHASE;
    { void* args[] = {&a};
      hipError_t e = hipLaunchCooperativeKernel((const void*)hybrid_fwd, dim3(grid), dim3(512), args, LDS_BYTES, stream);
      if (e != hipSuccess) fprintf(stderr, "cooperative launch failed: %s (grid %d)\n", hipGetErrorString(e), grid); }
#else
    for (int ph = 0; ph < NPHASE; ++ph) {
        a.ph_lo = ph; a.ph_hi = ph + 1; void* args[] = {&a};
        hipError_t e = hipLaunchCooperativeKernel((const void*)hybrid_fwd, dim3(grid), dim3(512), args, LDS_BYTES, stream);
        if (e != hipSuccess) { fprintf(stderr, "cooperative launch %d failed: %s (grid %d)\n", ph, hipGetErrorString(e), grid); break; }
    }
#endif
}
```
